# Optimizing an MI355X kernel written in HIP

```python
import math
import jax
import jax.numpy as jnp
from jax import lax
import numpy as np

D_MODEL = 2048
BATCH = 8
SEQ = 2048
DEPTH = 2

ROPE_THETA = 500000.0
Q_BLOCK = 128
NORM_EPS = 1e-5
MAX_POS_OFFSET = 4096

DIFF_HEADS = 4
DIFF_HALF_DIM = 64
DIFF_V_DIM = 2 * DIFF_HALF_DIM
DIFF_ROT = DIFF_HALF_DIM // 4

MLA_HEADS = 8
MLA_Q_RANK = 512
MLA_KV_RANK = 256
MLA_NOPE = 128
MLA_ROPE = 64
MLA_V = 128

MOBA_HEADS = 4
MOBA_HEAD_DIM = 128
MOBA_BLOCK = 256
MOBA_TOPK = 3
MOBA_ROT = MOBA_HEAD_DIM // 4
MOBA_Q_CHUNK = 128

A_WIDTH = DIFF_HEADS * DIFF_V_DIM
B_WIDTH = MLA_HEADS * MLA_V
C_WIDTH = MOBA_HEADS * MOBA_HEAD_DIM
MIX_WIDTH = A_WIDTH + B_WIDTH + C_WIDTH
N_BRANCHES = 3

IN_SIZES = (
    DIFF_HEADS * 2 * DIFF_HALF_DIM,
    DIFF_HEADS * 2 * DIFF_HALF_DIM,
    DIFF_HEADS * DIFF_V_DIM,
    MLA_Q_RANK,
    MLA_KV_RANK,
    MLA_ROPE,
    C_WIDTH, C_WIDTH, C_WIDTH,
    N_BRANCHES * D_MODEL,
)
IN_COLS = sum(IN_SIZES)

N_EXPERTS = 64
N_GROUPS = 8
TOPK_GROUPS = 4
TOPK = 8
EXPERT_FF = 512
SHARED_FF = 512
ROUTED_SCALE = 2.5
MOE_TOKEN_BLOCK = 1024

DEEPNORM_ALPHA = (2 * DEPTH) ** 0.25
DEEPNORM_BETA = (8 * DEPTH) ** -0.25

kernel_name = 'hybrid_gated_diff_mla_moba_moe'

F32 = jnp.float32


def _split(a, sizes):
    outs, off = [], 0
    for s in sizes:
        outs.append(a[..., off:off + s])
        off += s
    return outs


def _layer_norm(x, g, b):
    xf = x.astype(F32)
    mu = xf.mean(-1, keepdims=True)
    var = jnp.square(xf - mu).mean(-1, keepdims=True)
    return ((xf - mu) * lax.rsqrt(var + NORM_EPS) * g + b).astype(x.dtype)


def _rms_norm(x, g):
    xf = x.astype(F32)
    return (xf * lax.rsqrt(jnp.mean(jnp.square(xf), -1, keepdims=True) + NORM_EPS) * g).astype(x.dtype)


def _rope_tables(positions, rot_dim):
    inv_freq = ROPE_THETA ** (-jnp.arange(0, rot_dim, 2, dtype=F32) / rot_dim)
    ang = positions.astype(F32)[..., None] * inv_freq
    return jnp.cos(ang)[:, :, None, :], jnp.sin(ang)[:, :, None, :]


def _apply_rope(x, cs):
    cos, sin = cs
    half = cos.shape[-1]
    x1 = x[..., :half].astype(F32)
    x2 = x[..., half:2 * half].astype(F32)
    rot = jnp.concatenate([x1 * cos - x2 * sin, x2 * cos + x1 * sin], -1).astype(x.dtype)
    return jnp.concatenate([rot, x[..., 2 * half:]], -1)


def _heads(t):
    return t.transpose(0, 2, 1, 3)


def _causal_softmax(s, q_start):
    qpos = q_start + jnp.arange(s.shape[-2])
    kpos = jnp.arange(s.shape[-1])
    return jax.nn.softmax(jnp.where(kpos[None, :] <= qpos[:, None], s, -jnp.inf), axis=-1)


def _sweep_query_blocks(block_fn, *qs):
    b, h, s, _ = qs[0].shape
    n = s // Q_BLOCK
    blocks = tuple(q.reshape(b, h, n, Q_BLOCK, q.shape[-1]).transpose(2, 0, 1, 3, 4) for q in qs)
    out = lax.map(lambda a: block_fn(a[0] * Q_BLOCK, *a[1:]), (jnp.arange(n),) + blocks)
    return out.transpose(1, 2, 0, 3, 4).reshape(b, h, s, out.shape[-1])


def _causal_attention(q, k, v, scale):
    kf, vf = k.astype(F32), v.astype(F32)

    def block(q_start, qb):
        p = _causal_softmax(jnp.einsum('bhqd,bhkd->bhqk', qb.astype(F32), kf) * scale, q_start)
        return jnp.einsum('bhqk,bhkd->bhqd', p, vf)

    return _sweep_query_blocks(block, q)


def _diff_attention(q1, q2, k1, k2, v, lam):
    scale = DIFF_HALF_DIM ** -0.5
    k1f, k2f, vf = k1.astype(F32), k2.astype(F32), v.astype(F32)

    def block(q_start, q1b, q2b):
        p1 = _causal_softmax(jnp.einsum('bhqd,bhkd->bhqk', q1b.astype(F32), k1f) * scale, q_start)
        p2 = _causal_softmax(jnp.einsum('bhqd,bhkd->bhqk', q2b.astype(F32), k2f) * scale, q_start)
        return jnp.einsum('bhqk,bhkd->bhqd', p1 - lam * p2, vf)

    return _sweep_query_blocks(block, q1, q2)


def _moba_attention(q, k, v):
    b, h, s, dh = q.shape
    nb = -(-s // MOBA_BLOCK)
    n_sel = min(MOBA_TOPK, nb)
    pad = nb * MOBA_BLOCK - s
    padw = ((0, 0), (0, 0), (0, pad), (0, 0))
    kb = jnp.pad(k.astype(F32), padw).reshape(b, h, nb, MOBA_BLOCK, dh)
    vb = jnp.pad(v.astype(F32), padw).reshape(b, h, nb, MOBA_BLOCK, dh)
    qf = q.astype(F32)
    scale = dh ** -0.5
    k_mean = kb.mean(axis=3)
    gate = jnp.einsum('bhsd,bhnd->bhsn', qf, k_mean)
    q_block = jnp.arange(s) // MOBA_BLOCK
    fully_past = jnp.arange(nb)[None, :] < q_block[:, None]
    gate = jnp.where(fully_past, gate, -jnp.inf)
    gate_sel, sel = lax.top_k(gate, n_sel)
    valid = jnp.isfinite(gate_sel)
    head_idx = jnp.arange(h)[:, None, None]
    n_chunks = s // MOBA_Q_CHUNK

    def per_batch(args):
        q_b, kb_b, vb_b, sel_b, valid_b = args

        def per_chunk(c):
            q0 = c * MOBA_Q_CHUNK
            qc = lax.dynamic_slice_in_dim(q_b, q0, MOBA_Q_CHUNK, axis=1)
            sc = lax.dynamic_slice_in_dim(sel_b, q0, MOBA_Q_CHUNK, axis=1)
            vc = lax.dynamic_slice_in_dim(valid_b, q0, MOBA_Q_CHUNK, axis=1)
            k_sel = kb_b[head_idx, sc]
            v_sel = vb_b[head_idx, sc]
            s_sel = jnp.einsum('hqd,hqnld->hqnl', qc, k_sel) * scale
            s_sel = jnp.where(vc[..., None], s_sel, -jnp.inf).reshape(h, MOBA_Q_CHUNK, n_sel * MOBA_BLOCK)
            own = q0 // MOBA_BLOCK
            k_own = lax.dynamic_index_in_dim(kb_b, own, axis=1, keepdims=False)
            v_own = lax.dynamic_index_in_dim(vb_b, own, axis=1, keepdims=False)
            s_own = jnp.einsum('hqd,hld->hql', qc, k_own) * scale
            qpos = q0 + jnp.arange(MOBA_Q_CHUNK)
            kpos = own * MOBA_BLOCK + jnp.arange(MOBA_BLOCK)
            s_own = jnp.where(kpos[None, :] <= qpos[:, None], s_own, -jnp.inf)
            p = jax.nn.softmax(jnp.concatenate([s_sel, s_own], -1), axis=-1)
            p_sel = p[..., :n_sel * MOBA_BLOCK].reshape(h, MOBA_Q_CHUNK, n_sel, MOBA_BLOCK)
            p_own = p[..., n_sel * MOBA_BLOCK:]
            return (jnp.einsum('hqnl,hqnld->hqd', p_sel, v_sel)
                    + jnp.einsum('hql,hld->hqd', p_own, v_own))

        out = lax.map(per_chunk, jnp.arange(n_chunks))
        return out.transpose(1, 0, 2, 3).reshape(h, s, dh)

    return lax.map(per_batch, (qf, kb, vb, sel, valid))


def _token_mixer(x, ropes, layer, w_in, lq1, lk1, lq2, lk2, subln_g, q_norm_g, w_uq,
                 kv_norm_g, w_ukv, w_branch, w_out):
    b, s, _ = x.shape
    rope_diff, rope_mla, rope_moba = ropes
    dq, dk, dv, cq, ckv, kpe, mq, mk, mv, gates = _split(x @ w_in, IN_SIZES)

    q12 = dq.reshape(b, s, DIFF_HEADS, 2, DIFF_HALF_DIM)
    k12 = dk.reshape(b, s, DIFF_HEADS, 2, DIFF_HALF_DIM)
    q1 = _apply_rope(q12[..., 0, :], rope_diff)
    q2 = _apply_rope(q12[..., 1, :], rope_diff)
    k1 = _apply_rope(k12[..., 0, :], rope_diff)
    k2 = _apply_rope(k12[..., 1, :], rope_diff)
    lambda_init = 0.8 - 0.6 * math.exp(-0.3 * layer)
    lam = (jnp.exp(jnp.sum(lq1.astype(F32) * lk1.astype(F32)))
           - jnp.exp(jnp.sum(lq2.astype(F32) * lk2.astype(F32))) + lambda_init)
    o_a = _diff_attention(_heads(q1), _heads(q2), _heads(k1), _heads(k2),
                          _heads(dv.reshape(b, s, DIFF_HEADS, DIFF_V_DIM)), lam)
    o_a = _rms_norm(o_a, subln_g) * (1.0 - lambda_init)
    o_a = o_a.transpose(0, 2, 1, 3).reshape(b, s, A_WIDTH).astype(x.dtype)

    q = (_rms_norm(cq, q_norm_g) @ w_uq).reshape(b, s, MLA_HEADS, MLA_NOPE + MLA_ROPE)
    q = jnp.concatenate([q[..., :MLA_NOPE], _apply_rope(q[..., MLA_NOPE:], rope_mla)], -1)
    kv = (_rms_norm(ckv, kv_norm_g) @ w_ukv).reshape(b, s, MLA_HEADS, MLA_NOPE + MLA_V)
    k_pe = _apply_rope(kpe[:, :, None, :], rope_mla)
    k = jnp.concatenate([kv[..., :MLA_NOPE],
                         jnp.broadcast_to(k_pe, (b, s, MLA_HEADS, MLA_ROPE))], -1)
    o_b = _causal_attention(_heads(q), _heads(k), _heads(kv[..., MLA_NOPE:]),
                            (MLA_NOPE + MLA_ROPE) ** -0.5)
    o_b = o_b.transpose(0, 2, 1, 3).reshape(b, s, B_WIDTH).astype(x.dtype)

    qm = _apply_rope(mq.reshape(b, s, MOBA_HEADS, MOBA_HEAD_DIM), rope_moba)
    km = _apply_rope(mk.reshape(b, s, MOBA_HEADS, MOBA_HEAD_DIM), rope_moba)
    o_c = _moba_attention(_heads(qm), _heads(km), _heads(mv.reshape(b, s, MOBA_HEADS, MOBA_HEAD_DIM)))
    o_c = o_c.transpose(0, 2, 1, 3).reshape(b, s, C_WIDTH).astype(x.dtype)

    g = jax.nn.sigmoid(gates.astype(F32)).reshape(b, s, N_BRANCHES, D_MODEL)
    y = (g[..., 0, :] * (o_a @ w_branch[:A_WIDTH])
         + g[..., 1, :] * (o_b @ w_branch[A_WIDTH:A_WIDTH + B_WIDTH])
         + g[..., 2, :] * (o_c @ w_branch[A_WIDTH + B_WIDTH:]))
    return y.astype(x.dtype) @ w_out


def _moe_ffn(x, router_w, router_bias, w_gate, w_up, w_down, ws_gate, ws_up, ws_down):
    b, s, d = x.shape
    t = b * s
    xt = x.reshape(t, d)
    scores = jax.nn.sigmoid((xt @ router_w).astype(F32))
    choice = scores + router_bias.astype(F32)
    grp = choice.reshape(t, N_GROUPS, N_EXPERTS // N_GROUPS)
    grp_score = lax.top_k(grp, 2)[0].sum(-1)
    _, grp_idx = lax.top_k(grp_score, TOPK_GROUPS)
    grp_keep = jax.nn.one_hot(grp_idx, N_GROUPS, dtype=F32).sum(1) > 0
    choice = jnp.where(jnp.repeat(grp_keep, N_EXPERTS // N_GROUPS, axis=1), choice, -jnp.inf)
    _, idx = lax.top_k(choice, TOPK)
    w = jnp.take_along_axis(scores, idx, axis=-1)
    w = w / w.sum(-1, keepdims=True) * ROUTED_SCALE
    gates = jnp.zeros((t, N_EXPERTS), F32).at[jnp.arange(t)[:, None], idx].set(w)
    c = math.gcd(t, MOE_TOKEN_BLOCK)

    def chunk(args):
        xc, gc = args
        hid = jax.nn.silu(jnp.einsum('cd,edf->cef', xc, w_gate)) * jnp.einsum('cd,edf->cef', xc, w_up)
        return jnp.einsum('cef,efd->cd', hid * gc[..., None].astype(hid.dtype), w_down)

    routed = lax.map(chunk, (xt.reshape(t // c, c, d), gates.reshape(t // c, c, N_EXPERTS)))
    shared = (jax.nn.silu(x @ ws_gate) * (x @ ws_up)) @ ws_down
    return (routed.reshape(b, s, d) + shared).astype(x.dtype)


def setup_inputs(seed: int = 0) -> dict:
    key = jax.random.key(seed)
    ks = jax.random.split(key, 32)
    L, D = DEPTH, D_MODEL

    def nrm(k, shape, scale):
        return jax.random.normal(k, shape, F32) * scale

    def gain(k, shape):
        return 1.0 + 0.02 * jax.random.normal(k, shape, F32)

    x = jax.random.normal(ks[0], (BATCH, SEQ, D), F32)
    positions = (jax.random.randint(ks[1], (BATCH, 1), 0, MAX_POS_OFFSET, dtype=jnp.int32)
                 + jnp.arange(SEQ, dtype=jnp.int32)[None, :])
    w_branch = jnp.concatenate([nrm(ks[12], (L, A_WIDTH, D), A_WIDTH ** -0.5),
                                nrm(ks[13], (L, B_WIDTH, D), B_WIDTH ** -0.5),
                                nrm(ks[14], (L, C_WIDTH, D), C_WIDTH ** -0.5)], axis=1)
    return {
        'x': x,
        'positions': positions,
        'w_in': nrm(ks[2], (L, D, IN_COLS), D ** -0.5),
        'diff_lambda_q1': nrm(ks[3], (L, DIFF_HALF_DIM), 0.1),
        'diff_lambda_k1': nrm(ks[4], (L, DIFF_HALF_DIM), 0.1),
        'diff_lambda_q2': nrm(ks[5], (L, DIFF_HALF_DIM), 0.1),
        'diff_lambda_k2': nrm(ks[6], (L, DIFF_HALF_DIM), 0.1),
        'diff_subln_g': gain(ks[7], (L, DIFF_V_DIM)),
        'mla_q_norm_g': gain(ks[8], (L, MLA_Q_RANK)),
        'mla_w_uq': nrm(ks[9], (L, MLA_Q_RANK, MLA_HEADS * (MLA_NOPE + MLA_ROPE)), MLA_Q_RANK ** -0.5),
        'mla_kv_norm_g': gain(ks[10], (L, MLA_KV_RANK)),
        'mla_w_ukv': nrm(ks[11], (L, MLA_KV_RANK, MLA_HEADS * (MLA_NOPE + MLA_V)), MLA_KV_RANK ** -0.5),
        'w_branch': w_branch,
        'w_out': nrm(ks[15], (L, D, D), D ** -0.5 * DEEPNORM_BETA),
        'ln_mix_g': gain(ks[16], (L, D)),
        'ln_mix_b': nrm(ks[17], (L, D), 0.02),
        'router_w': nrm(ks[18], (L, D, N_EXPERTS), D ** -0.5),
        'router_bias': nrm(ks[19], (L, N_EXPERTS), 0.01),
        'expert_w_gate': nrm(ks[20], (L, N_EXPERTS, D, EXPERT_FF), D ** -0.5),
        'expert_w_up': nrm(ks[21], (L, N_EXPERTS, D, EXPERT_FF), D ** -0.5),
        'expert_w_down': nrm(ks[22], (L, N_EXPERTS, EXPERT_FF, D), EXPERT_FF ** -0.5 * DEEPNORM_BETA),
        'shared_w_gate': nrm(ks[23], (L, D, SHARED_FF), D ** -0.5),
        'shared_w_up': nrm(ks[24], (L, D, SHARED_FF), D ** -0.5),
        'shared_w_down': nrm(ks[25], (L, SHARED_FF, D), SHARED_FF ** -0.5 * DEEPNORM_BETA),
        'ln_ffn_g': gain(ks[26], (L, D)),
        'ln_ffn_b': nrm(ks[27], (L, D), 0.02),
    }


def reference(x, positions, w_in, diff_lambda_q1, diff_lambda_k1, diff_lambda_q2, diff_lambda_k2,
              diff_subln_g, mla_q_norm_g, mla_w_uq, mla_kv_norm_g, mla_w_ukv, w_branch, w_out,
              ln_mix_g, ln_mix_b, router_w, router_bias, expert_w_gate, expert_w_up, expert_w_down,
              shared_w_gate, shared_w_up, shared_w_down, ln_ffn_g, ln_ffn_b):
    ropes = (_rope_tables(positions, DIFF_ROT),
             _rope_tables(positions, MLA_ROPE),
             _rope_tables(positions, MOBA_ROT))
    for l in range(DEPTH):
        mix = _token_mixer(x, ropes, l, w_in[l], diff_lambda_q1[l], diff_lambda_k1[l],
                           diff_lambda_q2[l], diff_lambda_k2[l], diff_subln_g[l], mla_q_norm_g[l],
                           mla_w_uq[l], mla_kv_norm_g[l], mla_w_ukv[l], w_branch[l], w_out[l])
        x = _layer_norm(DEEPNORM_ALPHA * x + mix, ln_mix_g[l], ln_mix_b[l])
        ffn = _moe_ffn(x, router_w[l], router_bias[l], expert_w_gate[l], expert_w_up[l],
                       expert_w_down[l], shared_w_gate[l], shared_w_up[l], shared_w_down[l])
        x = _layer_norm(DEEPNORM_ALPHA * x + ffn, ln_ffn_g[l], ln_ffn_b[l])
    return x
```

```cpp
#include <hip/hip_runtime.h>
#include <cstdio>
#include <cstdint>
#include <cmath>

#ifndef REP_MASK
#define REP_MASK 0
#endif
#define REPN(k) (((REP_MASK >> (k)) & 1) ? 2 : 1)
#ifndef MK_ONE_LAUNCH
#define MK_ONE_LAUNCH 1
#endif

#define LAS __attribute__((address_space(3)))
#define GAS __attribute__((address_space(1)))
typedef unsigned short bf16_t;
typedef short bf16x8 __attribute__((ext_vector_type(8)));
typedef short s16x4 __attribute__((ext_vector_type(4)));
typedef float f32x4 __attribute__((ext_vector_type(4)));
typedef float f32x2 __attribute__((ext_vector_type(2)));
typedef float f32x16 __attribute__((ext_vector_type(16)));
typedef unsigned u32x4 __attribute__((ext_vector_type(4)));
typedef unsigned u32x2 __attribute__((ext_vector_type(2)));
typedef int v4i16_t __attribute__((ext_vector_type(2)));

constexpr int NB = 8, SEQ = 2048, T = NB * SEQ, DM = 2048;
constexpr int PC = 10240;
constexpr int C_DQ = 0, C_DK = 512, C_DV = 1024, C_CQ = 1536, C_CKV = 2048, C_MQ = 2304, C_MK = 2816, C_MV = 3328, C_G = 3840, C_KPE = 9984;
constexpr int IN_COLS = 10048;
constexpr int NEXP = 64, FF = 512;
constexpr int RT_ROWS = 147456;
constexpr int SR_ROWS = RT_ROWS + T;
constexpr int NRT = 56;
constexpr float NORM_EPS = 1e-5f;
constexpr float DN_ALPHA = 1.4142135623730951f;
constexpr int NPH = 11;

constexpr size_t MiB = 1u << 20;
constexpr size_t WS_CTL = 0, CTL_ZERO_BYTES = 1 * MiB;
constexpr int CW_BAR = 4096;
constexpr int CW_ECNT = 8192;
constexpr size_t WS_RSQQ = 52 * MiB, WS_RSQKV = 53 * MiB;
constexpr size_t WS_COS = 1 * MiB, WS_SIN = 5 * MiB;
constexpr size_t WS_KMEAN = 9 * MiB;
constexpr size_t WS_LOGIT = 10 * MiB;
constexpr size_t WS_RIDX = 14 * MiB, WS_RW = 14 * MiB + 512 * 1024, WS_RPOS = 15 * MiB, WS_BBASE = 15 * MiB + 512 * 1024;
constexpr size_t WS_STOK = 16 * MiB, WS_SW = 17 * MiB;
constexpr size_t WS_O1 = 18 * MiB;
constexpr size_t WS_WIN = 64 * MiB, WS_WUQ = 104 * MiB, WS_WUKV = 106 * MiB, WS_WR = 108 * MiB, WS_WBR = 109 * MiB, WS_WOUT = 117 * MiB;
constexpr size_t WS_W13 = 125 * MiB, WS_W2 = 385 * MiB;
constexpr size_t WS_XB = 515 * MiB, WS_X1F = 579 * MiB, WS_X1B = 707 * MiB, WS_X2F = 771 * MiB, WS_HID = 899 * MiB;
constexpr size_t WS_BIG = 1059 * MiB;
constexpr size_t WS_P = WS_BIG, WS_QM = WS_P + 320 * MiB, WS_KF = WS_QM + 48 * MiB, WS_VM = WS_KF + 48 * MiB, WS_O = WS_VM + 32 * MiB, WS_YB = WS_O + 64 * MiB;
constexpr size_t WS_X1Q = WS_HID + 80 * MiB;
constexpr size_t WS_XQ = WS_X1Q + 32 * MiB;
constexpr size_t WS_WINQ = WS_WIN + 20 * MiB;
static_assert(WS_XQ + 32 * MiB <= WS_BIG, "ws map");
constexpr size_t WS_YS = WS_BIG;
constexpr size_t WS_END = WS_BIG + 640 * MiB;
static_assert(WS_YB + 64 * MiB <= WS_END && WS_HID + (size_t)SR_ROWS * FF * 2 <= WS_BIG, "ws map");

constexpr int RING_BYTES = 131072;
constexpr int TAB_OFF = RING_BYTES;
constexpr int TAB_BYTES = 24576;
constexpr int MISC_OFF = TAB_OFF + TAB_BYTES;
constexpr int LDS_BYTES = 157696;
static_assert(MISC_OFF + 128 <= LDS_BYTES, "lds map");
constexpr int NWAVES = 8, NTHR = 512;

__device__ __forceinline__ unsigned cvt_pk_bf16(float lo, float hi) { unsigned r; asm volatile("v_cvt_pk_bf16_f32 %0, %1, %2" : "=v"(r) : "v"(lo), "v"(hi)); return r; }
__device__ __forceinline__ float bf2f(unsigned short b) { return __uint_as_float(((unsigned)b) << 16); }
__device__ __forceinline__ float bflo(unsigned w) { return __uint_as_float(w << 16); }
__device__ __forceinline__ float bfhi(unsigned w) { return __uint_as_float(w & 0xffff0000u); }
__device__ __forceinline__ bf16x8 pack8(f32x4 a, f32x4 b) { u32x4 w = {cvt_pk_bf16(a[0], a[1]), cvt_pk_bf16(a[2], a[3]), cvt_pk_bf16(b[0], b[1]), cvt_pk_bf16(b[2], b[3])}; return __builtin_bit_cast(bf16x8, w); }
typedef int v8i32 __attribute__((ext_vector_type(8)));
__device__ __forceinline__ unsigned pk4_fp8(float a, float b, float c, float d) { unsigned w = 0; w = __builtin_amdgcn_cvt_pk_fp8_f32(a, b, w, false); w = __builtin_amdgcn_cvt_pk_fp8_f32(c, d, w, true); return w; }
__device__ __forceinline__ float clamp8(float v) { return __builtin_amdgcn_fmed3f(v, -440.f, 440.f); }
constexpr float W8_SCALE = 64.f, H8_SCALE = 8.f, O8_SCALE = 16.f, Y8_SCALE = 8.f, YS8_SCALE = 16.f;
__device__ __forceinline__ void fp8x4_to_f32(unsigned w, float (&o)[4]) { const f32x2 a = __builtin_amdgcn_cvt_pk_f32_fp8((int)w, false), b = __builtin_amdgcn_cvt_pk_f32_fp8((int)w, true); o[0] = a[0]; o[1] = a[1]; o[2] = b[0]; o[3] = b[1]; }
__device__ __forceinline__ float wave_sum(float v) {
#pragma unroll
    for (int o = 1; o < 64; o <<= 1) v += __shfl_xor(v, o);
    return v;
}
__device__ __forceinline__ float sigmoidf_(float x) { return __builtin_amdgcn_rcpf(1.f + __builtin_amdgcn_exp2f(x * -1.4426950408889634f)); }

#define XB_TMO      128
#define XB_XCNT(j)  (256  + 64 * (j))
#define XB_XSUB(j)  (1280 + 64 * (j))
#define XB_XGEN(j)  (2304 + 64 * (j))
#define XB_TOP      3328
#define XB_TOPGEN   3392
#define XCD_BAR_WORDS 3456
#define XB_SPIN_CAP (1u << 20)
__device__ __forceinline__ unsigned xb_ld(unsigned* p)              { return __hip_atomic_load(p, __ATOMIC_RELAXED, __HIP_MEMORY_SCOPE_AGENT); }
__device__ __forceinline__ unsigned xb_add(unsigned* p, unsigned v) { return __hip_atomic_fetch_add(p, v, __ATOMIC_RELAXED, __HIP_MEMORY_SCOPE_AGENT); }
__device__ __forceinline__ unsigned xb_xcc_id() { return (unsigned)__builtin_amdgcn_s_getreg((3 << 11) | 20) & 0xFu; }
#define XB_SPIN(cond, bar) do { unsigned _sp = 0; while (cond) { __builtin_amdgcn_s_sleep(1); \
    if ((++_sp & 255u) == 0u) { if (xb_ld(&(bar)[XB_TMO])) break; if (_sp > XB_SPIN_CAP) { atomicAdd(&(bar)[XB_TMO], 1u); break; } } } } while (0)
struct XcdBarrier { unsigned* bar; unsigned x; volatile LAS unsigned* st; };
__device__ __forceinline__ XcdBarrier xcd_barrier_post(unsigned* bar, volatile LAS unsigned* st) {
    XcdBarrier b; b.bar = bar; b.x = xb_xcc_id(); b.st = st;
    if (threadIdx.x == 0) (void)xb_add(&bar[XB_XCNT(b.x)], 1u);
    return b;
}
__device__ __forceinline__ void xcd_barrier_complete(unsigned* bar, unsigned x, unsigned& nloc, unsigned& nx) {
    asm volatile("" : "+v"(x));
    const unsigned G = gridDim.x * gridDim.y * gridDim.z;
    unsigned sum, cnt, mine, sp = 0u;
    for (;;) {
        sum = 0u; cnt = 0u; mine = 0u;
#pragma unroll
        for (unsigned j = 0; j < 16; ++j) { const unsigned c = xb_ld(&bar[XB_XCNT(j)]); sum += c; cnt += (c > 0u) ? 1u : 0u; mine = (j == x) ? c : mine; }
        if (sum == G) break;
        __builtin_amdgcn_s_sleep(1);
        if ((++sp & 255u) == 0u) { if (xb_ld(&bar[XB_TMO])) break; if (sp > XB_SPIN_CAP) { atomicAdd(&bar[XB_TMO], 1u); break; } }
    }
    nloc = mine > 0u ? mine : 1u; nx = cnt > 0u ? cnt : 1u;
}
__device__ __forceinline__ void xcd_barrier(const XcdBarrier& b) {
    asm volatile("s_waitcnt vmcnt(0)" ::: "memory");
    __syncthreads();
    if (threadIdx.x == 0) {
        GAS unsigned* barg_ = (GAS unsigned*)b.bar; asm volatile("" : "+v"(barg_)); unsigned* bar = (unsigned*)barg_;
        __builtin_amdgcn_s_waitcnt(0);
        unsigned nloc = b.st[0], nx = b.st[1];
        if (nloc == 0u) { xcd_barrier_complete(bar, b.x, nloc, nx); b.st[0] = nloc; b.st[1] = nx; }
        const unsigned old = xb_add(&bar[XB_XSUB(b.x)], 1u);
        const unsigned gen = old / nloc;
        if (old + 1u == (gen + 1u) * nloc) {
            __builtin_amdgcn_fence(__ATOMIC_RELEASE, "agent");
            asm volatile("s_waitcnt vmcnt(0)" ::: "memory");
            const unsigned og = xb_add(&bar[XB_TOP], 1u);
            const unsigned tg = og / nx;
            if (og + 1u == (tg + 1u) * nx) xb_add(&bar[XB_TOPGEN], 1u);
            else XB_SPIN(xb_ld(&bar[XB_TOPGEN]) == tg, bar);
            __builtin_amdgcn_fence(__ATOMIC_ACQUIRE, "agent");
            xb_add(&bar[XB_XGEN(b.x)], 1u);
            asm volatile("s_waitcnt vmcnt(0)" ::: "memory");
        } else {
            XB_SPIN(xb_ld(&bar[XB_XGEN(b.x)]) == gen, bar);
            __builtin_amdgcn_fence(__ATOMIC_ACQUIRE, "agent");
            asm volatile("s_waitcnt vmcnt(0)" ::: "memory");
        }
    }
    __syncthreads();
}

namespace gm {
constexpr int BM = 256, BK = 64, HALF = 128, HTB = HALF * BK * 2, STAGE_BYTES = 8 * HTB, NXCD = 8, WGM = 8;
__device__ __forceinline__ int lds_byte(int r, int c) { const int st = (r >> 4) * 2 + (c >> 5), rr = r & 15, cc = c & 31, ob = rr * 64 + cc * 2; return st * 1024 + (ob ^ (((ob >> 9) & 1) << 5)); }
__device__ __forceinline__ void stage_rc(int b, int& R, int& C) { const int st = b / 1024, sb = b % 1024, swz = sb ^ (((sb >> 9) & 1) << 5); R = (st >> 1) * 16 + swz / 64; C = (st & 1) * 32 + (swz % 64) / 2; }
__device__ __forceinline__ int perm32(int rho) { const int n = rho >> 4, i = rho & 15; return 8 * (i >> 2) + 4 * n + (i & 3); }
struct Unit { int pm, pn; };
struct StaticOrder {
    int nM, nN, nwg, G, c;
    __device__ void init(int M, int N, int G_, int c_) { nM = M / BM; nN = N / BM; nwg = nM * nN; G = G_; c = c_; }
    __device__ bool next(int i, Unit& u) const {
        const long L = (long)i * G + c; if (L >= nwg) return false;
        int wgid = (int)L; { const int q = nwg / NXCD, r = nwg % NXCD, xcd = wgid % NXCD, off = wgid / NXCD; wgid = (xcd < r ? xcd * (q + 1) : r * (q + 1) + (xcd - r) * q) + off; }
        const int nig = WGM * nN, gid = wgid / nig, fm = gid * WGM, gsz = (nM - fm) < WGM ? (nM - fm) : WGM;
        u.pm = fm + ((wgid % nig) % gsz); u.pn = (wgid % nig) / gsz; return true;
    }
};
struct GUnit { const char* A; const char* B; int nt; int pm; int pn; int aux; int idx; };

template <class Epi, class Sched, bool GATHER, bool ALIGN_EPI, bool F8 = false>
__device__ __forceinline__ void gemm_phase(LAS unsigned char* lds, const unsigned lda, const unsigned ldb, const Sched& S, const Epi& E) {
    int tid_ = threadIdx.x; asm volatile("" : "+v"(tid_));
    const int tid = tid_, wid = __builtin_amdgcn_readfirstlane(tid >> 6), lane = tid & 63, wr = wid >> 2, wc = wid & 3, fr = lane & 15, fq = lane >> 4;
    unsigned voffA[2], voffB[2], colA[2]; int RA[2];
#pragma unroll
    for (int i = 0; i < 2; ++i) { int R, C; stage_rc(tid * 16 + i * 8192, R, C); const int Rb = (R & ~31) + perm32(R & 31);
        RA[i] = R; colA[i] = (unsigned)C * 2u; voffA[i] = (unsigned)R * lda + (unsigned)C * 2u; voffB[i] = (unsigned)(Epi::COL16 ? (16 * (Rb >> 3) + (Rb & 7)) : Rb) * ldb + (unsigned)C * 2u; }
    const size_t kstep = (size_t)(BK * 2);
    const size_t hA = GATHER ? 0 : (size_t)HALF * lda, hB = (size_t)(Epi::COL16 ? 8 : HALF) * ldb;
    const unsigned ldsw = (unsigned)wid * 1024u;
    const int aoff = lds_byte(wr * 64 + fr, fq * 8), boff = lds_byte(wc * 32 + fr, fq * 8);
    unsigned gcur[2][2];
#define GM_SA(b, h) (((b) * 2 + (h)) * HTB)
#define GM_SB(b, h) ((4 + (b) * 2 + (h)) * HTB)
#define GM_STAGE_B(bufoff, gbase) do { _Pragma("unroll") for (int _i = 0; _i < 2; ++_i) \
        __builtin_amdgcn_global_load_lds((const unsigned*)((const char*)(gbase) + voffB[_i]), (LAS unsigned*)(lds + (bufoff) + ldsw + _i * 8192), 16, 0, 0); } while (0)
#define GM_STAGE_A(bufoff, gbase, h, nx) do { _Pragma("unroll") for (int _i = 0; _i < 2; ++_i) { \
        unsigned _vo = GATHER ? gcur[h][_i] : voffA[_i]; if (GATHER && (nx) && has_next) _vo = S.rowoff(ui + 1, (h) * HALF + RA[_i]) * lda + colA[_i]; \
        __builtin_amdgcn_global_load_lds((const unsigned*)((const char*)(gbase) + (size_t)(h) * hA + _vo), (LAS unsigned*)(lds + (bufoff) + ldsw + _i * 8192), 16, 0, 0); } } while (0)
#define GM_LD8(p_) ({ const u32x4 lo_ = *(const LAS u32x4*)(p_), hi_ = *(const LAS u32x4*)((p_) + 1024); (v8i32){(int)lo_.x, (int)lo_.y, (int)lo_.z, (int)lo_.w, (int)hi_.x, (int)hi_.y, (int)hi_.z, (int)hi_.w}; })
#define GM_LDA(dst, b, h) do { if constexpr (F8) { _Pragma("unroll") for (int m = 0; m < 4; ++m) dst##8[m] = GM_LD8(lds + GM_SA(b, h) + aoff + m * 2048); } \
        else { _Pragma("unroll") for (int m = 0; m < 4; ++m) _Pragma("unroll") for (int k = 0; k < 2; ++k) dst[m][k] = *(const LAS bf16x8*)(lds + GM_SA(b, h) + aoff + m * 2048 + k * 1024); } } while (0)
#define GM_LDB(dst, b, h) do { if constexpr (F8) { _Pragma("unroll") for (int n = 0; n < 2; ++n) dst##8[n] = GM_LD8(lds + GM_SB(b, h) + boff + n * 2048); } \
        else { _Pragma("unroll") for (int n = 0; n < 2; ++n) _Pragma("unroll") for (int k = 0; k < 2; ++k) dst[n][k] = *(const LAS bf16x8*)(lds + GM_SB(b, h) + boff + n * 2048 + k * 1024); } } while (0)
#define GM_MMA(ai, bj, At, Bt) do { __builtin_amdgcn_s_setprio(1); _Pragma("unroll") for (int m = 0; m < 4; ++m) _Pragma("unroll") for (int n = 0; n < 2; ++n) { \
        if constexpr (F8) { asm volatile("v_mfma_scale_f32_16x16x128_f8f6f4 %0, %1, %2, %0, %3, %4 op_sel_hi:[0,0,0]" : "+v"(acc[ai][bj][m][n]) : "v"(Bt##8[n]), "v"(At##8[m]), "v"(sc_w), "v"(sc_one)); }   \
        else { _Pragma("unroll") for (int k = 0; k < 2; ++k) acc[ai][bj][m][n] = __builtin_amdgcn_mfma_f32_16x16x32_bf16(Bt[n][k], At[m][k], acc[ai][bj][m][n], 0, 0, 0); } } \
        __builtin_amdgcn_s_setprio(0); } while (0)
#define GM_WAIT_V(n) asm volatile("s_waitcnt vmcnt(" #n ")" ::: "memory")
#define GM_WAIT_L(n) asm volatile("s_waitcnt lgkmcnt(" #n ")" ::: "memory")
#define GM_BAR __builtin_amdgcn_s_barrier()
#define GM_SCHED __builtin_amdgcn_sched_barrier(0)
    GUnit cur, nxt; int ui = 0;
    if (!S.next(0, cur)) return;
    if constexpr (GATHER) {
#pragma unroll
        for (int h = 0; h < 2; ++h)
#pragma unroll
            for (int i = 0; i < 2; ++i) gcur[h][i] = S.rowoff(0, h * HALF + RA[i]) * lda + colA[i];
    }
    f32x4 acc[2][2][4][2];
#pragma unroll
    for (int a = 0; a < 2; ++a)
#pragma unroll
        for (int b = 0; b < 2; ++b)
#pragma unroll
            for (int m = 0; m < 4; ++m)
#pragma unroll
                for (int n = 0; n < 2; ++n) acc[a][b][m][n] = (f32x4){0.f, 0.f, 0.f, 0.f};
    int sc_one = 0x7f7f7f7f, sc_w = 0x01010101 * (127 - Epi::BSH); if constexpr (F8) { asm volatile("" : "+v"(sc_one)); asm volatile("" : "+v"(sc_w)); }
    bf16x8 At[4][2], B0[2][2], B1[2][2]; v8i32 At8[4], B08[2], B18[2];
    const char* cA = cur.A; const char* cB = cur.B;
    {
    const bool has_next = false;
    GM_STAGE_B(GM_SB(0, 0), cB); GM_STAGE_B(GM_SB(0, 1), cB + hB); GM_STAGE_A(GM_SA(0, 0), cA, 0, false); GM_STAGE_A(GM_SA(0, 1), cA, 1, false);
    if (wr == 1) GM_BAR;
    GM_WAIT_V(2); GM_BAR;
    GM_STAGE_B(GM_SB(1, 0), cB + kstep); GM_STAGE_A(GM_SA(1, 0), cA + kstep, 0, false); GM_STAGE_B(GM_SB(1, 1), cB + hB + kstep);
    GM_WAIT_V(6); GM_BAR;
    }
    for (;;) {
        const bool has_next = S.next(ui + 1, nxt);
        const char* nA = has_next ? nxt.A : cA; const char* nB = has_next ? nxt.B : cB;
        const int nt = cur.nt;
#pragma nounroll
        for (int t = 0; t < nt; t += 2) {
            const bool last = (t == nt - 2);
            const char* a1 = cA + (size_t)(t + 1) * kstep;
            const char* a2 = last ? nA : cA + (size_t)(t + 2) * kstep; const char* b2 = last ? nB : cB + (size_t)(t + 2) * kstep;
            const char* a3 = a2 + kstep; const char* b3 = b2 + kstep;
            GM_LDB(B0, 0, 0); GM_LDB(B1, 0, 1); GM_SCHED; GM_LDA(At, 0, 0); GM_STAGE_A(GM_SA(1, 1), a1, 1, false);
            GM_WAIT_V(8); GM_WAIT_L(0); GM_BAR; GM_MMA(0, 0, At, B0); GM_MMA(0, 1, At, B1); GM_BAR; GM_SCHED;
            GM_LDA(At, 0, 1); GM_STAGE_B(GM_SB(0, 0), b2); GM_STAGE_B(GM_SB(0, 1), b2 + hB); GM_STAGE_A(GM_SA(0, 0), a2, 0, last);
            GM_WAIT_V(8); GM_WAIT_L(0); GM_BAR; GM_MMA(1, 0, At, B0); GM_MMA(1, 1, At, B1); GM_BAR; GM_SCHED;
            GM_LDB(B0, 1, 0); GM_LDB(B1, 1, 1); GM_SCHED; GM_LDA(At, 1, 0); GM_STAGE_A(GM_SA(0, 1), a2, 1, last);
            GM_WAIT_V(8); GM_WAIT_L(0); GM_BAR; GM_MMA(0, 0, At, B0); GM_MMA(0, 1, At, B1); GM_BAR; GM_SCHED;
            GM_LDA(At, 1, 1); GM_STAGE_B(GM_SB(1, 0), b3); GM_STAGE_B(GM_SB(1, 1), b3 + hB); GM_STAGE_A(GM_SA(1, 0), a3, 0, last);
            GM_WAIT_V(8); GM_WAIT_L(0); GM_BAR; GM_MMA(1, 0, At, B0); GM_MMA(1, 1, At, B1); GM_BAR; GM_SCHED;
        }
        if constexpr (ALIGN_EPI) { if (wr == 0) GM_BAR; }
        if constexpr (F8) asm volatile("s_nop 15\n\ts_nop 15" ::: "memory");
        E(acc, cur, wr, wc, fr, fq);
        if (!has_next) break;
#pragma unroll
        for (int a = 0; a < 2; ++a)
#pragma unroll
            for (int b = 0; b < 2; ++b)
#pragma unroll
                for (int m = 0; m < 4; ++m)
#pragma unroll
                    for (int n = 0; n < 2; ++n) acc[a][b][m][n] = (f32x4){0.f, 0.f, 0.f, 0.f};
        cur = nxt; cA = nA; cB = nB; ++ui;
        if constexpr (GATHER) {
#pragma unroll
            for (int h = 0; h < 2; ++h)
#pragma unroll
                for (int i = 0; i < 2; ++i) gcur[h][i] = S.rowoff(ui, h * HALF + RA[i]) * lda + colA[i];
        }
        if constexpr (ALIGN_EPI) { if (wr == 1) GM_BAR; }
    }
    GM_WAIT_V(0);
    if constexpr (!ALIGN_EPI) { if (wr == 0) GM_BAR; }
    GM_BAR;
#undef GM_SA
#undef GM_SB
#undef GM_STAGE_A
#undef GM_STAGE_B
#undef GM_LDA
#undef GM_LDB
#undef GM_MMA
#undef GM_LD8
#undef GM_WAIT_V
#undef GM_WAIT_L
#undef GM_BAR
#undef GM_SCHED
}
}
using gm::GUnit;
typedef f32x4 AccT[2][2][4][2];

struct Args { const float* in[26]; float* out; unsigned char* ws; float invf[NRT]; int ph_lo, ph_hi; };
typedef const __attribute__((address_space(4))) Args ArgsK;
template <class Tp> __device__ __forceinline__ Tp* gptr(Tp* p) { return (Tp*)(GAS Tp*)p; }
struct Ctx {
    LAS unsigned char* lds; int tid, lane, wave, G, bid;
    unsigned char* ws;
    float* out;
};

struct DenseSched {
    gm::StaticOrder so; const char* A; const char* B; unsigned lda, ldb; int nt;
    __device__ __forceinline__ bool next(int i, GUnit& u) const { gm::Unit t; if (!so.next(i, t)) return false; u.pm = t.pm; u.pn = t.pn; u.aux = 0;
        u.A = A + (size_t)t.pm * 256 * lda; u.B = B + (size_t)t.pn * 256 * ldb; u.nt = nt; return true; }
    __device__ __forceinline__ unsigned rowoff(int, int) const { return 0; }
};
struct BranchSched {
    gm::StaticOrder so; const char* A; const char* B;
    __device__ __forceinline__ bool next(int j, GUnit& u) const { const int jt = j / 3, br = j - 3 * jt; gm::Unit t; if (!so.next(jt, t)) return false;
        const int koff = br == 0 ? 0 : (br == 1 ? 512 : 1536); u.pm = t.pm; u.pn = t.pn; u.aux = br; u.nt = br == 1 ? 8 : 4;
        u.A = A + (size_t)t.pm * 256 * 2048 + koff; u.B = B + (size_t)t.pn * 256 * 2048 + koff; return true; }
    __device__ __forceinline__ unsigned rowoff(int, int) const { return 0; }
};
struct UpSched {
    const char* P; const char* Wq; const char* Wkv; int G, c;
    __device__ __forceinline__ bool next(int i, GUnit& u) const {
        int L;
        if (G == 256) { if (c < 128) { if (i > 2) return false; L = i == 0 ? c : (i == 1 ? 128 + c : 384 + c); }
                        else { if (i > 3) return false; const int d = c - 128; L = i == 0 ? 256 + d : 384 + 128 * i + d; } }
        else { L = i * G + c; if (L >= 896) return false; }
        if (L < 384) { u.pm = L / 6; u.pn = L % 6; u.aux = 0; u.nt = 8; u.A = P + (size_t)u.pm * 256 * (PC * 2) + C_CQ * 2; u.B = Wq + (size_t)u.pn * 256 * 1024; }
        else { const int v = L - 384; u.pm = v / 8; u.pn = v % 8; u.aux = 1; u.nt = 4; u.A = P + (size_t)u.pm * 256 * (PC * 2) + C_CKV * 2; u.B = Wkv + (size_t)u.pn * 256 * 1024; }
        return true; }
    __device__ __forceinline__ unsigned rowoff(int, int) const { return 0; }
};
struct RouterSched {
    const char* X; const char* W; int G, c;
    __device__ __forceinline__ bool next(int i, GUnit& u) const { const int L = i * G + c; if (L >= 256) return false;
        u.pm = L >> 2; u.pn = 0; u.aux = L & 3; u.nt = 8; u.A = X + (size_t)u.pm * 256 * 4096 + (size_t)u.aux * 1024; u.B = W + (size_t)u.aux * 1024; return true; }
    __device__ __forceinline__ unsigned rowoff(int, int) const { return 0; }
};
__device__ __forceinline__ int xcd_chunk_unit(int i, int c, int G, int U) {
    if (G % 8 != 0) { const int L = i * G + c; return L < U ? L : -1; }
    const int per = G / 8, x = c % 8, j = c / 8, q = (U + 7) / 8, lo = x * q, hi = (lo + q < U) ? lo + q : U;
    const int L = lo + i * per + j; return L < hi ? L : -1;
}
constexpr int TAB_TILEE = 0, TAB_MISC = 704 * 4, TAB_IDX = 704 * 4 + 64, TAB_SW = TAB_IDX + 10 * 256 * 4;
struct Moe1Sched {
    LAS unsigned char* tab; const char* X; const char* W13; int G, c;
    __device__ __forceinline__ bool next(int i, GUnit& u) const { const LAS int* misc = (const LAS int*)(tab + TAB_MISC); const int nrt = misc[0], ntl = misc[1];
        const int L = xcd_chunk_unit(i, c, G, ntl * 4); if (L < 0 || i >= 10) return false; const int tile = L >> 2, pn = L & 3; const int e = ((const LAS int*)(tab + TAB_TILEE))[tile];
        u.pm = tile < nrt ? tile * 256 : RT_ROWS + (tile - nrt) * 256; u.pn = pn; u.aux = e; u.idx = i; u.nt = 16; u.A = X; u.B = W13 + (size_t)e * (2 * MiB) + (size_t)pn * 256 * 2048; return true; }
    __device__ __forceinline__ unsigned rowoff(int ui, int r) const { return ((const LAS unsigned*)(tab + TAB_IDX))[ui * 256 + r]; }
};
struct Moe2Sched {
    LAS unsigned char* tab; const char* H; const char* W2; int G, c;
    __device__ __forceinline__ bool next(int i, GUnit& u) const { const LAS int* misc = (const LAS int*)(tab + TAB_MISC); const int nrt = misc[0], ntl = misc[1];
        const int L = xcd_chunk_unit(i, c, G, ntl * 8); if (L < 0) return false; const int tile = L >> 3, pn = L & 7; const int e = ((const LAS int*)(tab + TAB_TILEE))[tile];
        u.pm = tile < nrt ? tile * 256 : RT_ROWS + (tile - nrt) * 256; u.pn = pn; u.aux = e; u.nt = 8; u.nt = 4; u.A = H + (size_t)u.pm * 512; u.B = W2 + (size_t)e * (1 * MiB) + (size_t)pn * 256 * 512; return true; }
    __device__ __forceinline__ unsigned rowoff(int, int) const { return 0; }
};

__device__ __forceinline__ u32x4 pk8(f32x4 v0, f32x4 v1) { u32x4 w; w.x = cvt_pk_bf16(v0[0], v0[1]); w.y = cvt_pk_bf16(v0[2], v0[3]); w.z = cvt_pk_bf16(v1[0], v1[1]); w.w = cvt_pk_bf16(v1[2], v1[3]); return w; }
struct EpiInProj {
    static constexpr bool COL16 = true;
    static constexpr int BSH = 6;
    bf16_t* P; float* rsq_q; float* rsq_kv;
    __device__ __forceinline__ void operator()(const AccT& acc, const GUnit& u, int wr, int wc, int fr, int fq) const {
        const int row0 = u.pm * 256 + wr * 64 + fr, col0 = u.pn * 256 + wc * 64 + 16 * fq;
        const bool sig = (u.pn >= 15 && u.pn < 39); const int sq = (u.pn == 6 || u.pn == 7) ? 1 : (u.pn == 8 ? 2 : 0);
        bf16_t* rowp0 = P + (size_t)row0 * PC + col0;
        if (sig) {
#pragma unroll
            for (int ai = 0; ai < 2; ++ai)
#pragma unroll
                for (int m = 0; m < 4; ++m) { bf16_t* rowp = rowp0 + (size_t)(ai * 128 + m * 16) * PC;
#pragma unroll
                    for (int bj = 0; bj < 2; ++bj) { const f32x4 v0 = acc[ai][bj][m][0], v1 = acc[ai][bj][m][1]; u32x4 w;
                        w.x = __builtin_bit_cast(unsigned, __builtin_amdgcn_cvt_pkrtz(sigmoidf_(v0[0]), sigmoidf_(v0[1]))); w.y = __builtin_bit_cast(unsigned, __builtin_amdgcn_cvt_pkrtz(sigmoidf_(v0[2]), sigmoidf_(v0[3])));
                        w.z = __builtin_bit_cast(unsigned, __builtin_amdgcn_cvt_pkrtz(sigmoidf_(v1[0]), sigmoidf_(v1[1]))); w.w = __builtin_bit_cast(unsigned, __builtin_amdgcn_cvt_pkrtz(sigmoidf_(v1[2]), sigmoidf_(v1[3])));
                        *(u32x4*)(rowp + bj * 8) = w; } }
        } else {
#pragma unroll
            for (int ai = 0; ai < 2; ++ai)
#pragma unroll
                for (int m = 0; m < 4; ++m) { const int row = row0 + ai * 128 + m * 16; bf16_t* rowp = rowp0 + (size_t)(ai * 128 + m * 16) * PC;
#pragma unroll
                    for (int bj = 0; bj < 2; ++bj) *(u32x4*)(rowp + bj * 8) = pk8(acc[ai][bj][m][0], acc[ai][bj][m][1]);
                    if (sq) { float ss = 0.f;
#pragma unroll
                        for (int bj = 0; bj < 2; ++bj) { const f32x4 v0 = acc[ai][bj][m][0], v1 = acc[ai][bj][m][1];
                            ss += (v0[0] * v0[0] + v0[1] * v0[1]) + (v0[2] * v0[2] + v0[3] * v0[3]) + (v1[0] * v1[0] + v1[1] * v1[1]) + (v1[2] * v1[2] + v1[3] * v1[3]); }
                        ss += __shfl_xor(ss, 16); ss += __shfl_xor(ss, 32); if (fq == 0) { if (sq == 1) rsq_q[row * 8 + (u.pn - 6) * 4 + wc] = ss; else rsq_kv[row * 4 + wc] = ss; } } }
        }
    }
};
struct EpiUp {
    static constexpr bool COL16 = false;
    static constexpr int BSH = 0;
    bf16_t* Qm; bf16_t* Kf; bf16_t* Vm; const float* rsq_q; const float* rsq_kv;
    __device__ __forceinline__ void operator()(const AccT& acc, const GUnit& u, int wr, int wc, int fr, int fq) const {
        const int row0 = u.pm * 256 + wr * 64 + fr, cw = wc * 32 + 8 * fq; const bool kv = u.aux != 0;
#pragma unroll
        for (int ai = 0; ai < 2; ++ai)
#pragma unroll
            for (int m = 0; m < 4; ++m) { const int row = row0 + ai * 128 + m * 16;
                float rs; if (kv) { const f32x4 p = *(const f32x4*)(rsq_kv + row * 4); rs = rsqrtf(((p[0] + p[1]) + (p[2] + p[3])) * (1.f / 256.f) + NORM_EPS); }
                else { const f32x4 p = *(const f32x4*)(rsq_q + row * 8), q = *(const f32x4*)(rsq_q + row * 8 + 4); rs = rsqrtf((((p[0] + p[1]) + (p[2] + p[3])) + ((q[0] + q[1]) + (q[2] + q[3]))) * (1.f / 512.f) + NORM_EPS); }
#pragma unroll
                for (int bj = 0; bj < 2; ++bj) { const f32x4 v0 = acc[ai][bj][m][0] * rs, v1 = acc[ai][bj][m][1] * rs;
                    bf16_t* dst = kv ? (bj == 0 ? Kf + (size_t)row * 1536 + u.pn * 192 + cw : Vm + (size_t)row * 1024 + u.pn * 128 + cw) : Qm + (size_t)row * 1536 + u.pn * 256 + bj * 128 + cw;
                    *(u32x4*)dst = pk8(v0, v1); } }
    }
};
typedef _Float16 h16x8 __attribute__((ext_vector_type(8)));
struct EpiBranch {
    static constexpr bool COL16 = true;
    static constexpr int BSH = 10;
    bf16_t* YB; unsigned char* YQ; const bf16_t* P;
    __device__ __forceinline__ void operator()(const AccT& acc, const GUnit& u, int wr, int wc, int fr, int fq) const {
        const int row0 = u.pm * 256 + wr * 64 + fr, col0 = u.pn * 256 + wc * 64 + 16 * fq; const int br = u.aux;
        const bf16_t* gp = P + (size_t)row0 * PC + C_G + br * 2048 + col0; bf16_t* yp = YB + (size_t)row0 * 2048 + col0; unsigned char* qp = YQ + (size_t)row0 * 2048 + col0;
#pragma unroll
        for (int ai = 0; ai < 2; ++ai) { h16x8 gg[4][2], yy[4][2];
#pragma unroll
            for (int m = 0; m < 4; ++m)
#pragma unroll
                for (int bj = 0; bj < 2; ++bj) { const int ro = ai * 128 + m * 16;
                    gg[m][bj] = *(const h16x8*)(gp + (size_t)ro * PC + bj * 8);
                    yy[m][bj] = br != 0 ? *(const h16x8*)(yp + (size_t)ro * 2048 + bj * 8) : (h16x8){0, 0, 0, 0, 0, 0, 0, 0}; }
#pragma unroll
            for (int m = 0; m < 4; ++m)
#pragma unroll
                for (int bj = 0; bj < 2; ++bj) { const int ro = ai * 128 + m * 16; const h16x8 g = gg[m][bj], y = yy[m][bj]; float v[8];
#pragma unroll
                    for (int j = 0; j < 8; ++j) v[j] = acc[ai][bj][m][j >> 2][j & 3] * (float)g[j] + (float)y[j];
                    if (br == 2) { u32x2 q; q.x = pk4_fp8(clamp8(v[0] * Y8_SCALE), clamp8(v[1] * Y8_SCALE), clamp8(v[2] * Y8_SCALE), clamp8(v[3] * Y8_SCALE));
                        q.y = pk4_fp8(clamp8(v[4] * Y8_SCALE), clamp8(v[5] * Y8_SCALE), clamp8(v[6] * Y8_SCALE), clamp8(v[7] * Y8_SCALE)); *(u32x2*)(qp + (size_t)ro * 2048 + bj * 8) = q; }
                    else { u32x4 w; w.x = __builtin_bit_cast(unsigned, __builtin_amdgcn_cvt_pkrtz(v[0], v[1])); w.y = __builtin_bit_cast(unsigned, __builtin_amdgcn_cvt_pkrtz(v[2], v[3]));
                        w.z = __builtin_bit_cast(unsigned, __builtin_amdgcn_cvt_pkrtz(v[4], v[5])); w.w = __builtin_bit_cast(unsigned, __builtin_amdgcn_cvt_pkrtz(v[6], v[7])); *(u32x4*)(yp + (size_t)ro * 2048 + bj * 8) = w; } } }
    }
};
struct EpiOut {
    static constexpr bool COL16 = true;
    static constexpr int BSH = 9;
    bf16_t* Z; const bf16_t* xres;
    __device__ __forceinline__ void operator()(const AccT& acc, const GUnit& u, int wr, int wc, int fr, int fq) const {
        const int row0 = u.pm * 256 + wr * 64 + fr, col0 = u.pn * 256 + wc * 64 + 16 * fq;
#pragma unroll
        for (int ai = 0; ai < 2; ++ai) { u32x4 xr[4][2];
#pragma unroll
            for (int m = 0; m < 4; ++m)
#pragma unroll
                for (int bj = 0; bj < 2; ++bj) xr[m][bj] = *(const u32x4*)(xres + (size_t)(row0 + ai * 128 + m * 16) * 2048 + col0 + bj * 8);
#pragma unroll
            for (int m = 0; m < 4; ++m) { const size_t ro = (size_t)(row0 + ai * 128 + m * 16) * 2048 + col0;
#pragma unroll
                for (int bj = 0; bj < 2; ++bj) { const u32x4 x = xr[m][bj]; f32x4 v0 = acc[ai][bj][m][0], v1 = acc[ai][bj][m][1];
                    v0[0] += DN_ALPHA * bflo(x.x); v0[1] += DN_ALPHA * bfhi(x.x); v0[2] += DN_ALPHA * bflo(x.y); v0[3] += DN_ALPHA * bfhi(x.y);
                    v1[0] += DN_ALPHA * bflo(x.z); v1[1] += DN_ALPHA * bfhi(x.z); v1[2] += DN_ALPHA * bflo(x.w); v1[3] += DN_ALPHA * bfhi(x.w);
                    *(u32x4*)(Z + ro + bj * 8) = pk8(v0, v1); } } }
    }
};
struct EpiLogit {
    static constexpr bool COL16 = false;
    static constexpr int BSH = 0;
    float* L;
    __device__ __forceinline__ void operator()(const AccT& acc, const GUnit& u, int wr, int wc, int fr, int fq) const {
        if (wc >= 2) return; const int row0 = u.pm * 256 + wr * 64 + fr, col0 = wc * 32 + 8 * fq;
#pragma unroll
        for (int ai = 0; ai < 2; ++ai)
#pragma unroll
            for (int m = 0; m < 4; ++m) { float* d = L + (size_t)u.aux * T * 64 + (size_t)(row0 + ai * 128 + m * 16) * 64 + col0; *(f32x4*)d = acc[ai][0][m][0]; *(f32x4*)(d + 4) = acc[ai][0][m][1]; }
    }
};
struct EpiMoe1 {
    static constexpr bool COL16 = false;
    static constexpr int BSH = 6;
    unsigned char* H; const LAS float* sw;
    __device__ __forceinline__ void operator()(const AccT& acc, const GUnit& u, int wr, int wc, int fr, int fq) const {
        const int row0 = u.pm + wr * 64 + fr, col0 = u.pn * 128 + wc * 32 + 8 * fq; const LAS float* swu = sw + u.idx * 256 + wr * 64 + fr;
        float w8[2][4];
#pragma unroll
        for (int ai = 0; ai < 2; ++ai)
#pragma unroll
            for (int m = 0; m < 4; ++m) w8[ai][m] = swu[ai * 128 + m * 16];
#pragma unroll
        for (int ai = 0; ai < 2; ++ai)
#pragma unroll
            for (int m = 0; m < 4; ++m) { const int srow = row0 + ai * 128 + m * 16; const float w = w8[ai][m] * H8_SCALE;
                float h0[4], h1[4];
#pragma unroll
                for (int j = 0; j < 4; ++j) { const float g0 = acc[ai][0][m][0][j], g1 = acc[ai][0][m][1][j];
                    h0[j] = clamp8(g0 * sigmoidf_(g0) * acc[ai][1][m][0][j] * w); h1[j] = clamp8(g1 * sigmoidf_(g1) * acc[ai][1][m][1][j] * w); }
                u32x2 o; o.x = pk4_fp8(h0[0], h0[1], h0[2], h0[3]); o.y = pk4_fp8(h1[0], h1[1], h1[2], h1[3]);
                *(u32x2*)(H + (size_t)srow * FF + col0) = o; }
    }
};
struct EpiMoe2 {
    static constexpr bool COL16 = true;
    static constexpr int BSH = 5;
    unsigned char* Y;
    __device__ __forceinline__ void operator()(const AccT& acc, const GUnit& u, int wr, int wc, int fr, int fq) const {
        const int row0 = u.pm + wr * 64 + fr, col0 = u.pn * 256 + wc * 64 + 16 * fq;
#pragma unroll
        for (int ai = 0; ai < 2; ++ai)
#pragma unroll
            for (int m = 0; m < 4; ++m) { u32x4 q;
                q.x = pk4_fp8(acc[ai][0][m][0][0], acc[ai][0][m][0][1], acc[ai][0][m][0][2], acc[ai][0][m][0][3]); q.y = pk4_fp8(acc[ai][0][m][1][0], acc[ai][0][m][1][1], acc[ai][0][m][1][2], acc[ai][0][m][1][3]);
                q.z = pk4_fp8(acc[ai][1][m][0][0], acc[ai][1][m][0][1], acc[ai][1][m][0][2], acc[ai][1][m][0][3]); q.w = pk4_fp8(acc[ai][1][m][1][0], acc[ai][1][m][1][1], acc[ai][1][m][1][2], acc[ai][1][m][1][3]);
                *(u32x4*)(Y + (size_t)(row0 + ai * 128 + m * 16) * 2048 + col0) = q; }
    }
};

struct CvtJob { const float* src; int pitch; int K; int N; const float* kscale; bf16_t* dst; int dpitch; int grp; int gstride; int rbase; size_t sbs; size_t dbs; int nbatch; int f8; };
template <int NT> __device__ __forceinline__ void cvt_job_t(const Ctx& C, const CvtJob& J, int& rot) {
    LAS float* scr = (LAS float*)C.lds;
    constexpr int TPR = NT / 4, RPP = 512 / TPR, NP = 128 / RPP, PT = NT + 1, NQ = NT * 16 / 512;
    const int nkb = J.K / 128, nnb = J.N / NT, per = nkb * nnb, total = per * J.nbatch;
    int start = C.bid - rot; if (start < 0) start += C.G;
    const int rr = C.tid / TPR, c4 = (C.tid % TPR) * 4;
    f32x4 v[NP], w[NP];
#define CVT_LOAD(dst, it_) do { const int e_ = (it_) / per, r_ = (it_) - e_ * per, kb_ = r_ / nnb, nb_ = r_ - kb_ * nnb; \
        const float* s_ = J.src + (size_t)e_ * J.sbs + (size_t)(kb_ * 128) * J.pitch + nb_ * NT; \
        _Pragma("unroll") for (int p = 0; p < NP; ++p) { const int k = p * RPP + rr; dst[p] = __builtin_nontemporal_load((const f32x4*)(s_ + (size_t)k * J.pitch + c4)); if (J.kscale)     dst[p] = dst[p] * J.kscale[kb_ * 128 + k]; } } while (0)
    if (start < total) CVT_LOAD(v, start);
    if (start + C.G < total) CVT_LOAD(w, start + C.G);
    for (int it = start; it < total; it += C.G) {
        const int e = it / per, r = it - e * per, kb = r / nnb, nb = r - kb * nnb;
#pragma unroll
        for (int p = 0; p < NP; ++p) { const int k = p * RPP + rr; scr[k * PT + c4 + 0] = v[p][0]; scr[k * PT + c4 + 1] = v[p][1]; scr[k * PT + c4 + 2] = v[p][2]; scr[k * PT + c4 + 3] = v[p][3]; }
        __syncthreads();
#pragma unroll
        for (int p = 0; p < NP; ++p) v[p] = w[p];
        if (it + 2 * C.G < total) CVT_LOAD(w, it + 2 * C.G);
        const int j0 = nb * NT; const int drow0 = (j0 / J.grp) * J.gstride + (j0 % J.grp) + J.rbase;
        if (J.f8) { unsigned char* d8 = (unsigned char*)J.dst + (size_t)e * J.dbs + (size_t)drow0 * J.dpitch + kb * 128;
#pragma unroll
            for (int q = 0; q < NQ; ++q) { const int ch = (C.tid & 7) | ((q & 1) << 3), n = (C.tid >> 3) + 64 * (q >> 1); const LAS float* sp = scr + (8 * ch) * PT + n;
                u32x2 o; o.x = pk4_fp8(sp[0] * W8_SCALE, sp[PT] * W8_SCALE, sp[2 * PT] * W8_SCALE, sp[3 * PT] * W8_SCALE); o.y = pk4_fp8(sp[4 * PT] * W8_SCALE, sp[5 * PT] * W8_SCALE, sp[6 * PT] * W8_SCALE, sp[7 * PT] * W8_SCALE);
                *(u32x2*)(d8 + (size_t)n * J.dpitch + 8 * ch) = o; }
        } else {
        bf16_t* d = J.dst + (size_t)e * J.dbs + (size_t)drow0 * J.dpitch + kb * 128;
#pragma unroll
        for (int q = 0; q < NQ; ++q) { const int ch = (C.tid & 7) | ((q & 1) << 3), n = (C.tid >> 3) + 64 * (q >> 1); const LAS float* sp = scr + (8 * ch) * PT + n;
            u32x4 o; o.x = cvt_pk_bf16(sp[0], sp[PT]); o.y = cvt_pk_bf16(sp[2 * PT], sp[3 * PT]); o.z = cvt_pk_bf16(sp[4 * PT], sp[5 * PT]); o.w = cvt_pk_bf16(sp[6 * PT], sp[7 * PT]);
            *(u32x4*)(d + (size_t)n * J.dpitch + 8 * ch) = o; }
        }
        __syncthreads();
    }
#undef CVT_LOAD
    rot = (rot + total) % C.G;
}
__device__ __forceinline__ void cvt_job(const Ctx& C, const CvtJob& J, int& rot) { if (J.N % 128 == 0) cvt_job_t<128>(C, J, rot); else cvt_job_t<64>(C, J, rot); }
__device__ __forceinline__ void zero_fill16(const Ctx& C, void* p, size_t bytes) {
    u32x4* q = (u32x4*)p; const size_t n = bytes / 16;
    unsigned z_; asm volatile("v_mov_b32 %0, 0" : "=v"(z_));
    for (size_t i = (size_t)C.bid * NTHR + C.tid; i < n; i += (size_t)C.G * NTHR) q[i] = (u32x4){z_, z_, z_, z_};
}
__device__ __forceinline__ void phase_convert(const Ctx& C, ArgsK* A, int l) {
    const __attribute__((address_space(4))) float* invf = A->invf;
    unsigned char* ws = C.ws; int rot = 0;
    if (C.bid == 0 && C.tid < 64) ((unsigned*)(ws + WS_CTL))[CW_ECNT + l * 64 + C.tid] = 0u;
    const float* w_in = gptr(A->in[2]) + (size_t)l * DM * IN_COLS;
    bf16_t* WinT = (bf16_t*)(ws + WS_WIN);
    const int BIG = 1 << 30;
    { CvtJob J{w_in, IN_COLS, DM, 2304, nullptr, WinT, DM, BIG, 0, 0, 0, 0, 1, 1}; cvt_job(C, J, rot); }
    { CvtJob J{w_in + 2368, IN_COLS, DM, 7680, nullptr, WinT, DM, BIG, 0, 2304, 0, 0, 1, 1}; cvt_job(C, J, rot); }
    { CvtJob J{w_in + 2304, IN_COLS, DM, 64, nullptr, WinT, DM, BIG, 0, 9984, 0, 0, 1, 1}; cvt_job(C, J, rot); }
    zero_fill16(C, (unsigned char*)WinT + (size_t)10048 * DM, (size_t)192 * DM);
    { CvtJob J{gptr(A->in[9]) + (size_t)l * 512 * 1536, 1536, 512, 1536, gptr(A->in[8]) + l * 512, (bf16_t*)(ws + WS_WUQ), 512, BIG, 0, 0, 0, 0, 1, 0}; cvt_job(C, J, rot); }
    { CvtJob J{gptr(A->in[11]) + (size_t)l * 256 * 2048, 2048, 256, 2048, gptr(A->in[10]) + l * 256, (bf16_t*)(ws + WS_WUKV), 512, BIG, 0, 0, 0, 0, 1, 0}; cvt_job(C, J, rot); }
    { CvtJob J{gptr(A->in[16]) + (size_t)l * DM * 64, 64, DM, 64, nullptr, (bf16_t*)(ws + WS_WR), DM, BIG, 0, 0, 0, 0, 1, 0}; cvt_job(C, J, rot); }
    zero_fill16(C, (bf16_t*)(ws + WS_WR) + (size_t)64 * DM, (size_t)192 * DM * 2);
    { CvtJob J{gptr(A->in[12]) + (size_t)l * DM * DM, DM, DM, DM, nullptr, (bf16_t*)(ws + WS_WBR), DM, BIG, 0, 0, 0, 0, 1, 1}; cvt_job(C, J, rot); }
    { CvtJob J{gptr(A->in[13]) + (size_t)l * DM * DM, DM, DM, DM, nullptr, (bf16_t*)(ws + WS_WOUT), DM, BIG, 0, 0, 0, 0, 1, 1}; cvt_job(C, J, rot); }
    bf16_t* W13 = (bf16_t*)(ws + WS_W13); bf16_t* W2 = (bf16_t*)(ws + WS_W2);
    const size_t EW = (size_t)DM * FF;
    { CvtJob J{gptr(A->in[18]) + (size_t)l * NEXP * EW, FF, DM, FF, nullptr, W13, DM, 128, 256, 0, EW, (size_t)1024 * DM, NEXP, 1}; cvt_job(C, J, rot); }
    { CvtJob J{gptr(A->in[19]) + (size_t)l * NEXP * EW, FF, DM, FF, nullptr, W13, DM, 128, 256, 128, EW, (size_t)1024 * DM, NEXP, 1}; cvt_job(C, J, rot); }
    { CvtJob J{gptr(A->in[20]) + (size_t)l * NEXP * EW, DM, FF, DM, nullptr, W2, FF, BIG, 0, 0, EW, (size_t)DM * FF, NEXP, 1}; cvt_job(C, J, rot); }
    { CvtJob J{gptr(A->in[21]) + (size_t)l * EW, FF, DM, FF, nullptr, (bf16_t*)((unsigned char*)W13 + (size_t)NEXP * 1024 * DM), DM, 128, 256, 0, 0, 0, 1, 1}; cvt_job(C, J, rot); }
    { CvtJob J{gptr(A->in[22]) + (size_t)l * EW, FF, DM, FF, nullptr, (bf16_t*)((unsigned char*)W13 + (size_t)NEXP * 1024 * DM), DM, 128, 256, 128, 0, 0, 1, 1}; cvt_job(C, J, rot); }
    { CvtJob J{gptr(A->in[23]) + (size_t)l * EW, DM, FF, DM, nullptr, (bf16_t*)((unsigned char*)W2 + (size_t)NEXP * DM * FF), FF, BIG, 0, 0, 0, 0, 1, 1}; cvt_job(C, J, rot); }
    if (l == 0) {
        const float* x = gptr(A->in[0]); bf16_t* XB = (bf16_t*)(ws + WS_XB);
        for (size_t i = ((size_t)C.bid * NTHR + C.tid) * 8; i < (size_t)T * DM; i += (size_t)C.G * NTHR * 8) {
            const f32x4 a = *(const f32x4*)(x + i), b = *(const f32x4*)(x + i + 4); *(u32x4*)(XB + i) = pk8(a, b);
            u32x2 q; q.x = pk4_fp8(a[0], a[1], a[2], a[3]); q.y = pk4_fp8(b[0], b[1], b[2], b[3]); *(u32x2*)((unsigned char*)(ws + WS_XQ) + i) = q; }
        const int* pos = (const int*)gptr(A->in[1]); float* cosT = (float*)(ws + WS_COS); float* sinT = (float*)(ws + WS_SIN);
        for (int i = C.bid * NTHR + C.tid; i < T * NRT; i += C.G * NTHR) { const int t = i / NRT, j = i - t * NRT;
            const float ang = (float)pos[t] * invf[j];
            const double rev = (double)ang * 0.15915494309189535; const float fr = (float)(rev - floor(rev));
            cosT[i] = __builtin_amdgcn_cosf(fr); sinT[i] = __builtin_amdgcn_sinf(fr); }
    }
}

__device__ __forceinline__ void rope8(u32x4& a, u32x4& b, const float* c, const float* s) {
    float x1[8] = {bflo(a.x), bfhi(a.x), bflo(a.y), bfhi(a.y), bflo(a.z), bfhi(a.z), bflo(a.w), bfhi(a.w)};
    float x2[8] = {bflo(b.x), bfhi(b.x), bflo(b.y), bfhi(b.y), bflo(b.z), bfhi(b.z), bflo(b.w), bfhi(b.w)};
    float y1[8], y2[8];
#pragma unroll
    for (int i = 0; i < 8; ++i) { y1[i] = x1[i] * c[i] - x2[i] * s[i]; y2[i] = x2[i] * c[i] + x1[i] * s[i]; }
    a.x = cvt_pk_bf16(y1[0], y1[1]); a.y = cvt_pk_bf16(y1[2], y1[3]); a.z = cvt_pk_bf16(y1[4], y1[5]); a.w = cvt_pk_bf16(y1[6], y1[7]);
    b.x = cvt_pk_bf16(y2[0], y2[1]); b.y = cvt_pk_bf16(y2[2], y2[3]); b.z = cvt_pk_bf16(y2[4], y2[5]); b.w = cvt_pk_bf16(y2[6], y2[7]);
}
__device__ __forceinline__ void ld8f(float (&d)[8], const float* p) { const f32x4 a = *(const f32x4*)p, b = *(const f32x4*)(p + 4); d[0] = a[0]; d[1] = a[1]; d[2] = a[2]; d[3] = a[3]; d[4] = b[0]; d[5] = b[1]; d[6] = b[2]; d[7] = b[3]; }
__device__ __forceinline__ void phase_krope(const Ctx& C) {
    unsigned char* ws = C.ws; bf16_t* P = (bf16_t*)(ws + WS_P); bf16_t* Kf = (bf16_t*)(ws + WS_KF);
    const float* cosT = (const float*)(ws + WS_COS); const float* sinT = (const float*)(ws + WS_SIN); float* kmean = (float*)(ws + WS_KMEAN);
    LAS float* red = (LAS float*)C.lds;
    for (int it = C.bid; it < 64 * 6; it += C.G) {
        const int rb = it / 6, kind = it - rb * 6, r0 = rb * 256;
        if (kind < 4) {
            const int h = kind, c8 = C.tid & 15, rr = C.tid >> 4;
            float cs[16];
#pragma unroll
            for (int j = 0; j < 16; ++j) cs[j] = 0.f;
            if (c8 < 2 || c8 >= 4) {
                for (int p = 0; p < 8; ++p) { const int row = r0 + p * 32 + rr; bf16_t* base = P + (size_t)row * PC + C_MK + h * 128;
                    if (c8 < 2) { u32x4 a = *(const u32x4*)(base + c8 * 8), b = *(const u32x4*)(base + 16 + c8 * 8);
                        float c[8], s[8]; ld8f(c, cosT + (size_t)row * NRT + 40 + c8 * 8); ld8f(s, sinT + (size_t)row * NRT + 40 + c8 * 8);
                        rope8(a, b, c, s); *(u32x4*)(base + c8 * 8) = a; *(u32x4*)(base + 16 + c8 * 8) = b;
                        cs[0] += bflo(a.x); cs[1] += bfhi(a.x); cs[2] += bflo(a.y); cs[3] += bfhi(a.y); cs[4] += bflo(a.z); cs[5] += bfhi(a.z); cs[6] += bflo(a.w); cs[7] += bfhi(a.w);
                        cs[8] += bflo(b.x); cs[9] += bfhi(b.x); cs[10] += bflo(b.y); cs[11] += bfhi(b.y); cs[12] += bflo(b.z); cs[13] += bfhi(b.z); cs[14] += bflo(b.w); cs[15] += bfhi(b.w);
                    } else { const u32x4 a = *(const u32x4*)(base + c8 * 8);
                        cs[0] += bflo(a.x); cs[1] += bfhi(a.x); cs[2] += bflo(a.y); cs[3] += bfhi(a.y); cs[4] += bflo(a.z); cs[5] += bfhi(a.z); cs[6] += bflo(a.w); cs[7] += bfhi(a.w); } }
            }
            if (c8 < 2) {
#pragma unroll
                for (int j = 0; j < 8; ++j) { red[rr * 128 + c8 * 8 + j] = cs[j]; red[rr * 128 + 16 + c8 * 8 + j] = cs[8 + j]; } }
            else if (c8 >= 4) {
#pragma unroll
                for (int j = 0; j < 8; ++j) red[rr * 128 + c8 * 8 + j] = cs[j]; }
            __syncthreads();
            if (C.tid < 128) { float s = 0.f; for (int q = 0; q < 32; ++q) s += red[q * 128 + C.tid];
                const int b = rb >> 3, nb = rb & 7; kmean[((size_t)(b * 4 + h) * 8 + nb) * 128 + C.tid] = s * (1.f / 256.f); }
            __syncthreads();
        } else if (kind == 4) {
            for (int q = 0; q < 4; ++q) { const int idx = C.tid + 512 * q, g = idx & 7, row = r0 + (idx >> 3); bf16_t* base = P + (size_t)row * PC + C_DK + g * 64;
                u32x4 a = *(const u32x4*)base, b = *(const u32x4*)(base + 8); float c[8], s[8]; ld8f(c, cosT + (size_t)row * NRT); ld8f(s, sinT + (size_t)row * NRT);
                rope8(a, b, c, s); *(u32x4*)base = a; *(u32x4*)(base + 8) = b; }
        } else {
            for (int q = 0; q < 2; ++q) { const int idx = C.tid + 512 * q, g = idx & 3, row = r0 + (idx >> 2); const bf16_t* base = P + (size_t)row * PC + C_KPE;
                u32x4 a = *(const u32x4*)(base + g * 8), b = *(const u32x4*)(base + 32 + g * 8); float c[8], s[8]; ld8f(c, cosT + (size_t)row * NRT + 8 + g * 8); ld8f(s, sinT + (size_t)row * NRT + 8 + g * 8);
                rope8(a, b, c, s);
#pragma unroll
                for (int h = 0; h < 8; ++h) { bf16_t* d = Kf + (size_t)row * 1536 + h * 192 + 128; *(u32x4*)(d + g * 8) = a; *(u32x4*)(d + 32 + g * 8) = b; } }
        }
    }
}

namespace at {
constexpr int LK = 0, LV = 24576, BUFSZ = 40960, LWS = 2 * BUFSZ, LKM = LWS + 2048;
__device__ __forceinline__ int v_st(int k, int c) { const int kk = (k & ~0xC) | ((k & 4) << 1) | ((k & 8) >> 1); return ((kk >> 3) * 4 + (c >> 5)) * 512 + ((kk & 7) * 32 + (c & 31)) * 2; }
__device__ __forceinline__ int v_rd_base(int lane) { return ((lane & 3) << 3) | (((lane >> 2) & 3) << 6) | (((lane >> 4) & 1) << 5) | (((lane >> 5) & 1) << 8); }
constexpr int v_rd_off(int d0, int ks, int half) { return d0 * 512 + ks * 4096 + half * 2048; }
__device__ __forceinline__ int crow(int r, int hi) { return (r & 3) + 8 * (r >> 2) + 4 * hi; }

__device__ __forceinline__ void rope_frag(bf16x8& a, bf16x8& b, const float* c, const float* s) {
    u32x4 ua = __builtin_bit_cast(u32x4, a), ub = __builtin_bit_cast(u32x4, b); rope8(ua, ub, c, s); a = __builtin_bit_cast(bf16x8, ua); b = __builtin_bit_cast(bf16x8, ub);
}

template <int KD, int MODE, int ROPE, int EPI>
__device__ __forceinline__ void attn_unit(LAS unsigned char* lds, const bf16_t* Qp, int qpitch, const bf16_t* Kp, int kpitch, const bf16_t* Vp, int vpitch,
                                          int trow0, int qb, const float* cosT, const float* sinT, float C2, const float* kmean_bh,
                                          float* O1, unsigned char* Oout, float lam, float outscale, const float* subg) {
    int tid_ = threadIdx.x; asm volatile("" : "+v"(tid_));
    const int tid = tid_, wid = __builtin_amdgcn_readfirstlane(tid >> 6), lane = tid & 63, r32 = lane & 31, hi = lane >> 5;
    const int q0 = qb * 256, qlo = q0 + wid * 32, qrow = qlo + r32;
    LAS unsigned char* K_lds = lds + LK; LAS unsigned char* V_lds = lds + LV;
    LAS float* wsf = (LAS float*)(lds + LWS) + wid * 64; LAS float* kml = (LAS float*)(lds + LKM);
    constexpr int ND = KD / 16;
    bf16x8 qr[ND];
    const bf16_t* qrowp = Qp + (size_t)qrow * qpitch;
#pragma unroll
    for (int d0 = 0; d0 < ND; ++d0) qr[d0] = *(const bf16x8*)(qrowp + d0 * 16 + hi * 8);
    const float* cr = cosT + (size_t)(trow0 + qrow) * NRT; const float* sr = sinT + (size_t)(trow0 + qrow) * NRT;
    if constexpr (ROPE == 0) {
        bf16x8 other = *(const bf16x8*)(qrowp + (1 - hi) * 8); float c[8], s[8]; ld8f(c, cr); ld8f(s, sr);
        bf16x8 a = hi ? other : qr[0], b = hi ? qr[0] : other; rope_frag(a, b, c, s); qr[0] = hi ? b : a;
    } else if constexpr (ROPE == 2) {
        float c[8], s[8]; ld8f(c, cr + 40 + hi * 8); ld8f(s, sr + 40 + hi * 8); rope_frag(qr[0], qr[1], c, s);
    } else {
        float c[8], s[8]; ld8f(c, cr + 8 + hi * 8); ld8f(s, sr + 8 + hi * 8); rope_frag(qr[8], qr[10], c, s);
        ld8f(c, cr + 8 + 16 + hi * 8); ld8f(s, sr + 8 + 16 + hi * 8); rope_frag(qr[9], qr[11], c, s);
    }
    unsigned selmask = 0xffu;
    if constexpr (MODE == 1) {
        __syncthreads();
        for (int i = tid; i < 1024; i += NTHR) kml[i] = kmean_bh[i];
        __syncthreads();
        float g[7];
#pragma unroll
        for (int n = 0; n < 7; ++n) { float s = 0.f;
            if (n < qb) {
#pragma unroll
                for (int d0 = 0; d0 < ND; ++d0) { const u32x4 w = __builtin_bit_cast(u32x4, qr[d0]); const LAS float* km = kml + n * 128 + d0 * 16 + hi * 8;
                    s += bflo(w.x) * km[0] + bfhi(w.x) * km[1] + bflo(w.y) * km[2] + bfhi(w.y) * km[3] + bflo(w.z) * km[4] + bfhi(w.z) * km[5] + bflo(w.w) * km[6] + bfhi(w.w) * km[7]; }
                s += __shfl_xor(s, 32);
            } else s = -__builtin_inff();
            g[n] = s; }
        if (qb <= 3) selmask = (1u << qb) - 1u;
        else { selmask = 0u;
#pragma unroll
            for (int n = 0; n < 7; ++n) { int rank = 0;
#pragma unroll
                for (int m = 0; m < 7; ++m) if (m != n) rank += (g[m] > g[n] || (g[m] == g[n] && m < n)) ? 1 : 0;
                if (rank < 3 && n < qb) selmask |= 1u << n; } }
    }
    constexpr int NKD = (64 * KD * 2) / 8192;
    int gko[NKD], gvo[2];
#pragma unroll
    for (int i = 0; i < NKD; ++i) { const int off = i * 8192 + tid * 16, row = off / (KD * 2), chs = (off - row * (KD * 2)) >> 4, ch = chs ^ (row & 7); gko[i] = row * kpitch + ch * 8; }
#pragma unroll
    for (int i = 0; i < 2; ++i) { const int off = i * 8192 + tid * 16, sub = off >> 9, within = off & 511, kk = (sub >> 2) * 8 + (within >> 6);
        const int k = (kk & ~0xC) | ((kk & 4) << 1) | ((kk & 8) >> 1), c = (sub & 3) * 32 + ((within & 63) >> 1); gvo[i] = k * vpitch + c; }
    const int vb00 = (int)(unsigned)(size_t)V_lds + v_rd_base(lane);
    int kbase4[4];
#pragma unroll
    for (int dd = 0; dd < 4; ++dd) kbase4[dd] = r32 * (KD * 2) + ((((dd * 2 + hi) ^ (r32 & 7))) << 4);
    const int NT = (q0 + 256) / 64;
#define AT_ISSUE(jt_, buf_) do { const size_t kb1_ = (size_t)(jt_) * 64; \
        _Pragma("unroll") for (int i = 0; i < NKD; ++i) __builtin_amdgcn_global_load_lds((const unsigned*)(Kp + kb1_ * kpitch + gko[i]), (LAS unsigned*)(lds + (buf_) * BUFSZ + LK + i * 8192 + wid * 1024), 16, 0, 0); \
        _Pragma("unroll") for (int i = 0; i < 2; ++i) __builtin_amdgcn_global_load_lds((const unsigned*)(Vp + kb1_ * vpitch + gvo[i]), (LAS unsigned*)(lds + (buf_) * BUFSZ + LV + i * 8192 + wid * 1024), 16, 0, 0); } while (0)
    AT_ISSUE(0, 0);
    float m_reg = -1e30f, l_reg = 0.f; f32x16 o[4];
#pragma unroll
    for (int d = 0; d < 4; ++d)
#pragma unroll
        for (int r = 0; r < 16; ++r) o[d][r] = 0.f;
    for (int jt = 0; jt < NT; ++jt) {
        asm volatile("s_waitcnt vmcnt(0)" ::: "memory");
        __syncthreads();
        if (jt + 1 < NT) AT_ISSUE(jt + 1, (jt + 1) & 1);
        const int bo = (jt & 1) * BUFSZ;
        const LAS unsigned char* Kb = K_lds + bo; const int vb0 = vb00 + bo;
        const int kb = jt * 64;
        bool act = kb <= qlo + 31;
        const int blk = jt >> 2;
        if (MODE == 1 && blk < qb) act = __any((int)((selmask >> blk) & 1u)) != 0;
        if (act) {
            f32x16 p0, p1;
#pragma unroll
            for (int r = 0; r < 16; ++r) { p0[r] = 0.f; p1[r] = 0.f; }
#pragma unroll
            for (int d0 = 0; d0 < ND; ++d0) { const LAS unsigned char* a = Kb + kbase4[d0 & 3] + (d0 >> 2) * 128;
                const bf16x8 b0 = *(const LAS bf16x8*)a, b1 = *(const LAS bf16x8*)(a + 32 * KD * 2);
                p0 = __builtin_amdgcn_mfma_f32_32x32x16_bf16(b0, qr[d0], p0, 0, 0, 0);
                p1 = __builtin_amdgcn_mfma_f32_32x32x16_bf16(b1, qr[d0], p1, 0, 0, 0); }
            const float NEG = -__builtin_inff();
            if (kb + 63 > qlo) {
                const int dq = qrow - 4 * hi - kb;
#pragma unroll
                for (int r = 0; r < 16; ++r) { const int c = (r & 3) + 8 * (r >> 2); if (dq - c < 0) p0[r] = NEG; if (dq - c - 32 < 0) p1[r] = NEG; }
            }
            if (MODE == 1 && blk < qb) { if (!((selmask >> blk) & 1u)) {
#pragma unroll
                for (int r = 0; r < 16; ++r) { p0[r] = NEG; p1[r] = NEG; } } }
            float pmax = p0[0];
#pragma unroll
            for (int r = 1; r < 16; ++r) pmax = fmaxf(pmax, p0[r]);
#pragma unroll
            for (int r = 0; r < 16; ++r) pmax = fmaxf(pmax, p1[r]);
            pmax = fmaxf(pmax, __shfl_xor(pmax, 32));
            const bool keep_max = __all((pmax - m_reg) * C2 <= 8.f) != 0;
            float mn = m_reg, alpha = 1.f;
            if (!keep_max) { mn = fmaxf(m_reg, pmax); alpha = __builtin_amdgcn_exp2f((m_reg - mn) * C2); m_reg = mn; }
            const float mnL = -mn * C2;
            float ps = 0.f;
#pragma unroll
            for (int r = 0; r < 16; ++r) { p0[r] = __builtin_amdgcn_exp2f(fmaf(p0[r], C2, mnL)); p1[r] = __builtin_amdgcn_exp2f(fmaf(p1[r], C2, mnL)); ps += p0[r] + p1[r]; }
            ps += __shfl_xor(ps, 32);
            l_reg = l_reg * alpha + ps;
            bf16x8 pa0, pa1, pa2, pa3;
#define PK4(P, B_, OUT) do { unsigned a0 = cvt_pk_bf16(P[B_+0], P[B_+1]), a1 = cvt_pk_bf16(P[B_+2], P[B_+3]); unsigned b0_ = cvt_pk_bf16(P[B_+4], P[B_+5]), b1_ = cvt_pk_bf16(P[B_+6], P[B_+7]); \
        auto r0 = __builtin_amdgcn_permlane32_swap(a0, b0_, false, false); auto r1 = __builtin_amdgcn_permlane32_swap(a1, b1_, false, false); \
        u32x4 w = {r0[0], r1[0], r0[1], r1[1]}; OUT = __builtin_bit_cast(bf16x8, w); } while (0)
            PK4(p0, 0, pa0); PK4(p0, 8, pa1); PK4(p1, 0, pa2); PK4(p1, 8, pa3);
#undef PK4
            if (!keep_max) { if (hi == 0) wsf[r32] = alpha; asm volatile("s_waitcnt lgkmcnt(0)" ::: "memory");
#pragma unroll
                for (int r = 0; r < 16; ++r) { const float a = wsf[crow(r, hi)];
#pragma unroll
                    for (int d = 0; d < 4; ++d) o[d][r] *= a; }
                asm volatile("s_waitcnt lgkmcnt(0)" ::: "memory"); }
#define TRRD(dst, off) asm volatile("ds_read_b64_tr_b16 %0, %1 offset:%2" : "=&v"(dst) : "v"(vb0), "i"(off) : "memory")
#define PV_D0(d0) do { s16x4 l0, l1, l2, l3, h0, h1, h2, h3; constexpr int b_ = v_rd_off(d0, 0, 0); \
        TRRD(l0, b_); TRRD(h0, b_ + 2048); TRRD(l1, b_ + 4096); TRRD(h1, b_ + 6144); TRRD(l2, b_ + 8192); TRRD(h2, b_ + 10240); TRRD(l3, b_ + 12288); TRRD(h3, b_ + 14336); \
        asm volatile("s_waitcnt lgkmcnt(0)" ::: "memory"); __builtin_amdgcn_sched_barrier(0); \
        o[d0] = __builtin_amdgcn_mfma_f32_32x32x16_bf16(pa0, (bf16x8){l0[0], l0[1], l0[2], l0[3], h0[0], h0[1], h0[2], h0[3]}, o[d0], 0, 0, 0); \
        o[d0] = __builtin_amdgcn_mfma_f32_32x32x16_bf16(pa1, (bf16x8){l1[0], l1[1], l1[2], l1[3], h1[0], h1[1], h1[2], h1[3]}, o[d0], 0, 0, 0); \
        o[d0] = __builtin_amdgcn_mfma_f32_32x32x16_bf16(pa2, (bf16x8){l2[0], l2[1], l2[2], l2[3], h2[0], h2[1], h2[2], h2[3]}, o[d0], 0, 0, 0); \
        o[d0] = __builtin_amdgcn_mfma_f32_32x32x16_bf16(pa3, (bf16x8){l3[0], l3[1], l3[2], l3[3], h3[0], h3[1], h3[2], h3[3]}, o[d0], 0, 0, 0); } while (0)
            PV_D0(0); PV_D0(1); PV_D0(2); PV_D0(3);
#undef PV_D0
#undef TRRD
        }
    }
#undef AT_ISSUE
    if (hi == 0) wsf[r32] = l_reg; asm volatile("s_waitcnt lgkmcnt(0)" ::: "memory");
    float rli[16];
#pragma unroll
    for (int r = 0; r < 16; ++r) rli[r] = __builtin_amdgcn_rcpf(wsf[crow(r, hi)]);
    asm volatile("s_waitcnt lgkmcnt(0)" ::: "memory");
    if constexpr (EPI == 0) {
#pragma unroll
        for (int r = 0; r < 16; ++r) { float* op = O1 + (size_t)(qlo + crow(r, hi)) * 512;
#pragma unroll
            for (int d = 0; d < 4; ++d) op[d * 32 + r32] = o[d][r] * rli[r]; }
    } else if constexpr (EPI == 1) {
        float gsub[4];
#pragma unroll
        for (int d = 0; d < 4; ++d) gsub[d] = subg[d * 32 + r32] * outscale;
#pragma unroll
        for (int r = 0; r < 16; ++r) { const int srow = qlo + crow(r, hi); const float* op = O1 + (size_t)srow * 512; float dv[4]; float ss = 0.f;
#pragma unroll
            for (int d = 0; d < 4; ++d) { dv[d] = op[d * 32 + r32] - lam * (o[d][r] * rli[r]); ss += dv[d] * dv[d]; }
#pragma unroll
            for (int off = 1; off < 32; off <<= 1) ss += __shfl_xor(ss, off);
            const float rs = rsqrtf(ss * (1.f / 128.f) + NORM_EPS);
#pragma unroll
            for (int d = 0; d < 4; ++d) { const float v = dv[d] * rs * gsub[d] * O8_SCALE; const float vn = __shfl_xor(v, 1);
                const unsigned h2 = (unsigned)__builtin_amdgcn_cvt_pk_fp8_f32(v, vn, 0, false) & 0xffffu; const unsigned hn = (unsigned)__shfl_xor((int)h2, 2);
                if ((r32 & 3) == 0) *(unsigned*)(Oout + (size_t)srow * 2048 + d * 32 + r32) = h2 | (hn << 16); } }
    } else {
#pragma unroll
        for (int r = 0; r < 16; ++r) { const int srow = qlo + crow(r, hi);
#pragma unroll
            for (int d = 0; d < 4; ++d) { const float v = o[d][r] * rli[r] * O8_SCALE; const float vn = __shfl_xor(v, 1);
                const unsigned h2 = (unsigned)__builtin_amdgcn_cvt_pk_fp8_f32(v, vn, 0, false) & 0xffffu; const unsigned hn = (unsigned)__shfl_xor((int)h2, 2);
                if ((r32 & 3) == 0) *(unsigned*)(Oout + (size_t)srow * 2048 + d * 32 + r32) = h2 | (hn << 16); } }
    }
    __syncthreads();
}
}

__device__ __forceinline__ void phase_attention(const Ctx& C, ArgsK* A, int l) {
    unsigned char* ws = C.ws; const bf16_t* P = (const bf16_t*)(ws + WS_P); const bf16_t* Qm = (const bf16_t*)(ws + WS_QM); const bf16_t* Kf = (const bf16_t*)(ws + WS_KF);
    const bf16_t* Vm = (const bf16_t*)(ws + WS_VM); unsigned char* O = (unsigned char*)(ws + WS_O); float* O1 = (float*)(ws + WS_O1);
    const float* cosT = (const float*)(ws + WS_COS); const float* sinT = (const float*)(ws + WS_SIN); const float* kmean = (const float*)(ws + WS_KMEAN);
    constexpr float LOG2E = 1.4426950408889634f;
    float d1 = 0.f, d2 = 0.f;
    for (int i = 0; i < 64; ++i) { d1 += gptr(A->in[3])[l * 64 + i] * gptr(A->in[4])[l * 64 + i]; d2 += gptr(A->in[5])[l * 64 + i] * gptr(A->in[6])[l * 64 + i]; }
    const float lam_init = 0.8f - 0.6f * expf(-0.3f * (float)l);
    const float lam = expf(d1) - expf(d2) + lam_init;
#ifndef ATT_ONLY
#define ATT_ONLY 7
#endif
    for (int rp_ = 0; rp_ < REPN(13); ++rp_) if (ATT_ONLY & 1) for (int L = C.bid; L < 128; L += C.G) {
        const int pair = L & 3, h = (L >> 2) & 3, b = L >> 4, trow0 = b * SEQ;
        for (int half = 0; half < 2; ++half) { const int qb = half ? 7 - pair : pair;
            const bf16_t* Vp = P + (size_t)trow0 * PC + C_DV + h * 128;
            float* o1 = O1 + ((size_t)trow0 * 4 + h) * 128;
            at::attn_unit<64, 0, 0, 0>(C.lds, P + (size_t)trow0 * PC + C_DQ + h * 128, PC, P + (size_t)trow0 * PC + C_DK + h * 128, PC, Vp, PC, trow0, qb, cosT, sinT, 0.125f * LOG2E, nullptr,
                                       o1, nullptr, 0.f, 0.f, nullptr);
            at::attn_unit<64, 0, 0, 1>(C.lds, P + (size_t)trow0 * PC + C_DQ + h * 128 + 64, PC, P + (size_t)trow0 * PC + C_DK + h * 128 + 64, PC, Vp, PC, trow0, qb, cosT, sinT, 0.125f * LOG2E, nullptr,
                                       o1, O + (size_t)trow0 * 2048 + h * 128, lam, 1.f - lam_init, gptr(A->in[7]) + l * 128);
        }
    }
    for (int rp_ = 0; rp_ < REPN(14); ++rp_) if (ATT_ONLY & 2) for (int L = C.bid; L < 512; L += C.G) {
        int it; if (L >= 128 && L < 256) it = L - 128; else if (L >= 384) it = L - 256; else continue;
        const int pair = it & 3, h = (it >> 2) & 7, b = it >> 5, trow0 = b * SEQ;
        for (int half = 0; half < 2; ++half) { const int qb = half ? 7 - pair : pair;
            at::attn_unit<192, 0, 1, 2>(C.lds, Qm + (size_t)trow0 * 1536 + h * 192, 1536, Kf + (size_t)trow0 * 1536 + h * 192, 1536, Vm + (size_t)trow0 * 1024 + h * 128, 1024, trow0, qb, cosT, sinT,
                                        0.07216878364870322f * LOG2E, nullptr, nullptr, O + (size_t)trow0 * 2048 + 512 + h * 128, 0.f, 0.f, nullptr); }
    }
    for (int rp_ = 0; rp_ < REPN(15); ++rp_) if (ATT_ONLY & 4) for (int L = C.bid; L < 512; L += C.G) {
        if (L < 256 || L >= 384) continue; const int it = L - 256;
        const int pair = it & 3, h = (it >> 2) & 3, b = it >> 4, trow0 = b * SEQ;
        for (int half = 0; half < 2; ++half) { const int qb = half ? 7 - pair : pair;
            at::attn_unit<128, 1, 2, 2>(C.lds, P + (size_t)trow0 * PC + C_MQ + h * 128, PC, P + (size_t)trow0 * PC + C_MK + h * 128, PC, P + (size_t)trow0 * PC + C_MV + h * 128, PC, trow0, qb, cosT, sinT,
                                        0.08838834764831845f * LOG2E, kmean + (size_t)(b * 4 + h) * 8 * 128, nullptr, O + (size_t)trow0 * 2048 + 1536 + h * 128, 0.f, 0.f, nullptr); }
    }
}

__device__ __forceinline__ void ln_row(f32x4 (&v)[4][2], const float* g, const float* bb, float* of, bf16_t* ob, unsigned char* oq, int lane) {
    float s = 0.f;
#pragma unroll
    for (int j = 0; j < 4; ++j)
#pragma unroll
        for (int h = 0; h < 2; ++h) s += (v[j][h][0] + v[j][h][1]) + (v[j][h][2] + v[j][h][3]);
    const float mean = wave_sum(s) * (1.f / DM); float s2 = 0.f;
#pragma unroll
    for (int j = 0; j < 4; ++j)
#pragma unroll
        for (int h = 0; h < 2; ++h) { const f32x4 d = v[j][h] - mean; s2 += (d[0] * d[0] + d[1] * d[1]) + (d[2] * d[2] + d[3] * d[3]); }
    const float rstd = rsqrtf(wave_sum(s2) * (1.f / DM) + NORM_EPS);
#pragma unroll
    for (int j = 0; j < 4; ++j) { const int c = (lane + 64 * j) * 8; f32x4 y[2];
#pragma unroll
        for (int h = 0; h < 2; ++h) { const f32x4 gg = *(const f32x4*)(g + c + 4 * h), b4 = *(const f32x4*)(bb + c + 4 * h); y[h] = (v[j][h] - mean) * rstd * gg + b4; }
        if (of) { *(f32x4*)(of + c) = y[0]; *(f32x4*)(of + c + 4) = y[1]; }
        if (ob) *(u32x4*)(ob + c) = pk8(y[0], y[1]);
        if (oq) { u32x2 q; q.x = pk4_fp8(y[0][0], y[0][1], y[0][2], y[0][3]); q.y = pk4_fp8(y[1][0], y[1][1], y[1][2], y[1][3]); *(u32x2*)(oq + c) = q; } }
}
__device__ __forceinline__ void ld_bf16x8(f32x4 (&d)[2], const bf16_t* p, float sc) { const u32x4 w = *(const u32x4*)p;
    d[0] = (f32x4){bflo(w.x), bfhi(w.x), bflo(w.y), bfhi(w.y)} * sc; d[1] = (f32x4){bflo(w.z), bfhi(w.z), bflo(w.w), bfhi(w.w)} * sc; }
__device__ __forceinline__ void phase_ln_mix(const Ctx& C, ArgsK* A, int l) {
    const bf16_t* Z = (const bf16_t*)(C.ws + WS_X1F); bf16_t* XB1 = (bf16_t*)(C.ws + WS_X1B);
    const float* g = gptr(A->in[14]) + l * DM; const float* bb = gptr(A->in[15]) + l * DM;
    for (int row0 = (C.bid * NWAVES + C.wave) * 4; row0 < T; row0 += C.G * NWAVES * 4) { f32x4 v[4][4][2];
#pragma unroll
        for (int u = 0; u < 4; ++u)
#pragma unroll
            for (int j = 0; j < 4; ++j) ld_bf16x8(v[u][j], Z + (size_t)(row0 + u) * DM + (C.lane + 64 * j) * 8, 1.f);
#pragma unroll
        for (int u = 0; u < 4; ++u) ln_row(v[u], g, bb, nullptr, XB1 + (size_t)(row0 + u) * DM, (unsigned char*)(C.ws + WS_X1Q) + (size_t)(row0 + u) * DM, C.lane); }
}

__device__ __forceinline__ void phase_route(const Ctx& C, ArgsK* A, int l) {
    unsigned char* ws = C.ws; const float* bias = gptr(A->in[17]) + l * NEXP;
    const float* logits = (const float*)(ws + WS_O1);
    int* ridx = (int*)(ws + WS_RIDX); float* rw = (float*)(ws + WS_RW); int* rpos = (int*)(ws + WS_RPOS); int* bbase = (int*)(ws + WS_BBASE);
    unsigned* ecnt = (unsigned*)(ws + WS_CTL) + CW_ECNT + l * 64;
    LAS int* hist = (LAS int*)C.lds;
    const int lane = C.lane;
    for (int chunk = C.bid; chunk < T / 64; chunk += C.G) {
        __syncthreads();
        if (C.tid < 64) hist[C.tid] = 0;
        __syncthreads();
        const float bs = bias[lane]; const float NEGI = -__builtin_inff();
        LAS float* cb = (LAS float*)(C.lds + 1024 + 16384) + C.wave * 128;
        const int gme = lane >> 3;
#pragma nounroll
        for (int q = 0; q < 8; ++q) { const int t = chunk * 64 + C.wave * 8 + q;
            const float* lp = logits + (size_t)t * 64 + lane; const float sv = sigmoidf_((lp[0] + lp[(size_t)T * 64]) + (lp[(size_t)2 * T * 64] + lp[(size_t)3 * T * 64])); const float c = sv + bs;
            cb[lane] = c; asm volatile("s_waitcnt lgkmcnt(0)" ::: "memory");
            const f32x4 ga = *(const LAS f32x4*)(cb + gme * 8), gb = *(const LAS f32x4*)(cb + gme * 8 + 4);
            float m1 = ga[0], m2 = NEGI;
#define TOP2(x) do { const float x_ = (x); const bool gt1 = x_ > m1; m2 = gt1 ? m1 : (x_ > m2 ? x_ : m2); m1 = gt1 ? x_ : m1; } while (0)
            TOP2(ga[1]); TOP2(ga[2]); TOP2(ga[3]); TOP2(gb[0]); TOP2(gb[1]); TOP2(gb[2]); TOP2(gb[3]);
#undef TOP2
            if ((lane & 7) == 0) cb[64 + gme] = m1 + m2;
            asm volatile("s_waitcnt lgkmcnt(0)" ::: "memory");
            const f32x4 s0 = *(const LAS f32x4*)(cb + 64), s1 = *(const LAS f32x4*)(cb + 68);
            const float gsv[8] = {s0[0], s0[1], s0[2], s0[3], s1[0], s1[1], s1[2], s1[3]};
            unsigned keepm = 0u;
#pragma unroll
            for (int g = 0; g < 8; ++g) { int r = 0;
#pragma unroll
                for (int h = 0; h < 8; ++h) if (h != g) r += (gsv[h] > gsv[g] || (gsv[h] == gsv[g] && h < g)) ? 1 : 0;
                if (r < 4) keepm |= 1u << g; }
            const bool keep = (keepm >> gme) & 1u;
            unsigned ub = __float_as_uint(c); ub = (ub & 0x80000000u) ? ~ub : (ub | 0x80000000u);
            const unsigned key = keep ? ((ub & ~63u) | (unsigned)(63 - lane)) : 0u;
            LAS unsigned* kb = (LAS unsigned*)cb;
            asm volatile("s_waitcnt lgkmcnt(0)" ::: "memory");
            kb[lane] = key; asm volatile("s_waitcnt lgkmcnt(0)" ::: "memory");
            int rk = 0;
#pragma unroll
            for (int e4 = 0; e4 < 16; ++e4) { const u32x4 v = *(const LAS u32x4*)(kb + e4 * 4);
                rk += (v[0] > key ? 1 : 0) + (v[1] > key ? 1 : 0) + (v[2] > key ? 1 : 0) + (v[3] > key ? 1 : 0); }
            const bool sel = keep && rk < 8;
            const float wsum = wave_sum(sel ? sv : 0.f);
            if (sel) { const int lr = __hip_atomic_fetch_add(hist + lane, 1, __ATOMIC_RELAXED, __HIP_MEMORY_SCOPE_WORKGROUP); ridx[t * 8 + rk] = lane; rw[t * 8 + rk] = sv / wsum * 2.5f; rpos[t * 8 + rk] = lr; }
            asm volatile("s_waitcnt lgkmcnt(0)" ::: "memory");
        }
        __syncthreads();
        if (C.tid < 64) bbase[chunk * 64 + C.tid] = (int)atomicAdd(ecnt + C.tid, (unsigned)hist[C.tid]);
    }
}
template <bool WANT_SEG> __device__ __forceinline__ void build_moe_tables(const Ctx& C, int l, LAS int* segb  ) {
    const unsigned* ecnt = (const unsigned*)(C.ws + WS_CTL) + CW_ECNT + l * 64;
    LAS unsigned char* tab = C.lds + TAB_OFF; LAS int* tile_e = (LAS int*)(tab + TAB_TILEE); LAS int* misc = (LAS int*)(tab + TAB_MISC);
    __syncthreads();
    if (C.wave == 0) { const int e = C.lane; const int cnt = (int)__hip_atomic_load(ecnt + e, __ATOMIC_RELAXED, __HIP_MEMORY_SCOPE_AGENT); const int nt = (cnt + 255) >> 8;
        int incl = nt;
#pragma unroll
        for (int o = 1; o < 64; o <<= 1) { const int v = __shfl_up(incl, o); if (e >= o) incl += v; }
        const int base = incl - nt; const int nrt = __shfl(incl, 63);
        for (int i = 0; i < nt; ++i) tile_e[base + i] = e;
        tile_e[nrt + e] = NEXP;
        if constexpr (WANT_SEG) segb[e] = base * 256;
        if (e == 0) { misc[0] = nrt; misc[1] = nrt + 64; } }
    __syncthreads();
}
__device__ __forceinline__ void phase_scatter(const Ctx& C, int l) {
    unsigned char* ws = C.ws; const int* ridx = (const int*)(ws + WS_RIDX); const float* rw = (const float*)(ws + WS_RW); int* rpos = (int*)(ws + WS_RPOS); const int* bbase = (const int*)(ws + WS_BBASE);
    int* stok = (int*)(ws + WS_STOK); float* sw = (float*)(ws + WS_SW);
    const unsigned* ecnt = (const unsigned*)(ws + WS_CTL) + CW_ECNT + l * 64;
    LAS int* segb = (LAS int*)C.lds;
    build_moe_tables<true>(C, l, segb);
    for (int chunk = C.bid; chunk < T / 64; chunk += C.G) {
        const int t = chunk * 64 + (C.tid >> 3), k = C.tid & 7; const int e = ridx[t * 8 + k];
        const int pos = segb[e] + bbase[chunk * 64 + e] + rpos[t * 8 + k];
        rpos[t * 8 + k] = pos; stok[pos] = t; sw[pos] = rw[t * 8 + k];
    }
    for (int e = C.bid; e < NEXP; e += C.G) { const int cnt = (int)__hip_atomic_load(ecnt + e, __ATOMIC_RELAXED, __HIP_MEMORY_SCOPE_AGENT); const int endp = segb[e] + ((cnt + 255) & ~255);
        for (int p = segb[e] + cnt + C.tid; p < endp; p += NTHR) { stok[p] = 0; sw[p] = 0.f; } }
    __syncthreads();
}

__device__ __forceinline__ void phase_combine(const Ctx& C, ArgsK* A, int l) {
    unsigned char* ws = C.ws; const bf16_t* X1 = (const bf16_t*)(ws + WS_X1B); const unsigned char* YS = (const unsigned char*)(ws + WS_YS); const int* rpos = (const int*)(ws + WS_RPOS);
    float* OF = (l == 1) ? gptr(A->out) : nullptr; bf16_t* OB = (l == 1) ? nullptr : (bf16_t*)(ws + WS_XB);
    const float* g = gptr(A->in[24]) + l * DM; const float* bb = gptr(A->in[25]) + l * DM;
    for (int row0 = (C.bid * NWAVES + C.wave) * 2; row0 < T; row0 += C.G * NWAVES * 2) {
        int sr[2][9];
#pragma unroll
        for (int u = 0; u < 2; ++u) {
#pragma unroll
            for (int k = 0; k < 8; ++k) sr[u][k] = rpos[(row0 + u) * 8 + k];
            sr[u][8] = RT_ROWS + row0 + u; }
        f32x4 v[2][4][2]; u32x2 yw[2][9][4];
#pragma unroll
        for (int u = 0; u < 2; ++u)
#pragma unroll
            for (int k = 0; k < 9; ++k) { const unsigned char* yr = YS + (size_t)sr[u][k] * DM;
#pragma unroll
                for (int j = 0; j < 4; ++j) yw[u][k][j] = *(const u32x2*)(yr + (C.lane + 64 * j) * 8); }
#pragma unroll
        for (int u = 0; u < 2; ++u)
#pragma unroll
            for (int j = 0; j < 4; ++j) ld_bf16x8(v[u][j], X1 + (size_t)(row0 + u) * DM + (C.lane + 64 * j) * 8, DN_ALPHA);
#pragma unroll
        for (int u = 0; u < 2; ++u) {
#pragma unroll
            for (int j = 0; j < 4; ++j) { f32x4 a0 = {0.f, 0.f, 0.f, 0.f}, a1 = a0;
#pragma unroll
                for (int k = 0; k < 9; ++k) { float lo[4], hi[4]; fp8x4_to_f32(yw[u][k][j].x, lo); fp8x4_to_f32(yw[u][k][j].y, hi);
                    a0 += (f32x4){lo[0], lo[1], lo[2], lo[3]}; a1 += (f32x4){hi[0], hi[1], hi[2], hi[3]}; }
                v[u][j][0] += a0 * (1.f / YS8_SCALE); v[u][j][1] += a1 * (1.f / YS8_SCALE); }
            const int row = row0 + u;
            ln_row(v[u], g, bb, OF ? OF + (size_t)row * DM : nullptr, OB ? OB + (size_t)row * DM : nullptr, OB ? (unsigned char*)(ws + WS_XQ) + (size_t)row * DM : nullptr, C.lane); }
    }
}

template <unsigned MASK> __global__ void __launch_bounds__(NTHR, 2) mk_fwd(Args args) {
    extern __shared__ __attribute__((aligned(16))) unsigned char lds_raw[];
    Ctx C;
    C.lds = (LAS unsigned char*)lds_raw; C.tid = threadIdx.x; C.lane = C.tid & 63; C.wave = __builtin_amdgcn_readfirstlane(C.tid >> 6); C.G = gridDim.x; C.bid = blockIdx.x;
    C.ws = args.ws; C.out = args.out;
    volatile LAS unsigned* MISC = (volatile LAS unsigned*)(C.lds + MISC_OFF);
    if (C.tid < 32) MISC[C.tid] = 0u;
    __syncthreads();
    unsigned char* ws = args.ws; ArgsK* ap;
    unsigned* ctl = (unsigned*)(ws + WS_CTL);
#if MK_ONE_LAUNCH
    XcdBarrier bar = xcd_barrier_post(ctl + CW_BAR, MISC + 8);
#define GRID_BAR() xcd_barrier(bar)
#else
#define GRID_BAR() do { } while (0)
#endif
    const int lo = args.ph_lo, hi = args.ph_hi;
#if MK_ONE_LAUNCH
#define IN(k) true
#else
#define IN(k) (((MASK >> ((k) % NPH)) & 1u) && lo <= (k) && (k) < hi)
#endif
#if MK_ONE_LAUNCH
#define BOTH(k) true
#else
#define BOTH(k) (IN(k) && IN((k) + 1))
#endif
#define OPAQUE_WS() do { ap = (ArgsK*)__builtin_amdgcn_kernarg_segment_ptr(); asm volatile("" : "+s"(ap)); ws = gptr(ap->ws); } while (0)
    for (int l = 0; l < 2; ++l) {
        OPAQUE_WS();
        const int pb = l * NPH;
        float* rsq_q = (float*)(ws + WS_RSQQ); float* rsq_kv = (float*)(ws + WS_RSQKV);
        for (int rep_ = 0; rep_ < REPN(0); ++rep_) if constexpr ((MASK >> 0) & 1u) if (IN(pb + 0)) { OPAQUE_WS(); C.ws = ws; { int t_ = threadIdx.x; asm volatile("" : "+v"(t_)); C.tid = t_; C.lane = t_ & 63; C.wave = __builtin_amdgcn_readfirstlane(t_ >> 6); int b_ = blockIdx.x, g_ = gridDim.x; asm volatile("" : "+s"(b_), "+s"(g_)); C.bid = b_; C.G = g_; }     phase_convert(C, ap, l); if (BOTH(pb + 0)) GRID_BAR(); }
        for (int rep_ = 0; rep_ < REPN(1); ++rep_) if constexpr ((MASK >> 1) & 1u) if (IN(pb + 1)) { OPAQUE_WS(); C.ws = ws; { int t_ = threadIdx.x; asm volatile("" : "+v"(t_)); C.tid = t_; C.lane = t_ & 63; C.wave = __builtin_amdgcn_readfirstlane(t_ >> 6); int b_ = blockIdx.x, g_ = gridDim.x; asm volatile("" : "+s"(b_), "+s"(g_)); C.bid = b_; C.G = g_; }
            { DenseSched S; S.so.init(T, PC, C.G, C.bid); S.A = (const char*)(ws + WS_XQ); S.B = (const char*)(ws + WS_WIN); S.lda = DM; S.ldb = DM; S.nt = DM / 128;
              EpiInProj E{(bf16_t*)(ws + WS_P), rsq_q, rsq_kv};
              gm::gemm_phase<EpiInProj, DenseSched, false, false, true>(C.lds, DM, DM, S, E); }
            if (BOTH(pb + 1)) GRID_BAR(); }
        for (int rep_ = 0; rep_ < REPN(2); ++rep_) if constexpr ((MASK >> 2) & 1u) if (IN(pb + 2)) { OPAQUE_WS(); C.ws = ws; { int t_ = threadIdx.x; asm volatile("" : "+v"(t_)); C.tid = t_; C.lane = t_ & 63; C.wave = __builtin_amdgcn_readfirstlane(t_ >> 6); int b_ = blockIdx.x, g_ = gridDim.x; asm volatile("" : "+s"(b_), "+s"(g_)); C.bid = b_; C.G = g_; }
            if (rep_ == 0) phase_krope(C);
            __syncthreads();
            UpSched S{(const char*)(ws + WS_P), (const char*)(ws + WS_WUQ), (const char*)(ws + WS_WUKV), C.G, C.bid};
            EpiUp E{(bf16_t*)(ws + WS_QM), (bf16_t*)(ws + WS_KF), (bf16_t*)(ws + WS_VM), rsq_q, rsq_kv};
            gm::gemm_phase<EpiUp, UpSched, false, false>(C.lds, PC * 2, 1024, S, E);
            if (BOTH(pb + 2)) GRID_BAR(); }
        for (int rep_ = 0; rep_ < REPN(3); ++rep_) if constexpr ((MASK >> 3) & 1u) if (IN(pb + 3)) { OPAQUE_WS(); C.ws = ws; { int t_ = threadIdx.x; asm volatile("" : "+v"(t_)); C.tid = t_; C.lane = t_ & 63; C.wave = __builtin_amdgcn_readfirstlane(t_ >> 6); int b_ = blockIdx.x, g_ = gridDim.x; asm volatile("" : "+s"(b_), "+s"(g_)); C.bid = b_; C.G = g_; }     phase_attention(C, ap, l); if (BOTH(pb + 3)) GRID_BAR(); }
        for (int rep_ = 0; rep_ < REPN(4); ++rep_) if constexpr ((MASK >> 4) & 1u) if (IN(pb + 4)) { OPAQUE_WS(); C.ws = ws; { int t_ = threadIdx.x; asm volatile("" : "+v"(t_)); C.tid = t_; C.lane = t_ & 63; C.wave = __builtin_amdgcn_readfirstlane(t_ >> 6); int b_ = blockIdx.x, g_ = gridDim.x; asm volatile("" : "+s"(b_), "+s"(g_)); C.bid = b_; C.G = g_; }
            BranchSched S; S.so.init(T, DM, C.G, C.bid); S.A = (const char*)(ws + WS_O); S.B = (const char*)(ws + WS_WBR);
            EpiBranch E{(bf16_t*)(ws + WS_YB), (unsigned char*)(ws + WS_O) + 32 * MiB, (const bf16_t*)(ws + WS_P)};
            gm::gemm_phase<EpiBranch, BranchSched, false, false, true>(C.lds, DM, DM, S, E);
            if (BOTH(pb + 4)) GRID_BAR(); }
        for (int rep_ = 0; rep_ < REPN(5); ++rep_) if constexpr ((MASK >> 5) & 1u) if (IN(pb + 5)) { OPAQUE_WS(); C.ws = ws; { int t_ = threadIdx.x; asm volatile("" : "+v"(t_)); C.tid = t_; C.lane = t_ & 63; C.wave = __builtin_amdgcn_readfirstlane(t_ >> 6); int b_ = blockIdx.x, g_ = gridDim.x; asm volatile("" : "+s"(b_), "+s"(g_)); C.bid = b_; C.G = g_; }
            DenseSched S; S.so.init(T, DM, C.G, C.bid); S.A = (const char*)(ws + WS_O) + 32 * MiB; S.B = (const char*)(ws + WS_WOUT); S.lda = DM; S.ldb = DM; S.nt = DM / 128;
            EpiOut E{(bf16_t*)(ws + WS_X1F), (const bf16_t*)(ws + WS_XB)};
            gm::gemm_phase<EpiOut, DenseSched, false, true, true>(C.lds, DM, DM, S, E);
            if (BOTH(pb + 5)) GRID_BAR(); }
        for (int rep_ = 0; rep_ < REPN(6); ++rep_) if constexpr ((MASK >> 6) & 1u) if (IN(pb + 6)) { OPAQUE_WS(); C.ws = ws; { int t_ = threadIdx.x; asm volatile("" : "+v"(t_)); C.tid = t_; C.lane = t_ & 63; C.wave = __builtin_amdgcn_readfirstlane(t_ >> 6); int b_ = blockIdx.x, g_ = gridDim.x; asm volatile("" : "+s"(b_), "+s"(g_)); C.bid = b_; C.G = g_; }     phase_ln_mix(C, ap, l); if (BOTH(pb + 6)) GRID_BAR(); }
        for (int rep_ = 0; rep_ < REPN(7); ++rep_) if constexpr ((MASK >> 7) & 1u) if (IN(pb + 7)) { OPAQUE_WS(); C.ws = ws; { int t_ = threadIdx.x; asm volatile("" : "+v"(t_)); C.tid = t_; C.lane = t_ & 63; C.wave = __builtin_amdgcn_readfirstlane(t_ >> 6); int b_ = blockIdx.x, g_ = gridDim.x; asm volatile("" : "+s"(b_), "+s"(g_)); C.bid = b_; C.G = g_; }
            RouterSched S{(const char*)(ws + WS_X1B), (const char*)(ws + WS_WR), C.G, C.bid};
            EpiLogit E{(float*)(ws + WS_O1)};
            gm::gemm_phase<EpiLogit, RouterSched, false, false>(C.lds, DM * 2, DM * 2, S, E);
            if (BOTH(pb + 7)) GRID_BAR(); }
        for (int rep_ = 0; rep_ < REPN(8); ++rep_) if constexpr ((MASK >> 8) & 1u) if (IN(pb + 8)) { OPAQUE_WS(); C.ws = ws; { int t_ = threadIdx.x; asm volatile("" : "+v"(t_)); C.tid = t_; C.lane = t_ & 63; C.wave = __builtin_amdgcn_readfirstlane(t_ >> 6); int b_ = blockIdx.x, g_ = gridDim.x; asm volatile("" : "+s"(b_), "+s"(g_)); C.bid = b_; C.G = g_; }     phase_route(C, ap, l); if (BOTH(pb + 8)) GRID_BAR(); }
        for (int rep_ = 0; rep_ < REPN(9); ++rep_) if constexpr ((MASK >> 9) & 1u) if (IN(pb + 9)) { OPAQUE_WS(); C.ws = ws; { int t_ = threadIdx.x; asm volatile("" : "+v"(t_)); C.tid = t_; C.lane = t_ & 63; C.wave = __builtin_amdgcn_readfirstlane(t_ >> 6); int b_ = blockIdx.x, g_ = gridDim.x; asm volatile("" : "+s"(b_), "+s"(g_)); C.bid = b_; C.G = g_; }     phase_scatter(C, l); if (BOTH(pb + 9)) GRID_BAR(); }
        for (int rep_ = 0; rep_ < REPN(10); ++rep_) if constexpr ((MASK >> 10) & 1u) if (IN(pb + 10)) { OPAQUE_WS(); C.ws = ws; { int t_ = threadIdx.x; asm volatile("" : "+v"(t_)); C.tid = t_; C.lane = t_ & 63; C.wave = __builtin_amdgcn_readfirstlane(t_ >> 6); int b_ = blockIdx.x, g_ = gridDim.x; asm volatile("" : "+s"(b_), "+s"(g_)); C.bid = b_; C.G = g_; }
            build_moe_tables<false>(C, l, (LAS int*)C.lds);
            LAS unsigned char* tab = C.lds + TAB_OFF;
            {
                const LAS int* misc = (const LAS int*)(tab + TAB_MISC); const int nrt = misc[0], ntl = misc[1]; const int* stok = (const int*)(ws + WS_STOK);
                LAS unsigned* idx = (LAS unsigned*)(tab + TAB_IDX);
#pragma nounroll
                for (int i = 0; i < 10; ++i) { const int L = xcd_chunk_unit(i, C.bid, C.G, ntl * 4); if (L < 0) break; const int tile = L >> 2;
                    if (C.tid < 256) { idx[i * 256 + C.tid] = tile < nrt ? (unsigned)stok[tile * 256 + C.tid] : (unsigned)((tile - nrt) * 256 + C.tid);
                        ((LAS float*)(tab + TAB_SW))[i * 256 + C.tid] = tile < nrt ? ((const float*)(ws + WS_SW))[tile * 256 + C.tid] : 1.f; } }
                __syncthreads();
            }
            Moe1Sched S1{tab, (const char*)(ws + WS_X1Q), (const char*)(ws + WS_W13), C.G, C.bid};
            EpiMoe1 E1{(unsigned char*)(ws + WS_HID), (const LAS float*)(tab + TAB_SW)};
            gm::gemm_phase<EpiMoe1, Moe1Sched, true, false, true>(C.lds, DM, DM, S1, E1);
#if MK_ONE_LAUNCH
            GRID_BAR();
#endif
        }
        if constexpr (((MASK >> 10) & 1u) && MK_ONE_LAUNCH) if (IN(pb + 10)) { OPAQUE_WS(); C.ws = ws; { int t_ = threadIdx.x; asm volatile("" : "+v"(t_)); C.tid = t_; C.lane = t_ & 63; C.wave = __builtin_amdgcn_readfirstlane(t_ >> 6); int b_ = blockIdx.x, g_ = gridDim.x; asm volatile("" : "+s"(b_), "+s"(g_)); C.bid = b_; C.G = g_; }
            LAS unsigned char* tab = C.lds + TAB_OFF;
            Moe2Sched S2{tab, (const char*)(ws + WS_HID), (const char*)(ws + WS_W2), C.G, C.bid};
            EpiMoe2 E2{(unsigned char*)(ws + WS_YS)};
            for (int rep_ = 0; rep_ < REPN(11); ++rep_) { gm::gemm_phase<EpiMoe2, Moe2Sched, false, false, true>(C.lds, FF, FF, S2, E2);
            GRID_BAR(); }
            for (int rep_ = 0; rep_ < REPN(12); ++rep_) { phase_combine(C, ap, l);
            if (l == 0 || rep_ + 1 < REPN(12)) GRID_BAR(); }
        }
    }
#undef IN
#undef BOTH
}

#if !MK_ONE_LAUNCH
__global__ void __launch_bounds__(NTHR, 2) mk_moe2(Args args, int l) {
    extern __shared__ __attribute__((aligned(16))) unsigned char lds_raw[];
    Ctx C; C.lds = (LAS unsigned char*)lds_raw; C.tid = threadIdx.x; C.lane = C.tid & 63; C.wave = __builtin_amdgcn_readfirstlane(C.tid >> 6); C.G = gridDim.x; C.bid = blockIdx.x; C.ws = args.ws; C.out = args.out;
    build_moe_tables<false>(C, l, (LAS int*)C.lds);
    LAS unsigned char* tab = C.lds + TAB_OFF; unsigned char* ws = args.ws;
    Moe2Sched S2{tab, (const char*)(ws + WS_HID), (const char*)(ws + WS_W2), C.G, C.bid};
    EpiMoe2 E2{(unsigned char*)(ws + WS_YS)};
    gm::gemm_phase<EpiMoe2, Moe2Sched, false, false, true>(C.lds, FF, FF, S2, E2);
}
__global__ void __launch_bounds__(NTHR, 2) mk_combine(Args args, int l) {
    extern __shared__ __attribute__((aligned(16))) unsigned char lds_raw[];
    Ctx C; C.lds = (LAS unsigned char*)lds_raw; C.tid = threadIdx.x; C.lane = C.tid & 63; C.wave = __builtin_amdgcn_readfirstlane(C.tid >> 6); C.G = gridDim.x; C.bid = blockIdx.x; C.ws = args.ws; C.out = args.out;
    phase_combine(C, (ArgsK*)__builtin_amdgcn_kernarg_segment_ptr(), l);
}
#endif


#ifdef DBG_STOP
__global__ void dbg_gather(const unsigned short* H, const unsigned short* YS, const int* rpos, float* out, int mode) {
    const size_t n = (size_t)T * DM;
    for (size_t i = (size_t)blockIdx.x * blockDim.x + threadIdx.x; i < n; i += (size_t)gridDim.x * blockDim.x) {
        if (mode == 9) { const size_t q = i % 131072; const int p = rpos[q]; const int* stok = (const int*)H; const float* sw = (const float*)YS; const bool oor = (p < 0 || p >= 147456);
#if DBG_SUB == 0
            out[i] = oor ? 1.f : 0.f;
#elif DBG_SUB == 1
            out[i] = oor ? 0.f : (stok[p] != (int)(q / 8) ? 1.f : 0.f);
#else
            out[i] = oor ? 0.f : sw[p];
#endif
            }
        else if (mode == 10) { const size_t t = i / 4096, k = (i / 512) % 8, c = i % 512; out[i] = __uint_as_float(((unsigned)H[(size_t)rpos[t * 8 + k] * 512 + c]) << 16); }
        else { const size_t t = i / 2048, c = i % 2048; float s = 0.f; for (int k = 0; k < 8; ++k) s += __uint_as_float(((unsigned)YS[(size_t)rpos[t * 8 + k] * 2048 + c]) << 16); out[i] = s; }
    }
}
__global__ void dbg_copy(const void* src, int is_f32, float* out, size_t n, size_t nsrc) {
    for (size_t i = (size_t)blockIdx.x * blockDim.x + threadIdx.x; i < n; i += (size_t)gridDim.x * blockDim.x) {
        const size_t j = i % nsrc; out[i] = is_f32 ? ((const float*)src)[j] : __uint_as_float(((unsigned)((const unsigned short*)src)[j]) << 16); }
}
#endif
#if MK_ONE_LAUNCH
static hipError_t set_attr_all() { return hipFuncSetAttribute((const void*)mk_fwd<0x7ffu>, hipFuncAttributeMaxDynamicSharedMemorySize, LDS_BYTES); }
#else
template <unsigned M> static hipError_t set_attr_one() { return hipFuncSetAttribute((const void*)mk_fwd<M>, hipFuncAttributeMaxDynamicSharedMemorySize, LDS_BYTES); }
static hipError_t set_attr_all() { hipError_t e = hipSuccess, r;
    r = set_attr_one<1u>(); if (r != hipSuccess) e = r; r = set_attr_one<2u>(); if (r != hipSuccess) e = r; r = set_attr_one<4u>(); if (r != hipSuccess) e = r; r = set_attr_one<8u>(); if (r != hipSuccess) e = r;
    r = set_attr_one<16u>(); if (r != hipSuccess) e = r; r = set_attr_one<32u>(); if (r != hipSuccess) e = r; r = set_attr_one<64u>(); if (r != hipSuccess) e = r; r = set_attr_one<128u>(); if (r != hipSuccess) e = r;
    r = set_attr_one<256u>(); if (r != hipSuccess) e = r; r = set_attr_one<512u>(); if (r != hipSuccess) e = r; r = set_attr_one<1024u>(); if (r != hipSuccess) e = r; return e; }
static void launch_phase(int k, int grid, hipStream_t stream, const Args& a) {
    switch (k) {
    case 0: hipLaunchKernelGGL(mk_fwd<1u>, dim3(grid), dim3(NTHR), LDS_BYTES, stream, a); break;
    case 1: hipLaunchKernelGGL(mk_fwd<2u>, dim3(grid), dim3(NTHR), LDS_BYTES, stream, a); break;
    case 2: hipLaunchKernelGGL(mk_fwd<4u>, dim3(grid), dim3(NTHR), LDS_BYTES, stream, a); break;
    case 3: hipLaunchKernelGGL(mk_fwd<8u>, dim3(grid), dim3(NTHR), LDS_BYTES, stream, a); break;
    case 4: hipLaunchKernelGGL(mk_fwd<16u>, dim3(grid), dim3(NTHR), LDS_BYTES, stream, a); break;
    case 5: hipLaunchKernelGGL(mk_fwd<32u>, dim3(grid), dim3(NTHR), LDS_BYTES, stream, a); break;
    case 6: hipLaunchKernelGGL(mk_fwd<64u>, dim3(grid), dim3(NTHR), LDS_BYTES, stream, a); break;
    case 7: hipLaunchKernelGGL(mk_fwd<128u>, dim3(grid), dim3(NTHR), LDS_BYTES, stream, a); break;
    case 8: hipLaunchKernelGGL(mk_fwd<256u>, dim3(grid), dim3(NTHR), LDS_BYTES, stream, a); break;
    case 9: hipLaunchKernelGGL(mk_fwd<512u>, dim3(grid), dim3(NTHR), LDS_BYTES, stream, a); break;
    default: hipLaunchKernelGGL(mk_fwd<1024u>, dim3(grid), dim3(NTHR), LDS_BYTES, stream, a); break;
    }
}
#endif

extern "C" void kernel_launch(void* const* d_in, const int* in_sizes, int n_in, void* d_out, int out_size, void* d_ws, size_t ws_size, hipStream_t stream) {
    static int grid = 0;
    if (grid == 0) {
        if (n_in != 26 || out_size != T * DM || ws_size < WS_END) { fprintf(stderr, "kernel_launch: unexpected shapes (n_in %d out %d ws %zu need %zu)\n", n_in, out_size, ws_size, (size_t)WS_END); grid = -1; return; }
        int dev = 0, cus = 0;
        if (hipGetDevice(&dev) != hipSuccess || hipDeviceGetAttribute(&cus, hipDeviceAttributeMultiprocessorCount, dev) != hipSuccess) { grid = -1; return; }
        if (set_attr_all() != hipSuccess) { fprintf(stderr, "kernel_launch: hipFuncSetAttribute failed\n"); grid = -1; return; }
#if !MK_ONE_LAUNCH
        (void)hipFuncSetAttribute((const void*)mk_moe2, hipFuncAttributeMaxDynamicSharedMemorySize, LDS_BYTES);
        (void)hipFuncSetAttribute((const void*)mk_combine, hipFuncAttributeMaxDynamicSharedMemorySize, LDS_BYTES);
#endif
        int per_cu = 0;
        if (hipOccupancyMaxActiveBlocksPerMultiprocessor(&per_cu, (const void*)mk_fwd<MK_ONE_LAUNCH ? 0x7ffu : 0x2u>, NTHR, LDS_BYTES) != hipSuccess || per_cu < 1) fprintf(stderr, "kernel_launch: occupancy query says %d\n", per_cu);
        (void)hipGetLastError();
        grid = cus > 256 ? 256 : cus;
    }
    if (grid < 0) return;
    (void)hipMemsetAsync((char*)d_ws + WS_CTL, 0, CTL_ZERO_BYTES, stream);
    Args a{};
    for (int i = 0; i < 26; ++i) a.in[i] = (const float*)d_in[i];
    a.out = (float*)d_out; a.ws = (unsigned char*)d_ws;
    for (int j = 0; j < 8; ++j) a.invf[j] = (float)pow(500000.0, -(double)(2 * j) / 16.0);
    for (int j = 0; j < 32; ++j) a.invf[8 + j] = (float)pow(500000.0, -(double)(2 * j) / 64.0);
    for (int j = 0; j < 16; ++j) a.invf[40 + j] = (float)pow(500000.0, -(double)(2 * j) / 32.0);
#if MK_ONE_LAUNCH
    a.ph_lo = 0; a.ph_hi = 2 * NPH;
    hipLaunchKernelGGL(mk_fwd<0x7ffu>, dim3(grid), dim3(NTHR), LDS_BYTES, stream, a);
#else
#ifdef DBG_STOP
    {
        const int l = 0;
        for (int k = 0; k < NPH && k <= DBG_STOP; ++k) { a.ph_lo = l * NPH + k; a.ph_hi = a.ph_lo + 1; launch_phase(k, grid, stream, a); }
        if (DBG_STOP >= 11) hipLaunchKernelGGL(mk_moe2, dim3(grid), dim3(NTHR), LDS_BYTES, stream, a, l);
        if (DBG_STOP >= 12) hipLaunchKernelGGL(mk_combine, dim3(grid), dim3(NTHR), LDS_BYTES, stream, a, l);
        const size_t n = (size_t)T * DM; unsigned char* w = (unsigned char*)d_ws;
        const void* src; int f32 = 0; size_t nsrc = n;
        switch (DBG_STOP) {
        case 0: src = w + WS_WIN; nsrc = (size_t)10240 * 2048; break;
        case 1: src = w + WS_P; break;
        case 2: src = w + WS_QM; nsrc = (size_t)T * (1536 + 1536 + 1024); break;
        case 3: src = w + WS_O; break;
        case 4: src = w + WS_YB; break;
        case 5: src = w + WS_X1F; f32 = 1; break;
        case 6: src = w + WS_X1B; break;
        case 7: src = w + WS_LOGIT; f32 = 1; nsrc = (size_t)T * 64; break;
        case 8: src = w + WS_RW; f32 = 1; nsrc = (size_t)T * 8; break;
        default: src = w + WS_X2F; f32 = 1; break;
        }
        if (DBG_STOP == 9) hipLaunchKernelGGL(dbg_gather, dim3(1024), dim3(256), 0, stream, (const unsigned short*)(w + WS_STOK), (const unsigned short*)(w + WS_SW), (const int*)(w + WS_RPOS), (float*)d_out, 9);
        else if (DBG_STOP == 10 || DBG_STOP == 11) hipLaunchKernelGGL(dbg_gather, dim3(1024), dim3(256), 0, stream, (const unsigned short*)(w + WS_HID), (const unsigned short*)(w + WS_YS), (const int*)(w + WS_RPOS), (float*)d_out, (int)DBG_STOP);
        else hipLaunchKernelGGL(dbg_copy, dim3(1024), dim3(256), 0, stream, src, f32, (float*)d_out, n, nsrc);
    }
#else
    for (int l = 0; l < 2; ++l) {
        for (int k = 0; k < NPH; ++k) { a.ph_lo = l * NPH + k; a.ph_hi = a.ph_lo + 1; launch_phase(k, grid, stream, a); }
        hipLaunchKernelGGL(mk_moe2, dim3(grid), dim3(NTHR), LDS_BYTES, stream, a, l);
        hipLaunchKernelGGL(mk_combine, dim3(grid), dim3(NTHR), LDS_BYTES, stream, a, l);
    }
#endif
#endif
}
```

```cpp
#include <hip/hip_runtime.h>
#include <cstdio>
#include <cstdint>
#include <cmath>

#ifndef REP_MASK
#define REP_MASK 0
#endif
#define REPN(k) (((REP_MASK >> (k)) & 1) ? 2 : 1)
#ifndef MK_ONE_LAUNCH
#define MK_ONE_LAUNCH 1
#endif

#define LAS __attribute__((address_space(3)))
#define GAS __attribute__((address_space(1)))
typedef unsigned short bf16_t;
typedef short bf16x8 __attribute__((ext_vector_type(8)));
typedef short s16x4 __attribute__((ext_vector_type(4)));
typedef float f32x4 __attribute__((ext_vector_type(4)));
typedef float f32x2 __attribute__((ext_vector_type(2)));
typedef float f32x16 __attribute__((ext_vector_type(16)));
typedef unsigned u32x4 __attribute__((ext_vector_type(4)));
typedef unsigned u32x2 __attribute__((ext_vector_type(2)));
typedef int v4i16_t __attribute__((ext_vector_type(2)));

constexpr int NB = 8, SEQ = 2048, T = NB * SEQ, DM = 2048;
constexpr int PC = 10240;
constexpr int C_DQ = 0, C_DK = 512, C_DV = 1024, C_CQ = 1536, C_CKV = 2048, C_MQ = 2304, C_MK = 2816, C_MV = 3328, C_G = 3840, C_KPE = 9984;
constexpr int IN_COLS = 10048;
constexpr int NEXP = 64, FF = 512;
constexpr int RT_ROWS = 147456;
constexpr int SR_ROWS = RT_ROWS + T;
constexpr int NRT = 56;
constexpr float NORM_EPS = 1e-5f;
constexpr float DN_ALPHA = 1.4142135623730951f;
constexpr int NPH = 11;

constexpr size_t MiB = 1u << 20;
constexpr size_t WS_CTL = 0, CTL_ZERO_BYTES = 1 * MiB;
constexpr int CW_BAR = 4096;
constexpr int CW_AQ = 8448;
#ifndef CVT_NC
#define CVT_NC 96
#endif
constexpr int CW_ECNT = 8192;
constexpr size_t WS_RSQQ = 52 * MiB, WS_RSQKV = 53 * MiB;
constexpr size_t WS_COS = 1 * MiB, WS_SIN = 5 * MiB;
constexpr size_t WS_KMEAN = 9 * MiB;
constexpr size_t WS_LOGIT = 10 * MiB;
constexpr size_t WS_RIDX = 14 * MiB, WS_RW = 14 * MiB + 512 * 1024, WS_RPOS = 15 * MiB, WS_BBASE = 15 * MiB + 512 * 1024;
constexpr size_t WS_STOK = 16 * MiB, WS_SW = 17 * MiB;
constexpr size_t WS_O1 = 18 * MiB;
constexpr size_t WS_WIN = 64 * MiB, WS_WUQ = 104 * MiB, WS_WUKV = 106 * MiB, WS_WR = 108 * MiB, WS_WBR = 109 * MiB, WS_WOUT = 117 * MiB;
constexpr size_t WS_W13 = 125 * MiB, WS_W2 = 385 * MiB;
constexpr size_t WS_XB = 515 * MiB, WS_X1F = 579 * MiB, WS_X1B = 707 * MiB, WS_X2F = 771 * MiB, WS_HID = 899 * MiB;
constexpr size_t WS_BIG = 1059 * MiB;
constexpr size_t WS_P = WS_BIG, WS_QM = WS_P + 320 * MiB, WS_KF = WS_QM + 48 * MiB, WS_VM = WS_KF + 48 * MiB, WS_O = WS_VM + 32 * MiB, WS_YB = WS_O + 64 * MiB;
constexpr size_t WS_X1Q = WS_HID + 80 * MiB;
constexpr size_t WS_XQ = WS_X1Q + 32 * MiB;
constexpr size_t WS_WINQ = WS_WIN + 20 * MiB;
static_assert(WS_XQ + 32 * MiB <= WS_BIG, "ws map");
constexpr size_t WS_YS = WS_BIG;
constexpr size_t WS_END = WS_BIG + 640 * MiB;
static_assert(WS_YB + 64 * MiB <= WS_END && WS_HID + (size_t)SR_ROWS * FF * 2 <= WS_BIG, "ws map");

constexpr int RING_BYTES = 131072;
constexpr int TAB_OFF = RING_BYTES;
constexpr int TAB_BYTES = 24576;
constexpr int MISC_OFF = TAB_OFF + TAB_BYTES;
constexpr int LDS_BYTES = 157696;
static_assert(MISC_OFF + 128 <= LDS_BYTES, "lds map");
constexpr int NWAVES = 8, NTHR = 512;

__device__ __forceinline__ unsigned cvt_pk_bf16(float lo, float hi) { unsigned r; asm volatile("v_cvt_pk_bf16_f32 %0, %1, %2" : "=v"(r) : "v"(lo), "v"(hi)); return r; }
__device__ __forceinline__ float bf2f(unsigned short b) { return __uint_as_float(((unsigned)b) << 16); }
__device__ __forceinline__ float bflo(unsigned w) { return __uint_as_float(w << 16); }
__device__ __forceinline__ float bfhi(unsigned w) { return __uint_as_float(w & 0xffff0000u); }
__device__ __forceinline__ bf16x8 pack8(f32x4 a, f32x4 b) { u32x4 w = {cvt_pk_bf16(a[0], a[1]), cvt_pk_bf16(a[2], a[3]), cvt_pk_bf16(b[0], b[1]), cvt_pk_bf16(b[2], b[3])}; return __builtin_bit_cast(bf16x8, w); }
typedef int v8i32 __attribute__((ext_vector_type(8)));
__device__ __forceinline__ unsigned pk4_fp8(float a, float b, float c, float d) { unsigned w = 0; w = __builtin_amdgcn_cvt_pk_fp8_f32(a, b, w, false); w = __builtin_amdgcn_cvt_pk_fp8_f32(c, d, w, true); return w; }
__device__ __forceinline__ float clamp8(float v) { return __builtin_amdgcn_fmed3f(v, -440.f, 440.f); }
constexpr float W8_SCALE = 64.f, H8_SCALE = 8.f, O8_SCALE = 16.f, Y8_SCALE = 8.f, YS8_SCALE = 16.f;
__device__ __forceinline__ void fp8x4_to_f32(unsigned w, float (&o)[4]) { const f32x2 a = __builtin_amdgcn_cvt_pk_f32_fp8((int)w, false), b = __builtin_amdgcn_cvt_pk_f32_fp8((int)w, true); o[0] = a[0]; o[1] = a[1]; o[2] = b[0]; o[3] = b[1]; }
__device__ __forceinline__ float wave_sum(float v) {
#pragma unroll
    for (int o = 1; o < 64; o <<= 1) v += __shfl_xor(v, o);
    return v;
}
__device__ __forceinline__ float sigmoidf_(float x) { return __builtin_amdgcn_rcpf(1.f + __builtin_amdgcn_exp2f(x * -1.4426950408889634f)); }

#define XB_TMO      128
#define XB_XCNT(j)  (256  + 64 * (j))
#define XB_XSUB(j)  (1280 + 64 * (j))
#define XB_XGEN(j)  (2304 + 64 * (j))
#define XB_TOP      3328
#define XB_TOPGEN   3392
#define XCD_BAR_WORDS 3456
#define XB_SPIN_CAP (1u << 20)
__device__ __forceinline__ unsigned xb_ld(unsigned* p)              { return __hip_atomic_load(p, __ATOMIC_RELAXED, __HIP_MEMORY_SCOPE_AGENT); }
__device__ __forceinline__ unsigned xb_add(unsigned* p, unsigned v) { return __hip_atomic_fetch_add(p, v, __ATOMIC_RELAXED, __HIP_MEMORY_SCOPE_AGENT); }
__device__ __forceinline__ unsigned xb_xcc_id() { return (unsigned)__builtin_amdgcn_s_getreg((3 << 11) | 20) & 0xFu; }
#define XB_SPIN(cond, bar) do { unsigned _sp = 0; while (cond) { __builtin_amdgcn_s_sleep(1); \
    if ((++_sp & 255u) == 0u) { if (xb_ld(&(bar)[XB_TMO])) break; if (_sp > XB_SPIN_CAP) { atomicAdd(&(bar)[XB_TMO], 1u); break; } } } } while (0)
struct XcdBarrier { unsigned* bar; unsigned x; volatile LAS unsigned* st; };
__device__ __forceinline__ XcdBarrier xcd_barrier_post(unsigned* bar, volatile LAS unsigned* st) {
    XcdBarrier b; b.bar = bar; b.x = xb_xcc_id(); b.st = st;
    if (threadIdx.x == 0) (void)xb_add(&bar[XB_XCNT(b.x)], 1u);
    return b;
}
__device__ __forceinline__ void xcd_barrier_complete(unsigned* bar, unsigned x, unsigned& nloc, unsigned& nx) {
    asm volatile("" : "+v"(x));
    const unsigned G = gridDim.x * gridDim.y * gridDim.z;
    unsigned sum, cnt, mine, sp = 0u;
    for (;;) {
        sum = 0u; cnt = 0u; mine = 0u;
#pragma unroll
        for (unsigned j = 0; j < 16; ++j) { const unsigned c = xb_ld(&bar[XB_XCNT(j)]); sum += c; cnt += (c > 0u) ? 1u : 0u; mine = (j == x) ? c : mine; }
        if (sum == G) break;
        __builtin_amdgcn_s_sleep(1);
        if ((++sp & 255u) == 0u) { if (xb_ld(&bar[XB_TMO])) break; if (sp > XB_SPIN_CAP) { atomicAdd(&bar[XB_TMO], 1u); break; } }
    }
    nloc = mine > 0u ? mine : 1u; nx = cnt > 0u ? cnt : 1u;
}
__device__ __forceinline__ void xcd_barrier(const XcdBarrier& b) {
    asm volatile("s_waitcnt vmcnt(0)" ::: "memory");
    __syncthreads();
    if (threadIdx.x == 0) {
        GAS unsigned* barg_ = (GAS unsigned*)b.bar; asm volatile("" : "+v"(barg_)); unsigned* bar = (unsigned*)barg_;
        __builtin_amdgcn_s_waitcnt(0);
        unsigned nloc = b.st[0], nx = b.st[1];
        if (nloc == 0u) { xcd_barrier_complete(bar, b.x, nloc, nx); b.st[0] = nloc; b.st[1] = nx; }
        const unsigned old = xb_add(&bar[XB_XSUB(b.x)], 1u);
        const unsigned gen = old / nloc;
        if (old + 1u == (gen + 1u) * nloc) {
            __builtin_amdgcn_fence(__ATOMIC_RELEASE, "agent");
            asm volatile("s_waitcnt vmcnt(0)" ::: "memory");
            const unsigned og = xb_add(&bar[XB_TOP], 1u);
            const unsigned tg = og / nx;
            if (og + 1u == (tg + 1u) * nx) xb_add(&bar[XB_TOPGEN], 1u);
            else XB_SPIN(xb_ld(&bar[XB_TOPGEN]) == tg, bar);
            __builtin_amdgcn_fence(__ATOMIC_ACQUIRE, "agent");
            xb_add(&bar[XB_XGEN(b.x)], 1u);
            asm volatile("s_waitcnt vmcnt(0)" ::: "memory");
        } else {
            XB_SPIN(xb_ld(&bar[XB_XGEN(b.x)]) == gen, bar);
            __builtin_amdgcn_fence(__ATOMIC_ACQUIRE, "agent");
            asm volatile("s_waitcnt vmcnt(0)" ::: "memory");
        }
    }
    __syncthreads();
}

namespace gm {
constexpr int BM = 256, BK = 64, HALF = 128, HTB = HALF * BK * 2, STAGE_BYTES = 8 * HTB, NXCD = 8, WGM = 8;
__device__ __forceinline__ int lds_byte(int r, int c) { const int st = (r >> 4) * 2 + (c >> 5), rr = r & 15, cc = c & 31, ob = rr * 64 + cc * 2; return st * 1024 + (ob ^ (((ob >> 9) & 1) << 5)); }
__device__ __forceinline__ void stage_rc(int b, int& R, int& C) { const int st = b / 1024, sb = b % 1024, swz = sb ^ (((sb >> 9) & 1) << 5); R = (st >> 1) * 16 + swz / 64; C = (st & 1) * 32 + (swz % 64) / 2; }
__device__ __forceinline__ int perm32(int rho) { const int n = rho >> 4, i = rho & 15; return 8 * (i >> 2) + 4 * n + (i & 3); }
struct Unit { int pm, pn; };
struct StaticOrder {
    int nM, nN, nwg, G, c;
    __device__ void init(int M, int N, int G_, int c_) { nM = M / BM; nN = N / BM; nwg = nM * nN; G = G_; c = c_; }
    __device__ bool next(int i, Unit& u) const {
        const long L = (long)i * G + c; if (L >= nwg) return false;
        int wgid = (int)L; { const int q = nwg / NXCD, r = nwg % NXCD, xcd = wgid % NXCD, off = wgid / NXCD; wgid = (xcd < r ? xcd * (q + 1) : r * (q + 1) + (xcd - r) * q) + off; }
        const int nig = WGM * nN, gid = wgid / nig, fm = gid * WGM, gsz = (nM - fm) < WGM ? (nM - fm) : WGM;
        u.pm = fm + ((wgid % nig) % gsz); u.pn = (wgid % nig) / gsz; return true;
    }
};
struct GUnit { const char* A; const char* B; int nt; int pm; int pn; int aux; int idx; };

template <class Epi, class Sched, bool GATHER, bool ALIGN_EPI, bool F8 = false>
__device__ __forceinline__ void gemm_phase(LAS unsigned char* lds, const unsigned lda, const unsigned ldb, const Sched& S, const Epi& E) {
    int tid_ = threadIdx.x; asm volatile("" : "+v"(tid_));
    const int tid = tid_, wid = __builtin_amdgcn_readfirstlane(tid >> 6), lane = tid & 63, wr = wid >> 2, wc = wid & 3, fr = lane & 15, fq = lane >> 4;
    unsigned voffA[2], voffB[2], colA[2]; int RA[2];
#pragma unroll
    for (int i = 0; i < 2; ++i) { int R, C; stage_rc(tid * 16 + i * 8192, R, C); const int Rb = (R & ~31) + perm32(R & 31);
        RA[i] = R; colA[i] = (unsigned)C * 2u; voffA[i] = (unsigned)R * lda + (unsigned)C * 2u; voffB[i] = (unsigned)(Epi::COL16 ? (16 * (Rb >> 3) + (Rb & 7)) : Rb) * ldb + (unsigned)C * 2u; }
    const size_t kstep = (size_t)(BK * 2);
    const size_t hA = GATHER ? 0 : (size_t)HALF * lda, hB = (size_t)(Epi::COL16 ? 8 : HALF) * ldb;
    const unsigned ldsw = (unsigned)wid * 1024u;
    const int aoff = lds_byte(wr * 64 + fr, fq * 8), boff = lds_byte(wc * 32 + fr, fq * 8);
    unsigned gcur[2][2];
#define GM_SA(b, h) (((b) * 2 + (h)) * HTB)
#define GM_SB(b, h) ((4 + (b) * 2 + (h)) * HTB)
#define GM_STAGE_B(bufoff, gbase) do { _Pragma("unroll") for (int _i = 0; _i < 2; ++_i) \
        __builtin_amdgcn_global_load_lds((const unsigned*)((const char*)(gbase) + voffB[_i]), (LAS unsigned*)(lds + (bufoff) + ldsw + _i * 8192), 16, 0, 0); } while (0)
#define GM_STAGE_A(bufoff, gbase, h, nx) do { _Pragma("unroll") for (int _i = 0; _i < 2; ++_i) { \
        unsigned _vo = GATHER ? gcur[h][_i] : voffA[_i]; if (GATHER && (nx) && has_next) _vo = S.rowoff(ui + 1, (h) * HALF + RA[_i]) * lda + colA[_i]; \
        __builtin_amdgcn_global_load_lds((const unsigned*)((const char*)(gbase) + (size_t)(h) * hA + _vo), (LAS unsigned*)(lds + (bufoff) + ldsw + _i * 8192), 16, 0, 0); } } while (0)
#define GM_LD8(p_) ({ const u32x4 lo_ = *(const LAS u32x4*)(p_), hi_ = *(const LAS u32x4*)((p_) + 1024); (v8i32){(int)lo_.x, (int)lo_.y, (int)lo_.z, (int)lo_.w, (int)hi_.x, (int)hi_.y, (int)hi_.z, (int)hi_.w}; })
#define GM_LDA(dst, b, h) do { if constexpr (F8) { _Pragma("unroll") for (int m = 0; m < 4; ++m) dst##8[m] = GM_LD8(lds + GM_SA(b, h) + aoff + m * 2048); } \
        else { _Pragma("unroll") for (int m = 0; m < 4; ++m) _Pragma("unroll") for (int k = 0; k < 2; ++k) dst[m][k] = *(const LAS bf16x8*)(lds + GM_SA(b, h) + aoff + m * 2048 + k * 1024); } } while (0)
#define GM_LDB(dst, b, h) do { if constexpr (F8) { _Pragma("unroll") for (int n = 0; n < 2; ++n) dst##8[n] = GM_LD8(lds + GM_SB(b, h) + boff + n * 2048); } \
        else { _Pragma("unroll") for (int n = 0; n < 2; ++n) _Pragma("unroll") for (int k = 0; k < 2; ++k) dst[n][k] = *(const LAS bf16x8*)(lds + GM_SB(b, h) + boff + n * 2048 + k * 1024); } } while (0)
#define GM_MMA(ai, bj, At, Bt) do { __builtin_amdgcn_s_setprio(1); _Pragma("unroll") for (int m = 0; m < 4; ++m) _Pragma("unroll") for (int n = 0; n < 2; ++n) { \
        if constexpr (F8) { asm volatile("v_mfma_scale_f32_16x16x128_f8f6f4 %0, %1, %2, %0, %3, %4 op_sel_hi:[0,0,0]" : "+v"(acc[ai][bj][m][n]) : "v"(Bt##8[n]), "v"(At##8[m]), "v"(sc_w), "v"(sc_one)); }   \
        else { _Pragma("unroll") for (int k = 0; k < 2; ++k) acc[ai][bj][m][n] = __builtin_amdgcn_mfma_f32_16x16x32_bf16(Bt[n][k], At[m][k], acc[ai][bj][m][n], 0, 0, 0); } } \
        __builtin_amdgcn_s_setprio(0); } while (0)
#define GM_WAIT_V(n) asm volatile("s_waitcnt vmcnt(" #n ")" ::: "memory")
#define GM_WAIT_L(n) asm volatile("s_waitcnt lgkmcnt(" #n ")" ::: "memory")
#define GM_BAR __builtin_amdgcn_s_barrier()
#define GM_SCHED __builtin_amdgcn_sched_barrier(0)
    GUnit cur, nxt; int ui = 0;
    if (!S.next(0, cur)) return;
    if constexpr (GATHER) {
#pragma unroll
        for (int h = 0; h < 2; ++h)
#pragma unroll
            for (int i = 0; i < 2; ++i) gcur[h][i] = S.rowoff(0, h * HALF + RA[i]) * lda + colA[i];
    }
    f32x4 acc[2][2][4][2];
#pragma unroll
    for (int a = 0; a < 2; ++a)
#pragma unroll
        for (int b = 0; b < 2; ++b)
#pragma unroll
            for (int m = 0; m < 4; ++m)
#pragma unroll
                for (int n = 0; n < 2; ++n) acc[a][b][m][n] = (f32x4){0.f, 0.f, 0.f, 0.f};
    int sc_one = 0x7f7f7f7f, sc_w = 0x01010101 * (127 - Epi::BSH); if constexpr (F8) { asm volatile("" : "+v"(sc_one)); asm volatile("" : "+v"(sc_w)); }
    bf16x8 At[4][2], B0[2][2], B1[2][2]; v8i32 At8[4], B08[2], B18[2];
    const char* cA = cur.A; const char* cB = cur.B;
    {
    const bool has_next = false;
    GM_STAGE_B(GM_SB(0, 0), cB); GM_STAGE_B(GM_SB(0, 1), cB + hB); GM_STAGE_A(GM_SA(0, 0), cA, 0, false); GM_STAGE_A(GM_SA(0, 1), cA, 1, false);
    if (wr == 1) GM_BAR;
    GM_WAIT_V(2); GM_BAR;
    GM_STAGE_B(GM_SB(1, 0), cB + kstep); GM_STAGE_A(GM_SA(1, 0), cA + kstep, 0, false); GM_STAGE_B(GM_SB(1, 1), cB + hB + kstep);
    GM_WAIT_V(6); GM_BAR;
    }
    for (;;) {
        const bool has_next = S.next(ui + 1, nxt);
        const char* nA = has_next ? nxt.A : cA; const char* nB = has_next ? nxt.B : cB;
        const int nt = cur.nt;
#pragma nounroll
        for (int t = 0; t < nt; t += 2) {
            const bool last = (t == nt - 2);
            const char* a1 = cA + (size_t)(t + 1) * kstep;
            const char* a2 = last ? nA : cA + (size_t)(t + 2) * kstep; const char* b2 = last ? nB : cB + (size_t)(t + 2) * kstep;
            const char* a3 = a2 + kstep; const char* b3 = b2 + kstep;
            GM_LDB(B0, 0, 0); GM_LDB(B1, 0, 1); GM_SCHED; GM_LDA(At, 0, 0); GM_STAGE_A(GM_SA(1, 1), a1, 1, false);
            GM_WAIT_V(8); GM_WAIT_L(0); GM_BAR; GM_MMA(0, 0, At, B0); GM_MMA(0, 1, At, B1); GM_BAR; GM_SCHED;
            GM_LDA(At, 0, 1); GM_STAGE_B(GM_SB(0, 0), b2); GM_STAGE_B(GM_SB(0, 1), b2 + hB); GM_STAGE_A(GM_SA(0, 0), a2, 0, last);
            GM_WAIT_V(8); GM_WAIT_L(0); GM_BAR; GM_MMA(1, 0, At, B0); GM_MMA(1, 1, At, B1); GM_BAR; GM_SCHED;
            GM_LDB(B0, 1, 0); GM_LDB(B1, 1, 1); GM_SCHED; GM_LDA(At, 1, 0); GM_STAGE_A(GM_SA(0, 1), a2, 1, last);
            GM_WAIT_V(8); GM_WAIT_L(0); GM_BAR; GM_MMA(0, 0, At, B0); GM_MMA(0, 1, At, B1); GM_BAR; GM_SCHED;
            GM_LDA(At, 1, 1); GM_STAGE_B(GM_SB(1, 0), b3); GM_STAGE_B(GM_SB(1, 1), b3 + hB); GM_STAGE_A(GM_SA(1, 0), a3, 0, last);
            GM_WAIT_V(8); GM_WAIT_L(0); GM_BAR; GM_MMA(1, 0, At, B0); GM_MMA(1, 1, At, B1); GM_BAR; GM_SCHED;
        }
        if constexpr (ALIGN_EPI) { if (wr == 0) GM_BAR; }
        if constexpr (F8) asm volatile("s_nop 15\n\ts_nop 15" ::: "memory");
        E(acc, cur, wr, wc, fr, fq);
        if (!has_next) break;
#pragma unroll
        for (int a = 0; a < 2; ++a)
#pragma unroll
            for (int b = 0; b < 2; ++b)
#pragma unroll
                for (int m = 0; m < 4; ++m)
#pragma unroll
                    for (int n = 0; n < 2; ++n) acc[a][b][m][n] = (f32x4){0.f, 0.f, 0.f, 0.f};
        cur = nxt; cA = nA; cB = nB; ++ui;
        if constexpr (GATHER) {
#pragma unroll
            for (int h = 0; h < 2; ++h)
#pragma unroll
                for (int i = 0; i < 2; ++i) gcur[h][i] = S.rowoff(ui, h * HALF + RA[i]) * lda + colA[i];
        }
        if constexpr (ALIGN_EPI) { if (wr == 1) GM_BAR; }
    }
    GM_WAIT_V(0);
    if constexpr (!ALIGN_EPI) { if (wr == 0) GM_BAR; }
    GM_BAR;
#undef GM_SA
#undef GM_SB
#undef GM_STAGE_A
#undef GM_STAGE_B
#undef GM_LDA
#undef GM_LDB
#undef GM_MMA
#undef GM_LD8
#undef GM_WAIT_V
#undef GM_WAIT_L
#undef GM_BAR
#undef GM_SCHED
}
}
using gm::GUnit;
typedef f32x4 AccT[2][2][4][2];

struct Args { const float* in[26]; float* out; unsigned char* ws; float invf[NRT]; int ph_lo, ph_hi; };
typedef const __attribute__((address_space(4))) Args ArgsK;
template <class Tp> __device__ __forceinline__ Tp* gptr(Tp* p) { return (Tp*)(GAS Tp*)p; }
struct Ctx {
    LAS unsigned char* lds; int tid, lane, wave, G, bid;
    unsigned char* ws;
    float* out;
};

struct DenseSched {
    gm::StaticOrder so; const char* A; const char* B; unsigned lda, ldb; int nt;
    __device__ __forceinline__ bool next(int i, GUnit& u) const { gm::Unit t; if (!so.next(i, t)) return false; u.pm = t.pm; u.pn = t.pn; u.aux = 0;
        u.A = A + (size_t)t.pm * 256 * lda; u.B = B + (size_t)t.pn * 256 * ldb; u.nt = nt; return true; }
    __device__ __forceinline__ unsigned rowoff(int, int) const { return 0; }
};
struct BranchSched {
    gm::StaticOrder so; const char* A; const char* B;
    __device__ __forceinline__ bool next(int j, GUnit& u) const { const int jt = j / 3, br = j - 3 * jt; gm::Unit t; if (!so.next(jt, t)) return false;
        const int koff = br == 0 ? 0 : (br == 1 ? 512 : 1536); u.pm = t.pm; u.pn = t.pn; u.aux = br; u.nt = br == 1 ? 8 : 4;
        u.A = A + (size_t)t.pm * 256 * 2048 + koff; u.B = B + (size_t)t.pn * 256 * 2048 + koff; return true; }
    __device__ __forceinline__ unsigned rowoff(int, int) const { return 0; }
};
struct UpSched {
    const char* P; const char* Wq; const char* Wkv; int G, c;
    __device__ __forceinline__ bool next(int i, GUnit& u) const {
        int L;
        if (G == 256) { if (c < 128) { if (i > 2) return false; L = i == 0 ? c : (i == 1 ? 128 + c : 384 + c); }
                        else { if (i > 3) return false; const int d = c - 128; L = i == 0 ? 256 + d : 384 + 128 * i + d; } }
        else { L = i * G + c; if (L >= 896) return false; }
        if (L < 384) { u.pm = L / 6; u.pn = L % 6; u.aux = 0; u.nt = 8; u.A = P + (size_t)u.pm * 256 * (PC * 2) + C_CQ * 2; u.B = Wq + (size_t)u.pn * 256 * 1024; }
        else { const int v = L - 384; u.pm = v / 8; u.pn = v % 8; u.aux = 1; u.nt = 4; u.A = P + (size_t)u.pm * 256 * (PC * 2) + C_CKV * 2; u.B = Wkv + (size_t)u.pn * 256 * 1024; }
        return true; }
    __device__ __forceinline__ unsigned rowoff(int, int) const { return 0; }
};
struct RouterSched {
    const char* X; const char* W; int G, c;
    __device__ __forceinline__ bool next(int i, GUnit& u) const { const int L = i * G + c; if (L >= 256) return false;
        u.pm = L >> 2; u.pn = 0; u.aux = L & 3; u.nt = 8; u.A = X + (size_t)u.pm * 256 * 4096 + (size_t)u.aux * 1024; u.B = W + (size_t)u.aux * 1024; return true; }
    __device__ __forceinline__ unsigned rowoff(int, int) const { return 0; }
};
__device__ __forceinline__ int xcd_chunk_unit(int i, int c, int G, int U) {
    if (G % 8 != 0) { const int L = i * G + c; return L < U ? L : -1; }
    const int per = G / 8, x = c % 8, j = c / 8, q = (U + 7) / 8, lo = x * q, hi = (lo + q < U) ? lo + q : U;
    const int L = lo + i * per + j; return L < hi ? L : -1;
}
constexpr int TAB_TILEE = 0, TAB_MISC = 704 * 4, TAB_IDX = 704 * 4 + 64, TAB_SW = TAB_IDX + 10 * 256 * 4;
struct Moe1Sched {
    LAS unsigned char* tab; const char* X; const char* W13; int G, c;
    __device__ __forceinline__ bool next(int i, GUnit& u) const { const LAS int* misc = (const LAS int*)(tab + TAB_MISC); const int nrt = misc[0], ntl = misc[1];
        const int L = xcd_chunk_unit(i, c, G, ntl * 4); if (L < 0 || i >= 10) return false; const int tile = L >> 2, pn = L & 3; const int e = ((const LAS int*)(tab + TAB_TILEE))[tile];
        u.pm = tile < nrt ? tile * 256 : RT_ROWS + (tile - nrt) * 256; u.pn = pn; u.aux = e; u.idx = i; u.nt = 16; u.A = X; u.B = W13 + (size_t)e * (2 * MiB) + (size_t)pn * 256 * 2048; return true; }
    __device__ __forceinline__ unsigned rowoff(int ui, int r) const { return ((const LAS unsigned*)(tab + TAB_IDX))[ui * 256 + r]; }
};
struct Moe2Sched {
    LAS unsigned char* tab; const char* H; const char* W2; int G, c;
    __device__ __forceinline__ bool next(int i, GUnit& u) const { const LAS int* misc = (const LAS int*)(tab + TAB_MISC); const int nrt = misc[0], ntl = misc[1];
        const int L = xcd_chunk_unit(i, c, G, ntl * 8); if (L < 0) return false; const int tile = L >> 3, pn = L & 7; const int e = ((const LAS int*)(tab + TAB_TILEE))[tile];
        u.pm = tile < nrt ? tile * 256 : RT_ROWS + (tile - nrt) * 256; u.pn = pn; u.aux = e; u.nt = 8; u.nt = 4; u.A = H + (size_t)u.pm * 512; u.B = W2 + (size_t)e * (1 * MiB) + (size_t)pn * 256 * 512; return true; }
    __device__ __forceinline__ unsigned rowoff(int, int) const { return 0; }
};

__device__ __forceinline__ u32x4 pk8(f32x4 v0, f32x4 v1) { u32x4 w; w.x = cvt_pk_bf16(v0[0], v0[1]); w.y = cvt_pk_bf16(v0[2], v0[3]); w.z = cvt_pk_bf16(v1[0], v1[1]); w.w = cvt_pk_bf16(v1[2], v1[3]); return w; }
struct EpiInProj {
    static constexpr bool COL16 = true;
    static constexpr int BSH = 6;
    bf16_t* P; float* rsq_q; float* rsq_kv;
    __device__ __forceinline__ void operator()(const AccT& acc, const GUnit& u, int wr, int wc, int fr, int fq) const {
        const int row0 = u.pm * 256 + wr * 64 + fr, col0 = u.pn * 256 + wc * 64 + 16 * fq;
        const bool sig = (u.pn >= 15 && u.pn < 39); const int sq = (u.pn == 6 || u.pn == 7) ? 1 : (u.pn == 8 ? 2 : 0);
        bf16_t* rowp0 = P + (size_t)row0 * PC + col0;
        if (sig) {
#pragma unroll
            for (int ai = 0; ai < 2; ++ai)
#pragma unroll
                for (int m = 0; m < 4; ++m) { bf16_t* rowp = rowp0 + (size_t)(ai * 128 + m * 16) * PC;
#pragma unroll
                    for (int bj = 0; bj < 2; ++bj) { const f32x4 v0 = acc[ai][bj][m][0], v1 = acc[ai][bj][m][1]; u32x4 w;
                        w.x = __builtin_bit_cast(unsigned, __builtin_amdgcn_cvt_pkrtz(sigmoidf_(v0[0]), sigmoidf_(v0[1]))); w.y = __builtin_bit_cast(unsigned, __builtin_amdgcn_cvt_pkrtz(sigmoidf_(v0[2]), sigmoidf_(v0[3])));
                        w.z = __builtin_bit_cast(unsigned, __builtin_amdgcn_cvt_pkrtz(sigmoidf_(v1[0]), sigmoidf_(v1[1]))); w.w = __builtin_bit_cast(unsigned, __builtin_amdgcn_cvt_pkrtz(sigmoidf_(v1[2]), sigmoidf_(v1[3])));
                        *(u32x4*)(rowp + bj * 8) = w; } }
        } else {
#pragma unroll
            for (int ai = 0; ai < 2; ++ai)
#pragma unroll
                for (int m = 0; m < 4; ++m) { const int row = row0 + ai * 128 + m * 16; bf16_t* rowp = rowp0 + (size_t)(ai * 128 + m * 16) * PC;
#pragma unroll
                    for (int bj = 0; bj < 2; ++bj) *(u32x4*)(rowp + bj * 8) = pk8(acc[ai][bj][m][0], acc[ai][bj][m][1]);
                    if (sq) { float ss = 0.f;
#pragma unroll
                        for (int bj = 0; bj < 2; ++bj) { const f32x4 v0 = acc[ai][bj][m][0], v1 = acc[ai][bj][m][1];
                            ss += (v0[0] * v0[0] + v0[1] * v0[1]) + (v0[2] * v0[2] + v0[3] * v0[3]) + (v1[0] * v1[0] + v1[1] * v1[1]) + (v1[2] * v1[2] + v1[3] * v1[3]); }
                        ss += __shfl_xor(ss, 16); ss += __shfl_xor(ss, 32); if (fq == 0) { if (sq == 1) rsq_q[row * 8 + (u.pn - 6) * 4 + wc] = ss; else rsq_kv[row * 4 + wc] = ss; } } }
        }
    }
};
struct EpiUp {
    static constexpr bool COL16 = false;
    static constexpr int BSH = 0;
    bf16_t* Qm; bf16_t* Kf; bf16_t* Vm; const float* rsq_q; const float* rsq_kv;
    __device__ __forceinline__ void operator()(const AccT& acc, const GUnit& u, int wr, int wc, int fr, int fq) const {
        const int row0 = u.pm * 256 + wr * 64 + fr, cw = wc * 32 + 8 * fq; const bool kv = u.aux != 0;
#pragma unroll
        for (int ai = 0; ai < 2; ++ai)
#pragma unroll
            for (int m = 0; m < 4; ++m) { const int row = row0 + ai * 128 + m * 16;
                float rs; if (kv) { const f32x4 p = *(const f32x4*)(rsq_kv + row * 4); rs = rsqrtf(((p[0] + p[1]) + (p[2] + p[3])) * (1.f / 256.f) + NORM_EPS); }
                else { const f32x4 p = *(const f32x4*)(rsq_q + row * 8), q = *(const f32x4*)(rsq_q + row * 8 + 4); rs = rsqrtf((((p[0] + p[1]) + (p[2] + p[3])) + ((q[0] + q[1]) + (q[2] + q[3]))) * (1.f / 512.f) + NORM_EPS); }
#pragma unroll
                for (int bj = 0; bj < 2; ++bj) { const f32x4 v0 = acc[ai][bj][m][0] * rs, v1 = acc[ai][bj][m][1] * rs;
                    bf16_t* dst = kv ? (bj == 0 ? Kf + (size_t)row * 1536 + u.pn * 192 + cw : Vm + (size_t)row * 1024 + u.pn * 128 + cw) : Qm + (size_t)row * 1536 + u.pn * 256 + bj * 128 + cw;
                    *(u32x4*)dst = pk8(v0, v1); } }
    }
};
typedef _Float16 h16x8 __attribute__((ext_vector_type(8)));
struct EpiBranch {
    static constexpr bool COL16 = true;
    static constexpr int BSH = 10;
    bf16_t* YB; unsigned char* YQ; const bf16_t* P;
    __device__ __forceinline__ void operator()(const AccT& acc, const GUnit& u, int wr, int wc, int fr, int fq) const {
        const int row0 = u.pm * 256 + wr * 64 + fr, col0 = u.pn * 256 + wc * 64 + 16 * fq; const int br = u.aux;
        const bf16_t* gp = P + (size_t)row0 * PC + C_G + br * 2048 + col0; bf16_t* yp = YB + (size_t)row0 * 2048 + col0; unsigned char* qp = YQ + (size_t)row0 * 2048 + col0;
#pragma unroll
        for (int ai = 0; ai < 2; ++ai) { h16x8 gg[4][2], yy[4][2];
#pragma unroll
            for (int m = 0; m < 4; ++m)
#pragma unroll
                for (int bj = 0; bj < 2; ++bj) { const int ro = ai * 128 + m * 16;
                    gg[m][bj] = *(const h16x8*)(gp + (size_t)ro * PC + bj * 8);
                    yy[m][bj] = br != 0 ? *(const h16x8*)(yp + (size_t)ro * 2048 + bj * 8) : (h16x8){0, 0, 0, 0, 0, 0, 0, 0}; }
#pragma unroll
            for (int m = 0; m < 4; ++m)
#pragma unroll
                for (int bj = 0; bj < 2; ++bj) { const int ro = ai * 128 + m * 16; const h16x8 g = gg[m][bj], y = yy[m][bj]; float v[8];
#pragma unroll
                    for (int j = 0; j < 8; ++j) v[j] = acc[ai][bj][m][j >> 2][j & 3] * (float)g[j] + (float)y[j];
                    if (br == 2) { u32x2 q; q.x = pk4_fp8(clamp8(v[0] * Y8_SCALE), clamp8(v[1] * Y8_SCALE), clamp8(v[2] * Y8_SCALE), clamp8(v[3] * Y8_SCALE));
                        q.y = pk4_fp8(clamp8(v[4] * Y8_SCALE), clamp8(v[5] * Y8_SCALE), clamp8(v[6] * Y8_SCALE), clamp8(v[7] * Y8_SCALE)); *(u32x2*)(qp + (size_t)ro * 2048 + bj * 8) = q; }
                    else { u32x4 w; w.x = __builtin_bit_cast(unsigned, __builtin_amdgcn_cvt_pkrtz(v[0], v[1])); w.y = __builtin_bit_cast(unsigned, __builtin_amdgcn_cvt_pkrtz(v[2], v[3]));
                        w.z = __builtin_bit_cast(unsigned, __builtin_amdgcn_cvt_pkrtz(v[4], v[5])); w.w = __builtin_bit_cast(unsigned, __builtin_amdgcn_cvt_pkrtz(v[6], v[7])); *(u32x4*)(yp + (size_t)ro * 2048 + bj * 8) = w; } } }
    }
};
struct EpiOut {
    static constexpr bool COL16 = true;
    static constexpr int BSH = 9;
    bf16_t* Z; const bf16_t* xres;
    __device__ __forceinline__ void operator()(const AccT& acc, const GUnit& u, int wr, int wc, int fr, int fq) const {
        const int row0 = u.pm * 256 + wr * 64 + fr, col0 = u.pn * 256 + wc * 64 + 16 * fq;
#pragma unroll
        for (int ai = 0; ai < 2; ++ai) { u32x4 xr[4][2];
#pragma unroll
            for (int m = 0; m < 4; ++m)
#pragma unroll
                for (int bj = 0; bj < 2; ++bj) xr[m][bj] = *(const u32x4*)(xres + (size_t)(row0 + ai * 128 + m * 16) * 2048 + col0 + bj * 8);
#pragma unroll
            for (int m = 0; m < 4; ++m) { const size_t ro = (size_t)(row0 + ai * 128 + m * 16) * 2048 + col0;
#pragma unroll
                for (int bj = 0; bj < 2; ++bj) { const u32x4 x = xr[m][bj]; f32x4 v0 = acc[ai][bj][m][0], v1 = acc[ai][bj][m][1];
                    v0[0] += DN_ALPHA * bflo(x.x); v0[1] += DN_ALPHA * bfhi(x.x); v0[2] += DN_ALPHA * bflo(x.y); v0[3] += DN_ALPHA * bfhi(x.y);
                    v1[0] += DN_ALPHA * bflo(x.z); v1[1] += DN_ALPHA * bfhi(x.z); v1[2] += DN_ALPHA * bflo(x.w); v1[3] += DN_ALPHA * bfhi(x.w);
                    *(u32x4*)(Z + ro + bj * 8) = pk8(v0, v1); } } }
    }
};
struct EpiLogit {
    static constexpr bool COL16 = false;
    static constexpr int BSH = 0;
    float* L;
    __device__ __forceinline__ void operator()(const AccT& acc, const GUnit& u, int wr, int wc, int fr, int fq) const {
        if (wc >= 2) return; const int row0 = u.pm * 256 + wr * 64 + fr, col0 = wc * 32 + 8 * fq;
#pragma unroll
        for (int ai = 0; ai < 2; ++ai)
#pragma unroll
            for (int m = 0; m < 4; ++m) { float* d = L + (size_t)u.aux * T * 64 + (size_t)(row0 + ai * 128 + m * 16) * 64 + col0; *(f32x4*)d = acc[ai][0][m][0]; *(f32x4*)(d + 4) = acc[ai][0][m][1]; }
    }
};
struct EpiMoe1 {
    static constexpr bool COL16 = false;
    static constexpr int BSH = 6;
    unsigned char* H; const LAS float* sw;
    __device__ __forceinline__ void operator()(const AccT& acc, const GUnit& u, int wr, int wc, int fr, int fq) const {
        const int row0 = u.pm + wr * 64 + fr, col0 = u.pn * 128 + wc * 32 + 8 * fq; const LAS float* swu = sw + u.idx * 256 + wr * 64 + fr;
        float w8[2][4];
#pragma unroll
        for (int ai = 0; ai < 2; ++ai)
#pragma unroll
            for (int m = 0; m < 4; ++m) w8[ai][m] = swu[ai * 128 + m * 16];
#pragma unroll
        for (int ai = 0; ai < 2; ++ai)
#pragma unroll
            for (int m = 0; m < 4; ++m) { const int srow = row0 + ai * 128 + m * 16; const float w = w8[ai][m] * H8_SCALE;
                float h0[4], h1[4];
#pragma unroll
                for (int j = 0; j < 4; ++j) { const float g0 = acc[ai][0][m][0][j], g1 = acc[ai][0][m][1][j];
                    h0[j] = clamp8(g0 * sigmoidf_(g0) * acc[ai][1][m][0][j] * w); h1[j] = clamp8(g1 * sigmoidf_(g1) * acc[ai][1][m][1][j] * w); }
                u32x2 o; o.x = pk4_fp8(h0[0], h0[1], h0[2], h0[3]); o.y = pk4_fp8(h1[0], h1[1], h1[2], h1[3]);
                *(u32x2*)(H + (size_t)srow * FF + col0) = o; }
    }
};
struct EpiMoe2 {
    static constexpr bool COL16 = true;
    static constexpr int BSH = 5;
    unsigned char* Y;
    __device__ __forceinline__ void operator()(const AccT& acc, const GUnit& u, int wr, int wc, int fr, int fq) const {
        const int row0 = u.pm + wr * 64 + fr, col0 = u.pn * 256 + wc * 64 + 16 * fq;
#pragma unroll
        for (int ai = 0; ai < 2; ++ai)
#pragma unroll
            for (int m = 0; m < 4; ++m) { u32x4 q;
                q.x = pk4_fp8(acc[ai][0][m][0][0], acc[ai][0][m][0][1], acc[ai][0][m][0][2], acc[ai][0][m][0][3]); q.y = pk4_fp8(acc[ai][0][m][1][0], acc[ai][0][m][1][1], acc[ai][0][m][1][2], acc[ai][0][m][1][3]);
                q.z = pk4_fp8(acc[ai][1][m][0][0], acc[ai][1][m][0][1], acc[ai][1][m][0][2], acc[ai][1][m][0][3]); q.w = pk4_fp8(acc[ai][1][m][1][0], acc[ai][1][m][1][1], acc[ai][1][m][1][2], acc[ai][1][m][1][3]);
                *(u32x4*)(Y + (size_t)(row0 + ai * 128 + m * 16) * 2048 + col0) = q; }
    }
};

struct CvtJob { const float* src; int pitch; int K; int N; const float* kscale; bf16_t* dst; int dpitch; int grp; int gstride; int rbase; size_t sbs; size_t dbs; int nbatch; int f8; };
template <int NT, int NP> __device__ __forceinline__ void cvt_load(const Ctx& C, const CvtJob& J, f32x4 (&dst)[NP], int it, int per, int nnb) {
    constexpr int TPR = NT / 4, RPP = 512 / TPR;
    const int rr = C.tid / TPR, c4 = (C.tid % TPR) * 4;
    const int e_ = it / per, r_ = it - e_ * per, kb_ = r_ / nnb, nb_ = r_ - kb_ * nnb;
    const float* s_ = J.src + (size_t)e_ * J.sbs + (size_t)(kb_ * 128) * J.pitch + nb_ * NT;
#pragma unroll
    for (int p = 0; p < NP; ++p) { const int k = p * RPP + rr; dst[p] = __builtin_nontemporal_load((const f32x4*)(s_ + (size_t)k * J.pitch + c4)); }
}
template <int NT, int NP> __device__ __forceinline__ void cvt_step(const Ctx& C, const CvtJob& J, f32x4 (&v)[NP], int it, int total, int per, int nnb) {
    LAS float* scr = (LAS float*)C.lds;
    constexpr int TPR = NT / 4, RPP = 512 / TPR, PT = NT + 1, NQ = NT * 16 / 512;
    const int rr = C.tid / TPR, c4 = (C.tid % TPR) * 4;
    const int e = it / per, r = it - e * per, kb = r / nnb, nb = r - kb * nnb;
#pragma unroll
    for (int p = 0; p < NP; ++p) { const int k = p * RPP + rr; f32x4 x = v[p]; if (J.kscale) x = x * J.kscale[kb * 128 + k];
        scr[k * PT + c4 + 0] = x[0]; scr[k * PT + c4 + 1] = x[1]; scr[k * PT + c4 + 2] = x[2]; scr[k * PT + c4 + 3] = x[3]; }
    __syncthreads();
    if (it + 3 * C.G < total) cvt_load<NT, NP>(C, J, v, it + 3 * C.G, per, nnb);
    const int j0 = nb * NT; const int drow0 = (j0 / J.grp) * J.gstride + (j0 % J.grp) + J.rbase;
    if (J.f8) { unsigned char* d8 = (unsigned char*)J.dst + (size_t)e * J.dbs + (size_t)drow0 * J.dpitch + kb * 128;
#pragma unroll
        for (int q = 0; q < NQ; ++q) { const int ch = (C.tid & 7) | ((q & 1) << 3), n = (C.tid >> 3) + 64 * (q >> 1); const LAS float* sp = scr + (8 * ch) * PT + n;
            u32x2 o; o.x = pk4_fp8(sp[0] * W8_SCALE, sp[PT] * W8_SCALE, sp[2 * PT] * W8_SCALE, sp[3 * PT] * W8_SCALE); o.y = pk4_fp8(sp[4 * PT] * W8_SCALE, sp[5 * PT] * W8_SCALE, sp[6 * PT] * W8_SCALE, sp[7 * PT] * W8_SCALE);
            *(u32x2*)(d8 + (size_t)n * J.dpitch + 8 * ch) = o; }
    } else {
        bf16_t* d = J.dst + (size_t)e * J.dbs + (size_t)drow0 * J.dpitch + kb * 128;
#pragma unroll
        for (int q = 0; q < NQ; ++q) { const int ch = (C.tid & 7) | ((q & 1) << 3), n = (C.tid >> 3) + 64 * (q >> 1); const LAS float* sp = scr + (8 * ch) * PT + n;
            u32x4 o; o.x = cvt_pk_bf16(sp[0], sp[PT]); o.y = cvt_pk_bf16(sp[2 * PT], sp[3 * PT]); o.z = cvt_pk_bf16(sp[4 * PT], sp[5 * PT]); o.w = cvt_pk_bf16(sp[6 * PT], sp[7 * PT]);
            *(u32x4*)(d + (size_t)n * J.dpitch + 8 * ch) = o; }
    }
    __syncthreads();
}
template <int NT> __device__ __forceinline__ void cvt_job_t(const Ctx& C, const CvtJob& J, int& rot) {
    constexpr int TPR = NT / 4, RPP = 512 / TPR, NP = 128 / RPP;
    const int nkb = J.K / 128, nnb = J.N / NT, per = nkb * nnb, total = per * J.nbatch;
    int start = C.bid - rot; if (start < 0) start += C.G;
    f32x4 va[NP], vb[NP], vc[NP];
    if (start < total) cvt_load<NT, NP>(C, J, va, start, per, nnb);
    if (start + C.G < total) cvt_load<NT, NP>(C, J, vb, start + C.G, per, nnb);
    if (start + 2 * C.G < total) cvt_load<NT, NP>(C, J, vc, start + 2 * C.G, per, nnb);
#pragma nounroll
    for (int it = start; it < total; it += 3 * C.G) {
        cvt_step<NT, NP>(C, J, va, it, total, per, nnb);
        if (it + C.G < total) cvt_step<NT, NP>(C, J, vb, it + C.G, total, per, nnb);
        if (it + 2 * C.G < total) cvt_step<NT, NP>(C, J, vc, it + 2 * C.G, total, per, nnb);
    }
    rot = (rot + total) % C.G;
}
__device__ __forceinline__ void ld_nt_async(f32x4& v, const float* p) { asm volatile("global_load_dwordx4 %0, %1, off nt" : "=v"(v) : "v"(p)); }
#define CVT_W8(v) "+v"(v[0]), "+v"(v[1]), "+v"(v[2]), "+v"(v[3]), "+v"(v[4]), "+v"(v[5]), "+v"(v[6]), "+v"(v[7])
__device__ __forceinline__ void cvt_loada(const Ctx& C, const CvtJob& J, f32x4 (&dst)[8], int it, int total, int per, int nnb) {
    const int rr = C.tid >> 5, c4 = (C.tid & 31) * 4;
    const bool ok = it < total; const int itc = ok ? it : 0;
    const int e_ = itc / per, r_ = itc - e_ * per, kb_ = r_ / nnb, nb_ = r_ - kb_ * nnb;
    const float* s_ = J.src + (size_t)e_ * J.sbs + (size_t)(kb_ * 128) * J.pitch + nb_ * 128;
#pragma unroll
    for (int p = 0; p < 8; ++p) { const int k = p * 16 + rr; const float* a = ok ? s_ + (size_t)k * J.pitch + c4 : J.src; ld_nt_async(dst[p], a); }
}
__device__ __forceinline__ void cvt_dummy4(const Ctx& C) {
    unsigned char* dp = C.ws + WS_X2F + ((size_t)C.bid * NTHR + C.tid) * 16; u32x2 z = (u32x2){0u, 0u};
#pragma unroll
    for (int q = 0; q < 4; ++q) asm volatile("global_store_dwordx2 %0, %1, off" :: "v"(dp), "v"(z) : "memory");
}
__device__ __forceinline__ void cvt_stepa(const Ctx& C, const CvtJob& J, f32x4 (&v)[8], int it, int total, int per, int nnb) {
    LAS float* scr = (LAS float*)C.lds;
    const int rr = C.tid >> 5, cg = C.tid & 31;
    const int e = it / per, r = it - e * per, kb = r / nnb, nb = r - kb * nnb;
    asm volatile("s_waitcnt vmcnt(28)" : CVT_W8(v));
#pragma unroll
    for (int p = 0; p < 8; ++p) { const int k = p * 16 + rr; f32x4 x = v[p]; if (J.kscale) x = x * J.kscale[kb * 128 + k];
        *(LAS f32x4*)(scr + k * 128 + ((cg ^ ((k >> 3) & 15)) << 2)) = x; }
    __syncthreads();
    cvt_loada(C, J, v, it + 3 * C.G, total, per, nnb);
    const int j0 = nb * 128; const int drow0 = (j0 / J.grp) * J.gstride + (j0 % J.grp) + J.rbase;
    const int k8 = C.tid & 15, g = C.tid >> 4;
    f32x4 x[8];
#pragma unroll
    for (int j = 0; j < 8; ++j) x[j] = *(const LAS f32x4*)(scr + (k8 * 8 + j) * 128 + ((g ^ k8) << 2));
    if (J.f8) { unsigned char* d8 = (unsigned char*)J.dst + (size_t)e * J.dbs + (size_t)drow0 * J.dpitch + kb * 128 + k8 * 8;
#pragma unroll
        for (int q = 0; q < 4; ++q) {
            u32x2 o; o.x = pk4_fp8(x[0][q] * W8_SCALE, x[1][q] * W8_SCALE, x[2][q] * W8_SCALE, x[3][q] * W8_SCALE); o.y = pk4_fp8(x[4][q] * W8_SCALE, x[5][q] * W8_SCALE, x[6][q] * W8_SCALE, x[7][q] * W8_SCALE);
            *(u32x2*)(d8 + (size_t)(4 * g + q) * J.dpitch) = o; }
    } else {
        bf16_t* d = J.dst + (size_t)e * J.dbs + (size_t)drow0 * J.dpitch + kb * 128 + k8 * 8;
#pragma unroll
        for (int q = 0; q < 4; ++q) {
            u32x4 o; o.x = cvt_pk_bf16(x[0][q], x[1][q]); o.y = cvt_pk_bf16(x[2][q], x[3][q]); o.z = cvt_pk_bf16(x[4][q], x[5][q]); o.w = cvt_pk_bf16(x[6][q], x[7][q]);
            *(u32x4*)(d + (size_t)(4 * g + q) * J.dpitch) = o; }
    }
    __syncthreads();
}
__device__ __forceinline__ void cvt_job_a(const Ctx& C, const CvtJob& J, int& rot) {
    const int nkb = J.K / 128, nnb = J.N / 128, per = nkb * nnb, total = per * J.nbatch;
    int start = C.bid - rot; if (start < 0) start += C.G;
    f32x4 va[8], vb[8], vc[8];
    cvt_loada(C, J, va, start, total, per, nnb); cvt_dummy4(C);
    cvt_loada(C, J, vb, start + C.G, total, per, nnb); cvt_dummy4(C);
    cvt_loada(C, J, vc, start + 2 * C.G, total, per, nnb); cvt_dummy4(C);
#pragma nounroll
    for (int it = start; it < total; it += 3 * C.G) {
        cvt_stepa(C, J, va, it, total, per, nnb);
        if (it + C.G < total) cvt_stepa(C, J, vb, it + C.G, total, per, nnb);
        if (it + 2 * C.G < total) cvt_stepa(C, J, vc, it + 2 * C.G, total, per, nnb);
    }
    asm volatile("s_waitcnt vmcnt(0)" : CVT_W8(va), CVT_W8(vb), CVT_W8(vc));
    rot = (rot + total) % C.G;
}
__device__ __forceinline__ void cvt_job(const Ctx& C, const CvtJob& J, int& rot) { if (J.N % 128 == 0) cvt_job_a(C, J, rot); else cvt_job_t<64>(C, J, rot); }
__device__ __forceinline__ void zero_fill16(const Ctx& C, void* p, size_t bytes) {
    u32x4* q = (u32x4*)p; const size_t n = bytes / 16;
    unsigned z_; asm volatile("v_mov_b32 %0, 0" : "=v"(z_));
    for (size_t i = (size_t)C.bid * NTHR + C.tid; i < n; i += (size_t)C.G * NTHR) q[i] = (u32x4){z_, z_, z_, z_};
}
__device__ __forceinline__ void phase_convert(const Ctx& C, ArgsK* A, int l) {
    const __attribute__((address_space(4))) float* invf = A->invf;
    unsigned char* ws = C.ws; int rot = 0;
    if (C.bid == 0 && C.tid < 64) ((unsigned*)(ws + WS_CTL))[CW_ECNT + l * 64 + C.tid] = 0u;
    const float* w_in = gptr(A->in[2]) + (size_t)l * DM * IN_COLS;
    bf16_t* WinT = (bf16_t*)(ws + WS_WIN);
    const int BIG = 1 << 30;
    { CvtJob J{w_in, IN_COLS, DM, 2304, nullptr, WinT, DM, BIG, 0, 0, 0, 0, 1, 1}; cvt_job(C, J, rot); }
    { CvtJob J{w_in + 2368, IN_COLS, DM, 7680, nullptr, WinT, DM, BIG, 0, 2304, 0, 0, 1, 1}; cvt_job(C, J, rot); }
    { CvtJob J{w_in + 2304, IN_COLS, DM, 64, nullptr, WinT, DM, BIG, 0, 9984, 0, 0, 1, 1}; cvt_job(C, J, rot); }
    zero_fill16(C, (unsigned char*)WinT + (size_t)10048 * DM, (size_t)192 * DM);
    { CvtJob J{gptr(A->in[9]) + (size_t)l * 512 * 1536, 1536, 512, 1536, gptr(A->in[8]) + l * 512, (bf16_t*)(ws + WS_WUQ), 512, BIG, 0, 0, 0, 0, 1, 0}; cvt_job(C, J, rot); }
    { CvtJob J{gptr(A->in[11]) + (size_t)l * 256 * 2048, 2048, 256, 2048, gptr(A->in[10]) + l * 256, (bf16_t*)(ws + WS_WUKV), 512, BIG, 0, 0, 0, 0, 1, 0}; cvt_job(C, J, rot); }
    { CvtJob J{gptr(A->in[16]) + (size_t)l * DM * 64, 64, DM, 64, nullptr, (bf16_t*)(ws + WS_WR), DM, BIG, 0, 0, 0, 0, 1, 0}; cvt_job(C, J, rot); }
    zero_fill16(C, (bf16_t*)(ws + WS_WR) + (size_t)64 * DM, (size_t)192 * DM * 2);
    { CvtJob J{gptr(A->in[12]) + (size_t)l * DM * DM, DM, DM, DM, nullptr, (bf16_t*)(ws + WS_WBR), DM, BIG, 0, 0, 0, 0, 1, 1}; cvt_job(C, J, rot); }
    { CvtJob J{gptr(A->in[13]) + (size_t)l * DM * DM, DM, DM, DM, nullptr, (bf16_t*)(ws + WS_WOUT), DM, BIG, 0, 0, 0, 0, 1, 1}; cvt_job(C, J, rot); }
    if (l == 0) {
        const float* x = gptr(A->in[0]); bf16_t* XB = (bf16_t*)(ws + WS_XB);
        for (size_t i = ((size_t)C.bid * NTHR + C.tid) * 8; i < (size_t)T * DM; i += (size_t)C.G * NTHR * 8) {
            const f32x4 a = *(const f32x4*)(x + i), b = *(const f32x4*)(x + i + 4); *(u32x4*)(XB + i) = pk8(a, b);
            u32x2 q; q.x = pk4_fp8(a[0], a[1], a[2], a[3]); q.y = pk4_fp8(b[0], b[1], b[2], b[3]); *(u32x2*)((unsigned char*)(ws + WS_XQ) + i) = q; }
        const int* pos = (const int*)gptr(A->in[1]); float* cosT = (float*)(ws + WS_COS); float* sinT = (float*)(ws + WS_SIN);
        for (int i = C.bid * NTHR + C.tid; i < T * NRT; i += C.G * NTHR) { const int t = i / NRT, j = i - t * NRT;
            const float ang = (float)pos[t] * invf[j];
            const double rev = (double)ang * 0.15915494309189535; const float fr = (float)(rev - floor(rev));
            cosT[i] = __builtin_amdgcn_cosf(fr); sinT[i] = __builtin_amdgcn_sinf(fr); }
    }
}
__device__ __forceinline__ void phase_convert_moe(const Ctx& C, ArgsK* A, int l) {
    unsigned char* ws = C.ws; int rot = 0;
    const int BIG = 1 << 30;
    bf16_t* W13 = (bf16_t*)(ws + WS_W13); bf16_t* W2 = (bf16_t*)(ws + WS_W2);
    const size_t EW = (size_t)DM * FF;
    { CvtJob J{gptr(A->in[18]) + (size_t)l * NEXP * EW, FF, DM, FF, nullptr, W13, DM, 128, 256, 0, EW, (size_t)1024 * DM, NEXP, 1}; cvt_job(C, J, rot); }
    { CvtJob J{gptr(A->in[19]) + (size_t)l * NEXP * EW, FF, DM, FF, nullptr, W13, DM, 128, 256, 128, EW, (size_t)1024 * DM, NEXP, 1}; cvt_job(C, J, rot); }
    { CvtJob J{gptr(A->in[20]) + (size_t)l * NEXP * EW, DM, FF, DM, nullptr, W2, FF, BIG, 0, 0, EW, (size_t)DM * FF, NEXP, 1}; cvt_job(C, J, rot); }
    { CvtJob J{gptr(A->in[21]) + (size_t)l * EW, FF, DM, FF, nullptr, (bf16_t*)((unsigned char*)W13 + (size_t)NEXP * 1024 * DM), DM, 128, 256, 0, 0, 0, 1, 1}; cvt_job(C, J, rot); }
    { CvtJob J{gptr(A->in[22]) + (size_t)l * EW, FF, DM, FF, nullptr, (bf16_t*)((unsigned char*)W13 + (size_t)NEXP * 1024 * DM), DM, 128, 256, 128, 0, 0, 1, 1}; cvt_job(C, J, rot); }
    { CvtJob J{gptr(A->in[23]) + (size_t)l * EW, DM, FF, DM, nullptr, (bf16_t*)((unsigned char*)W2 + (size_t)NEXP * DM * FF), FF, BIG, 0, 0, 0, 0, 1, 1}; cvt_job(C, J, rot); }
}

__device__ __forceinline__ void rope8(u32x4& a, u32x4& b, const float* c, const float* s) {
    float x1[8] = {bflo(a.x), bfhi(a.x), bflo(a.y), bfhi(a.y), bflo(a.z), bfhi(a.z), bflo(a.w), bfhi(a.w)};
    float x2[8] = {bflo(b.x), bfhi(b.x), bflo(b.y), bfhi(b.y), bflo(b.z), bfhi(b.z), bflo(b.w), bfhi(b.w)};
    float y1[8], y2[8];
#pragma unroll
    for (int i = 0; i < 8; ++i) { y1[i] = x1[i] * c[i] - x2[i] * s[i]; y2[i] = x2[i] * c[i] + x1[i] * s[i]; }
    a.x = cvt_pk_bf16(y1[0], y1[1]); a.y = cvt_pk_bf16(y1[2], y1[3]); a.z = cvt_pk_bf16(y1[4], y1[5]); a.w = cvt_pk_bf16(y1[6], y1[7]);
    b.x = cvt_pk_bf16(y2[0], y2[1]); b.y = cvt_pk_bf16(y2[2], y2[3]); b.z = cvt_pk_bf16(y2[4], y2[5]); b.w = cvt_pk_bf16(y2[6], y2[7]);
}
__device__ __forceinline__ void ld8f(float (&d)[8], const float* p) { const f32x4 a = *(const f32x4*)p, b = *(const f32x4*)(p + 4); d[0] = a[0]; d[1] = a[1]; d[2] = a[2]; d[3] = a[3]; d[4] = b[0]; d[5] = b[1]; d[6] = b[2]; d[7] = b[3]; }
__device__ __forceinline__ void phase_krope(const Ctx& C) {
    unsigned char* ws = C.ws; bf16_t* P = (bf16_t*)(ws + WS_P); bf16_t* Kf = (bf16_t*)(ws + WS_KF);
    const float* cosT = (const float*)(ws + WS_COS); const float* sinT = (const float*)(ws + WS_SIN); float* kmean = (float*)(ws + WS_KMEAN);
    LAS float* red = (LAS float*)C.lds;
    for (int it = C.bid; it < 64 * 6; it += C.G) {
        const int rb = it / 6, kind = it - rb * 6, r0 = rb * 256;
        if (kind < 4) {
            const int h = kind, c8 = C.tid & 15, rr = C.tid >> 4;
            float cs[16];
#pragma unroll
            for (int j = 0; j < 16; ++j) cs[j] = 0.f;
            if (c8 < 2 || c8 >= 4) {
                for (int p = 0; p < 8; ++p) { const int row = r0 + p * 32 + rr; bf16_t* base = P + (size_t)row * PC + C_MK + h * 128;
                    if (c8 < 2) { u32x4 a = *(const u32x4*)(base + c8 * 8), b = *(const u32x4*)(base + 16 + c8 * 8);
                        float c[8], s[8]; ld8f(c, cosT + (size_t)row * NRT + 40 + c8 * 8); ld8f(s, sinT + (size_t)row * NRT + 40 + c8 * 8);
                        rope8(a, b, c, s); *(u32x4*)(base + c8 * 8) = a; *(u32x4*)(base + 16 + c8 * 8) = b;
                        cs[0] += bflo(a.x); cs[1] += bfhi(a.x); cs[2] += bflo(a.y); cs[3] += bfhi(a.y); cs[4] += bflo(a.z); cs[5] += bfhi(a.z); cs[6] += bflo(a.w); cs[7] += bfhi(a.w);
                        cs[8] += bflo(b.x); cs[9] += bfhi(b.x); cs[10] += bflo(b.y); cs[11] += bfhi(b.y); cs[12] += bflo(b.z); cs[13] += bfhi(b.z); cs[14] += bflo(b.w); cs[15] += bfhi(b.w);
                    } else { const u32x4 a = *(const u32x4*)(base + c8 * 8);
                        cs[0] += bflo(a.x); cs[1] += bfhi(a.x); cs[2] += bflo(a.y); cs[3] += bfhi(a.y); cs[4] += bflo(a.z); cs[5] += bfhi(a.z); cs[6] += bflo(a.w); cs[7] += bfhi(a.w); } }
            }
            if (c8 < 2) {
#pragma unroll
                for (int j = 0; j < 8; ++j) { red[rr * 128 + c8 * 8 + j] = cs[j]; red[rr * 128 + 16 + c8 * 8 + j] = cs[8 + j]; } }
            else if (c8 >= 4) {
#pragma unroll
                for (int j = 0; j < 8; ++j) red[rr * 128 + c8 * 8 + j] = cs[j]; }
            __syncthreads();
            if (C.tid < 128) { float s = 0.f; for (int q = 0; q < 32; ++q) s += red[q * 128 + C.tid];
                const int b = rb >> 3, nb = rb & 7; kmean[((size_t)(b * 4 + h) * 8 + nb) * 128 + C.tid] = s * (1.f / 256.f); }
            __syncthreads();
        } else if (kind == 4) {
            for (int q = 0; q < 4; ++q) { const int idx = C.tid + 512 * q, g = idx & 7, row = r0 + (idx >> 3); bf16_t* base = P + (size_t)row * PC + C_DK + g * 64;
                u32x4 a = *(const u32x4*)base, b = *(const u32x4*)(base + 8); float c[8], s[8]; ld8f(c, cosT + (size_t)row * NRT); ld8f(s, sinT + (size_t)row * NRT);
                rope8(a, b, c, s); *(u32x4*)base = a; *(u32x4*)(base + 8) = b; }
        } else {
            for (int q = 0; q < 2; ++q) { const int idx = C.tid + 512 * q, g = idx & 3, row = r0 + (idx >> 2); const bf16_t* base = P + (size_t)row * PC + C_KPE;
                u32x4 a = *(const u32x4*)(base + g * 8), b = *(const u32x4*)(base + 32 + g * 8); float c[8], s[8]; ld8f(c, cosT + (size_t)row * NRT + 8 + g * 8); ld8f(s, sinT + (size_t)row * NRT + 8 + g * 8);
                rope8(a, b, c, s);
#pragma unroll
                for (int h = 0; h < 8; ++h) { bf16_t* d = Kf + (size_t)row * 1536 + h * 192 + 128; *(u32x4*)(d + g * 8) = a; *(u32x4*)(d + 32 + g * 8) = b; } }
        }
    }
}

namespace at {
constexpr int LK = 0, LV = 24576, BUFSZ = 40960, LWS = 2 * BUFSZ, LKM = LWS + 2048;
__device__ __forceinline__ int v_st(int k, int c) { const int kk = (k & ~0xC) | ((k & 4) << 1) | ((k & 8) >> 1); return ((kk >> 3) * 4 + (c >> 5)) * 512 + ((kk & 7) * 32 + (c & 31)) * 2; }
__device__ __forceinline__ int v_rd_base(int lane) { return ((lane & 3) << 3) | (((lane >> 2) & 3) << 6) | (((lane >> 4) & 1) << 5) | (((lane >> 5) & 1) << 8); }
constexpr int v_rd_off(int d0, int ks, int half) { return d0 * 512 + ks * 4096 + half * 2048; }
__device__ __forceinline__ int crow(int r, int hi) { return (r & 3) + 8 * (r >> 2) + 4 * hi; }

__device__ __forceinline__ void rope_frag(bf16x8& a, bf16x8& b, const float* c, const float* s) {
    u32x4 ua = __builtin_bit_cast(u32x4, a), ub = __builtin_bit_cast(u32x4, b); rope8(ua, ub, c, s); a = __builtin_bit_cast(bf16x8, ua); b = __builtin_bit_cast(bf16x8, ub);
}

template <int KD, int MODE, int ROPE, int EPI>
__device__ __forceinline__ void attn_unit(LAS unsigned char* lds, const bf16_t* Qp, int qpitch, const bf16_t* Kp, int kpitch, const bf16_t* Vp, int vpitch,
                                          int trow0, int qb, const float* cosT, const float* sinT, float C2, const float* kmean_bh,
                                          float* O1, unsigned char* Oout, float lam, float outscale, const float* subg) {
    int tid_ = threadIdx.x; asm volatile("" : "+v"(tid_));
    const int tid = tid_, wid = __builtin_amdgcn_readfirstlane(tid >> 6), lane = tid & 63, r32 = lane & 31, hi = lane >> 5;
    const int q0 = qb * 256, qlo = q0 + wid * 32, qrow = qlo + r32;
    LAS unsigned char* K_lds = lds + LK; LAS unsigned char* V_lds = lds + LV;
    LAS float* wsf = (LAS float*)(lds + LWS) + wid * 64; LAS float* kml = (LAS float*)(lds + LKM);
    constexpr int ND = KD / 16;
    bf16x8 qr[ND];
    const bf16_t* qrowp = Qp + (size_t)qrow * qpitch;
#pragma unroll
    for (int d0 = 0; d0 < ND; ++d0) qr[d0] = *(const bf16x8*)(qrowp + d0 * 16 + hi * 8);
    const float* cr = cosT + (size_t)(trow0 + qrow) * NRT; const float* sr = sinT + (size_t)(trow0 + qrow) * NRT;
    if constexpr (ROPE == 0) {
        bf16x8 other = *(const bf16x8*)(qrowp + (1 - hi) * 8); float c[8], s[8]; ld8f(c, cr); ld8f(s, sr);
        bf16x8 a = hi ? other : qr[0], b = hi ? qr[0] : other; rope_frag(a, b, c, s); qr[0] = hi ? b : a;
    } else if constexpr (ROPE == 2) {
        float c[8], s[8]; ld8f(c, cr + 40 + hi * 8); ld8f(s, sr + 40 + hi * 8); rope_frag(qr[0], qr[1], c, s);
    } else {
        float c[8], s[8]; ld8f(c, cr + 8 + hi * 8); ld8f(s, sr + 8 + hi * 8); rope_frag(qr[8], qr[10], c, s);
        ld8f(c, cr + 8 + 16 + hi * 8); ld8f(s, sr + 8 + 16 + hi * 8); rope_frag(qr[9], qr[11], c, s);
    }
    unsigned selmask = 0xffu;
    if constexpr (MODE == 1) {
        __syncthreads();
        for (int i = tid; i < 1024; i += NTHR) kml[i] = kmean_bh[i];
        __syncthreads();
        float g[7];
#pragma unroll
        for (int n = 0; n < 7; ++n) { float s = 0.f;
            if (n < qb) {
#pragma unroll
                for (int d0 = 0; d0 < ND; ++d0) { const u32x4 w = __builtin_bit_cast(u32x4, qr[d0]); const LAS float* km = kml + n * 128 + d0 * 16 + hi * 8;
                    s += bflo(w.x) * km[0] + bfhi(w.x) * km[1] + bflo(w.y) * km[2] + bfhi(w.y) * km[3] + bflo(w.z) * km[4] + bfhi(w.z) * km[5] + bflo(w.w) * km[6] + bfhi(w.w) * km[7]; }
                s += __shfl_xor(s, 32);
            } else s = -__builtin_inff();
            g[n] = s; }
        if (qb <= 3) selmask = (1u << qb) - 1u;
        else { selmask = 0u;
#pragma unroll
            for (int n = 0; n < 7; ++n) { int rank = 0;
#pragma unroll
                for (int m = 0; m < 7; ++m) if (m != n) rank += (g[m] > g[n] || (g[m] == g[n] && m < n)) ? 1 : 0;
                if (rank < 3 && n < qb) selmask |= 1u << n; } }
    }
    constexpr int NKD = (64 * KD * 2) / 8192;
    int gko[NKD], gvo[2];
#pragma unroll
    for (int i = 0; i < NKD; ++i) { const int off = i * 8192 + tid * 16, row = off / (KD * 2), chs = (off - row * (KD * 2)) >> 4, ch = chs ^ (row & 7); gko[i] = row * kpitch + ch * 8; }
#pragma unroll
    for (int i = 0; i < 2; ++i) { const int off = i * 8192 + tid * 16, sub = off >> 9, within = off & 511, kk = (sub >> 2) * 8 + (within >> 6);
        const int k = (kk & ~0xC) | ((kk & 4) << 1) | ((kk & 8) >> 1), c = (sub & 3) * 32 + ((within & 63) >> 1); gvo[i] = k * vpitch + c; }
    const int vb00 = (int)(unsigned)(size_t)V_lds + v_rd_base(lane);
    int kbase4[4];
#pragma unroll
    for (int dd = 0; dd < 4; ++dd) kbase4[dd] = r32 * (KD * 2) + ((((dd * 2 + hi) ^ (r32 & 7))) << 4);
    const int NT = (q0 + 256) / 64;
#define AT_ISSUE(jt_, buf_) do { const size_t kb1_ = (size_t)(jt_) * 64; \
        _Pragma("unroll") for (int i = 0; i < NKD; ++i) __builtin_amdgcn_global_load_lds((const unsigned*)(Kp + kb1_ * kpitch + gko[i]), (LAS unsigned*)(lds + (buf_) * BUFSZ + LK + i * 8192 + wid * 1024), 16, 0, 0); \
        _Pragma("unroll") for (int i = 0; i < 2; ++i) __builtin_amdgcn_global_load_lds((const unsigned*)(Vp + kb1_ * vpitch + gvo[i]), (LAS unsigned*)(lds + (buf_) * BUFSZ + LV + i * 8192 + wid * 1024), 16, 0, 0); } while (0)
    AT_ISSUE(0, 0);
    float m_reg = -1e30f, l_reg = 0.f; f32x16 o[4];
#pragma unroll
    for (int d = 0; d < 4; ++d)
#pragma unroll
        for (int r = 0; r < 16; ++r) o[d][r] = 0.f;
    for (int jt = 0; jt < NT; ++jt) {
        asm volatile("s_waitcnt vmcnt(0)" ::: "memory");
        __syncthreads();
        if (jt + 1 < NT) AT_ISSUE(jt + 1, (jt + 1) & 1);
        const int bo = (jt & 1) * BUFSZ;
        const LAS unsigned char* Kb = K_lds + bo; const int vb0 = vb00 + bo;
        const int kb = jt * 64;
        bool act = kb <= qlo + 31;
        const int blk = jt >> 2;
        if (MODE == 1 && blk < qb) act = __any((int)((selmask >> blk) & 1u)) != 0;
        if (act) {
            f32x16 p0, p1;
#pragma unroll
            for (int r = 0; r < 16; ++r) { p0[r] = 0.f; p1[r] = 0.f; }
#pragma unroll
            for (int d0 = 0; d0 < ND; ++d0) { const LAS unsigned char* a = Kb + kbase4[d0 & 3] + (d0 >> 2) * 128;
                const bf16x8 b0 = *(const LAS bf16x8*)a, b1 = *(const LAS bf16x8*)(a + 32 * KD * 2);
                p0 = __builtin_amdgcn_mfma_f32_32x32x16_bf16(b0, qr[d0], p0, 0, 0, 0);
                p1 = __builtin_amdgcn_mfma_f32_32x32x16_bf16(b1, qr[d0], p1, 0, 0, 0); }
            const float NEG = -__builtin_inff();
            if (kb + 63 > qlo) {
                const int dq = qrow - 4 * hi - kb;
#pragma unroll
                for (int r = 0; r < 16; ++r) { const int c = (r & 3) + 8 * (r >> 2); if (dq - c < 0) p0[r] = NEG; if (dq - c - 32 < 0) p1[r] = NEG; }
            }
            if (MODE == 1 && blk < qb) { if (!((selmask >> blk) & 1u)) {
#pragma unroll
                for (int r = 0; r < 16; ++r) { p0[r] = NEG; p1[r] = NEG; } } }
            float pmax = p0[0];
#pragma unroll
            for (int r = 1; r < 16; ++r) pmax = fmaxf(pmax, p0[r]);
#pragma unroll
            for (int r = 0; r < 16; ++r) pmax = fmaxf(pmax, p1[r]);
            pmax = fmaxf(pmax, __shfl_xor(pmax, 32));
            const bool keep_max = __all((pmax - m_reg) * C2 <= 8.f) != 0;
            float mn = m_reg, alpha = 1.f;
            if (!keep_max) { mn = fmaxf(m_reg, pmax); alpha = __builtin_amdgcn_exp2f((m_reg - mn) * C2); m_reg = mn; }
            const float mnL = -mn * C2;
            float ps = 0.f;
#pragma unroll
            for (int r = 0; r < 16; ++r) { p0[r] = __builtin_amdgcn_exp2f(fmaf(p0[r], C2, mnL)); p1[r] = __builtin_amdgcn_exp2f(fmaf(p1[r], C2, mnL)); ps += p0[r] + p1[r]; }
            ps += __shfl_xor(ps, 32);
            l_reg = l_reg * alpha + ps;
            bf16x8 pa0, pa1, pa2, pa3;
#define PK4(P, B_, OUT) do { unsigned a0 = cvt_pk_bf16(P[B_+0], P[B_+1]), a1 = cvt_pk_bf16(P[B_+2], P[B_+3]); unsigned b0_ = cvt_pk_bf16(P[B_+4], P[B_+5]), b1_ = cvt_pk_bf16(P[B_+6], P[B_+7]); \
        auto r0 = __builtin_amdgcn_permlane32_swap(a0, b0_, false, false); auto r1 = __builtin_amdgcn_permlane32_swap(a1, b1_, false, false); \
        u32x4 w = {r0[0], r1[0], r0[1], r1[1]}; OUT = __builtin_bit_cast(bf16x8, w); } while (0)
            PK4(p0, 0, pa0); PK4(p0, 8, pa1); PK4(p1, 0, pa2); PK4(p1, 8, pa3);
#undef PK4
            if (!keep_max) { if (hi == 0) wsf[r32] = alpha; asm volatile("s_waitcnt lgkmcnt(0)" ::: "memory");
#pragma unroll
                for (int r = 0; r < 16; ++r) { const float a = wsf[crow(r, hi)];
#pragma unroll
                    for (int d = 0; d < 4; ++d) o[d][r] *= a; }
                asm volatile("s_waitcnt lgkmcnt(0)" ::: "memory"); }
#define TRRD(dst, off) asm volatile("ds_read_b64_tr_b16 %0, %1 offset:%2" : "=&v"(dst) : "v"(vb0), "i"(off) : "memory")
#define PV_D0(d0) do { s16x4 l0, l1, l2, l3, h0, h1, h2, h3; constexpr int b_ = v_rd_off(d0, 0, 0); \
        TRRD(l0, b_); TRRD(h0, b_ + 2048); TRRD(l1, b_ + 4096); TRRD(h1, b_ + 6144); TRRD(l2, b_ + 8192); TRRD(h2, b_ + 10240); TRRD(l3, b_ + 12288); TRRD(h3, b_ + 14336); \
        asm volatile("s_waitcnt lgkmcnt(0)" ::: "memory"); __builtin_amdgcn_sched_barrier(0); \
        o[d0] = __builtin_amdgcn_mfma_f32_32x32x16_bf16(pa0, (bf16x8){l0[0], l0[1], l0[2], l0[3], h0[0], h0[1], h0[2], h0[3]}, o[d0], 0, 0, 0); \
        o[d0] = __builtin_amdgcn_mfma_f32_32x32x16_bf16(pa1, (bf16x8){l1[0], l1[1], l1[2], l1[3], h1[0], h1[1], h1[2], h1[3]}, o[d0], 0, 0, 0); \
        o[d0] = __builtin_amdgcn_mfma_f32_32x32x16_bf16(pa2, (bf16x8){l2[0], l2[1], l2[2], l2[3], h2[0], h2[1], h2[2], h2[3]}, o[d0], 0, 0, 0); \
        o[d0] = __builtin_amdgcn_mfma_f32_32x32x16_bf16(pa3, (bf16x8){l3[0], l3[1], l3[2], l3[3], h3[0], h3[1], h3[2], h3[3]}, o[d0], 0, 0, 0); } while (0)
            PV_D0(0); PV_D0(1); PV_D0(2); PV_D0(3);
#undef PV_D0
#undef TRRD
        }
    }
#undef AT_ISSUE
    if (hi == 0) wsf[r32] = l_reg; asm volatile("s_waitcnt lgkmcnt(0)" ::: "memory");
    float rli[16];
#pragma unroll
    for (int r = 0; r < 16; ++r) rli[r] = __builtin_amdgcn_rcpf(wsf[crow(r, hi)]);
    asm volatile("s_waitcnt lgkmcnt(0)" ::: "memory");
    if constexpr (EPI == 0) {
#pragma unroll
        for (int r = 0; r < 16; ++r) { float* op = O1 + (size_t)(qlo + crow(r, hi)) * 512;
#pragma unroll
            for (int d = 0; d < 4; ++d) op[d * 32 + r32] = o[d][r] * rli[r]; }
    } else if constexpr (EPI == 1) {
        float gsub[4];
#pragma unroll
        for (int d = 0; d < 4; ++d) gsub[d] = subg[d * 32 + r32] * outscale;
#pragma unroll
        for (int r = 0; r < 16; ++r) { const int srow = qlo + crow(r, hi); const float* op = O1 + (size_t)srow * 512; float dv[4]; float ss = 0.f;
#pragma unroll
            for (int d = 0; d < 4; ++d) { dv[d] = op[d * 32 + r32] - lam * (o[d][r] * rli[r]); ss += dv[d] * dv[d]; }
#pragma unroll
            for (int off = 1; off < 32; off <<= 1) ss += __shfl_xor(ss, off);
            const float rs = rsqrtf(ss * (1.f / 128.f) + NORM_EPS);
#pragma unroll
            for (int d = 0; d < 4; ++d) { const float v = dv[d] * rs * gsub[d] * O8_SCALE; const float vn = __shfl_xor(v, 1);
                const unsigned h2 = (unsigned)__builtin_amdgcn_cvt_pk_fp8_f32(v, vn, 0, false) & 0xffffu; const unsigned hn = (unsigned)__shfl_xor((int)h2, 2);
                if ((r32 & 3) == 0) *(unsigned*)(Oout + (size_t)srow * 2048 + d * 32 + r32) = h2 | (hn << 16); } }
    } else {
#pragma unroll
        for (int r = 0; r < 16; ++r) { const int srow = qlo + crow(r, hi);
#pragma unroll
            for (int d = 0; d < 4; ++d) { const float v = o[d][r] * rli[r] * O8_SCALE; const float vn = __shfl_xor(v, 1);
                const unsigned h2 = (unsigned)__builtin_amdgcn_cvt_pk_fp8_f32(v, vn, 0, false) & 0xffffu; const unsigned hn = (unsigned)__shfl_xor((int)h2, 2);
                if ((r32 & 3) == 0) *(unsigned*)(Oout + (size_t)srow * 2048 + d * 32 + r32) = h2 | (hn << 16); } }
    }
    __syncthreads();
}
}

__device__ __forceinline__ void phase_attention(const Ctx& C, ArgsK* A, int l) {
    unsigned char* ws = C.ws; const bf16_t* P = (const bf16_t*)(ws + WS_P); const bf16_t* Qm = (const bf16_t*)(ws + WS_QM); const bf16_t* Kf = (const bf16_t*)(ws + WS_KF);
    const bf16_t* Vm = (const bf16_t*)(ws + WS_VM); unsigned char* O = (unsigned char*)(ws + WS_O); float* O1 = (float*)(ws + WS_O1);
    const float* cosT = (const float*)(ws + WS_COS); const float* sinT = (const float*)(ws + WS_SIN); const float* kmean = (const float*)(ws + WS_KMEAN);
    constexpr float LOG2E = 1.4426950408889634f;
    float d1 = 0.f, d2 = 0.f;
    for (int i = 0; i < 64; ++i) { d1 += gptr(A->in[3])[l * 64 + i] * gptr(A->in[4])[l * 64 + i]; d2 += gptr(A->in[5])[l * 64 + i] * gptr(A->in[6])[l * 64 + i]; }
    const float lam_init = 0.8f - 0.6f * expf(-0.3f * (float)l);
    const float lam = expf(d1) - expf(d2) + lam_init;
    {   const int NC = (C.G % 8 == 0 && C.G > CVT_NC) ? CVT_NC : C.G;
        if (C.bid < NC) { Ctx C2 = C; C2.G = NC; phase_convert_moe(C2, A, l); __syncthreads(); } }
    const int nq = (C.G % 8 == 0) ? 8 : 1, qx = C.bid % nq, bpq = 8 / nq, nun = 128 * bpq;
    unsigned* qc = (unsigned*)(ws + WS_CTL) + CW_AQ + l * 8 + qx;
    LAS int* slot = (LAS int*)(C.lds + 90112);
    if (C.tid == 0) *slot = (int)atomicAdd(qc, 1u);
    __syncthreads();
    int cur = __builtin_amdgcn_readfirstlane(*slot);
#pragma nounroll
    while (cur < nun) {
        int nxt = 0; if (C.tid == 0) nxt = (int)atomicAdd(qc, 1u);
        const int per = 16 * bpq, lvl = cur / per, r = cur - lvl * per, b = (r >> 4) * nq + qx, w = r & 15, qb = 7 - lvl, trow0 = b * SEQ;
        if (w < 8) { const int h = w;
            at::attn_unit<192, 0, 1, 2>(C.lds, Qm + (size_t)trow0 * 1536 + h * 192, 1536, Kf + (size_t)trow0 * 1536 + h * 192, 1536, Vm + (size_t)trow0 * 1024 + h * 128, 1024, trow0, qb, cosT, sinT,
                                        0.07216878364870322f * LOG2E, nullptr, nullptr, O + (size_t)trow0 * 2048 + 512 + h * 128, 0.f, 0.f, nullptr);
        } else if (w < 12) { const int h = w - 8;
            const bf16_t* Vp = P + (size_t)trow0 * PC + C_DV + h * 128;
            float* o1 = O1 + ((size_t)trow0 * 4 + h) * 128;
            at::attn_unit<64, 0, 0, 0>(C.lds, P + (size_t)trow0 * PC + C_DQ + h * 128, PC, P + (size_t)trow0 * PC + C_DK + h * 128, PC, Vp, PC, trow0, qb, cosT, sinT, 0.125f * LOG2E, nullptr,
                                       o1, nullptr, 0.f, 0.f, nullptr);
            at::attn_unit<64, 0, 0, 1>(C.lds, P + (size_t)trow0 * PC + C_DQ + h * 128 + 64, PC, P + (size_t)trow0 * PC + C_DK + h * 128 + 64, PC, Vp, PC, trow0, qb, cosT, sinT, 0.125f * LOG2E, nullptr,
                                       o1, O + (size_t)trow0 * 2048 + h * 128, lam, 1.f - lam_init, gptr(A->in[7]) + l * 128);
        } else { const int h = w - 12;
            at::attn_unit<128, 1, 2, 2>(C.lds, P + (size_t)trow0 * PC + C_MQ + h * 128, PC, P + (size_t)trow0 * PC + C_MK + h * 128, PC, P + (size_t)trow0 * PC + C_MV + h * 128, PC, trow0, qb, cosT, sinT,
                                        0.08838834764831845f * LOG2E, kmean + (size_t)(b * 4 + h) * 8 * 128, nullptr, O + (size_t)trow0 * 2048 + 1536 + h * 128, 0.f, 0.f, nullptr);
        }
        if (C.tid == 0) *slot = nxt;
        __syncthreads();
        cur = __builtin_amdgcn_readfirstlane(*slot);
    }
}

__device__ __forceinline__ void ln_row(f32x4 (&v)[4][2], const float* g, const float* bb, float* of, bf16_t* ob, unsigned char* oq, int lane) {
    float s = 0.f;
#pragma unroll
    for (int j = 0; j < 4; ++j)
#pragma unroll
        for (int h = 0; h < 2; ++h) s += (v[j][h][0] + v[j][h][1]) + (v[j][h][2] + v[j][h][3]);
    const float mean = wave_sum(s) * (1.f / DM); float s2 = 0.f;
#pragma unroll
    for (int j = 0; j < 4; ++j)
#pragma unroll
        for (int h = 0; h < 2; ++h) { const f32x4 d = v[j][h] - mean; s2 += (d[0] * d[0] + d[1] * d[1]) + (d[2] * d[2] + d[3] * d[3]); }
    const float rstd = rsqrtf(wave_sum(s2) * (1.f / DM) + NORM_EPS);
#pragma unroll
    for (int j = 0; j < 4; ++j) { const int c = (lane + 64 * j) * 8; f32x4 y[2];
#pragma unroll
        for (int h = 0; h < 2; ++h) { const f32x4 gg = *(const f32x4*)(g + c + 4 * h), b4 = *(const f32x4*)(bb + c + 4 * h); y[h] = (v[j][h] - mean) * rstd * gg + b4; }
        if (of) { *(f32x4*)(of + c) = y[0]; *(f32x4*)(of + c + 4) = y[1]; }
        if (ob) *(u32x4*)(ob + c) = pk8(y[0], y[1]);
        if (oq) { u32x2 q; q.x = pk4_fp8(y[0][0], y[0][1], y[0][2], y[0][3]); q.y = pk4_fp8(y[1][0], y[1][1], y[1][2], y[1][3]); *(u32x2*)(oq + c) = q; } }
}
__device__ __forceinline__ void ld_bf16x8(f32x4 (&d)[2], const bf16_t* p, float sc) { const u32x4 w = *(const u32x4*)p;
    d[0] = (f32x4){bflo(w.x), bfhi(w.x), bflo(w.y), bfhi(w.y)} * sc; d[1] = (f32x4){bflo(w.z), bfhi(w.z), bflo(w.w), bfhi(w.w)} * sc; }
__device__ __forceinline__ void phase_ln_mix(const Ctx& C, ArgsK* A, int l) {
    const bf16_t* Z = (const bf16_t*)(C.ws + WS_X1F); bf16_t* XB1 = (bf16_t*)(C.ws + WS_X1B);
    const float* g = gptr(A->in[14]) + l * DM; const float* bb = gptr(A->in[15]) + l * DM;
    for (int row0 = (C.bid * NWAVES + C.wave) * 4; row0 < T; row0 += C.G * NWAVES * 4) { f32x4 v[4][4][2];
#pragma unroll
        for (int u = 0; u < 4; ++u)
#pragma unroll
            for (int j = 0; j < 4; ++j) ld_bf16x8(v[u][j], Z + (size_t)(row0 + u) * DM + (C.lane + 64 * j) * 8, 1.f);
#pragma unroll
        for (int u = 0; u < 4; ++u) ln_row(v[u], g, bb, nullptr, XB1 + (size_t)(row0 + u) * DM, (unsigned char*)(C.ws + WS_X1Q) + (size_t)(row0 + u) * DM, C.lane); }
}

__device__ __forceinline__ void phase_route(const Ctx& C, ArgsK* A, int l) {
    unsigned char* ws = C.ws; const float* bias = gptr(A->in[17]) + l * NEXP;
    const float* logits = (const float*)(ws + WS_O1);
    int* ridx = (int*)(ws + WS_RIDX); float* rw = (float*)(ws + WS_RW); int* rpos = (int*)(ws + WS_RPOS); int* bbase = (int*)(ws + WS_BBASE);
    unsigned* ecnt = (unsigned*)(ws + WS_CTL) + CW_ECNT + l * 64;
    LAS int* hist = (LAS int*)C.lds;
    const int lane = C.lane;
    for (int chunk = C.bid; chunk < T / 64; chunk += C.G) {
        __syncthreads();
        if (C.tid < 64) hist[C.tid] = 0;
        __syncthreads();
        const float bs = bias[lane]; const float NEGI = -__builtin_inff();
        LAS float* cb = (LAS float*)(C.lds + 1024 + 16384) + C.wave * 128;
        const int gme = lane >> 3;
#pragma nounroll
        for (int q = 0; q < 8; ++q) { const int t = chunk * 64 + C.wave * 8 + q;
            const float* lp = logits + (size_t)t * 64 + lane; const float sv = sigmoidf_((lp[0] + lp[(size_t)T * 64]) + (lp[(size_t)2 * T * 64] + lp[(size_t)3 * T * 64])); const float c = sv + bs;
            cb[lane] = c; asm volatile("s_waitcnt lgkmcnt(0)" ::: "memory");
            const f32x4 ga = *(const LAS f32x4*)(cb + gme * 8), gb = *(const LAS f32x4*)(cb + gme * 8 + 4);
            float m1 = ga[0], m2 = NEGI;
#define TOP2(x) do { const float x_ = (x); const bool gt1 = x_ > m1; m2 = gt1 ? m1 : (x_ > m2 ? x_ : m2); m1 = gt1 ? x_ : m1; } while (0)
            TOP2(ga[1]); TOP2(ga[2]); TOP2(ga[3]); TOP2(gb[0]); TOP2(gb[1]); TOP2(gb[2]); TOP2(gb[3]);
#undef TOP2
            if ((lane & 7) == 0) cb[64 + gme] = m1 + m2;
            asm volatile("s_waitcnt lgkmcnt(0)" ::: "memory");
            const f32x4 s0 = *(const LAS f32x4*)(cb + 64), s1 = *(const LAS f32x4*)(cb + 68);
            const float gsv[8] = {s0[0], s0[1], s0[2], s0[3], s1[0], s1[1], s1[2], s1[3]};
            unsigned keepm = 0u;
#pragma unroll
            for (int g = 0; g < 8; ++g) { int r = 0;
#pragma unroll
                for (int h = 0; h < 8; ++h) if (h != g) r += (gsv[h] > gsv[g] || (gsv[h] == gsv[g] && h < g)) ? 1 : 0;
                if (r < 4) keepm |= 1u << g; }
            const bool keep = (keepm >> gme) & 1u;
            unsigned ub = __float_as_uint(c); ub = (ub & 0x80000000u) ? ~ub : (ub | 0x80000000u);
            const unsigned key = keep ? ((ub & ~63u) | (unsigned)(63 - lane)) : 0u;
            LAS unsigned* kb = (LAS unsigned*)cb;
            asm volatile("s_waitcnt lgkmcnt(0)" ::: "memory");
            kb[lane] = key; asm volatile("s_waitcnt lgkmcnt(0)" ::: "memory");
            int rk = 0;
#pragma unroll
            for (int e4 = 0; e4 < 16; ++e4) { const u32x4 v = *(const LAS u32x4*)(kb + e4 * 4);
                rk += (v[0] > key ? 1 : 0) + (v[1] > key ? 1 : 0) + (v[2] > key ? 1 : 0) + (v[3] > key ? 1 : 0); }
            const bool sel = keep && rk < 8;
            const float wsum = wave_sum(sel ? sv : 0.f);
            if (sel) { const int lr = __hip_atomic_fetch_add(hist + lane, 1, __ATOMIC_RELAXED, __HIP_MEMORY_SCOPE_WORKGROUP); ridx[t * 8 + rk] = lane; rw[t * 8 + rk] = sv / wsum * 2.5f; rpos[t * 8 + rk] = lr; }
            asm volatile("s_waitcnt lgkmcnt(0)" ::: "memory");
        }
        __syncthreads();
        if (C.tid < 64) bbase[chunk * 64 + C.tid] = (int)atomicAdd(ecnt + C.tid, (unsigned)hist[C.tid]);
    }
}
template <bool WANT_SEG> __device__ __forceinline__ void build_moe_tables(const Ctx& C, int l, LAS int* segb  ) {
    const unsigned* ecnt = (const unsigned*)(C.ws + WS_CTL) + CW_ECNT + l * 64;
    LAS unsigned char* tab = C.lds + TAB_OFF; LAS int* tile_e = (LAS int*)(tab + TAB_TILEE); LAS int* misc = (LAS int*)(tab + TAB_MISC);
    __syncthreads();
    if (C.wave == 0) { const int e = C.lane; const int cnt = (int)__hip_atomic_load(ecnt + e, __ATOMIC_RELAXED, __HIP_MEMORY_SCOPE_AGENT); const int nt = (cnt + 255) >> 8;
        int incl = nt;
#pragma unroll
        for (int o = 1; o < 64; o <<= 1) { const int v = __shfl_up(incl, o); if (e >= o) incl += v; }
        const int base = incl - nt; const int nrt = __shfl(incl, 63);
        for (int i = 0; i < nt; ++i) tile_e[base + i] = e;
        tile_e[nrt + e] = NEXP;
        if constexpr (WANT_SEG) segb[e] = base * 256;
        if (e == 0) { misc[0] = nrt; misc[1] = nrt + 64; } }
    __syncthreads();
}
__device__ __forceinline__ void phase_scatter(const Ctx& C, int l) {
    unsigned char* ws = C.ws; const int* ridx = (const int*)(ws + WS_RIDX); const float* rw = (const float*)(ws + WS_RW); int* rpos = (int*)(ws + WS_RPOS); const int* bbase = (const int*)(ws + WS_BBASE);
    int* stok = (int*)(ws + WS_STOK); float* sw = (float*)(ws + WS_SW);
    const unsigned* ecnt = (const unsigned*)(ws + WS_CTL) + CW_ECNT + l * 64;
    LAS int* segb = (LAS int*)C.lds;
    build_moe_tables<true>(C, l, segb);
    for (int chunk = C.bid; chunk < T / 64; chunk += C.G) {
        const int t = chunk * 64 + (C.tid >> 3), k = C.tid & 7; const int e = ridx[t * 8 + k];
        const int pos = segb[e] + bbase[chunk * 64 + e] + rpos[t * 8 + k];
        rpos[t * 8 + k] = pos; stok[pos] = t; sw[pos] = rw[t * 8 + k];
    }
    for (int e = C.bid; e < NEXP; e += C.G) { const int cnt = (int)__hip_atomic_load(ecnt + e, __ATOMIC_RELAXED, __HIP_MEMORY_SCOPE_AGENT); const int endp = segb[e] + ((cnt + 255) & ~255);
        for (int p = segb[e] + cnt + C.tid; p < endp; p += NTHR) { stok[p] = 0; sw[p] = 0.f; } }
    __syncthreads();
}

__device__ __forceinline__ void phase_combine(const Ctx& C, ArgsK* A, int l) {
    unsigned char* ws = C.ws; const bf16_t* X1 = (const bf16_t*)(ws + WS_X1B); const unsigned char* YS = (const unsigned char*)(ws + WS_YS); const int* rpos = (const int*)(ws + WS_RPOS);
    float* OF = (l == 1) ? gptr(A->out) : nullptr; bf16_t* OB = (l == 1) ? nullptr : (bf16_t*)(ws + WS_XB);
    const float* g = gptr(A->in[24]) + l * DM; const float* bb = gptr(A->in[25]) + l * DM;
    for (int row0 = (C.bid * NWAVES + C.wave) * 2; row0 < T; row0 += C.G * NWAVES * 2) {
        int sr[2][9];
#pragma unroll
        for (int u = 0; u < 2; ++u) {
#pragma unroll
            for (int k = 0; k < 8; ++k) sr[u][k] = rpos[(row0 + u) * 8 + k];
            sr[u][8] = RT_ROWS + row0 + u; }
        f32x4 v[2][4][2]; u32x2 yw[2][9][4];
#pragma unroll
        for (int u = 0; u < 2; ++u)
#pragma unroll
            for (int k = 0; k < 9; ++k) { const unsigned char* yr = YS + (size_t)sr[u][k] * DM;
#pragma unroll
                for (int j = 0; j < 4; ++j) yw[u][k][j] = *(const u32x2*)(yr + (C.lane + 64 * j) * 8); }
#pragma unroll
        for (int u = 0; u < 2; ++u)
#pragma unroll
            for (int j = 0; j < 4; ++j) ld_bf16x8(v[u][j], X1 + (size_t)(row0 + u) * DM + (C.lane + 64 * j) * 8, DN_ALPHA);
#pragma unroll
        for (int u = 0; u < 2; ++u) {
#pragma unroll
            for (int j = 0; j < 4; ++j) { f32x4 a0 = {0.f, 0.f, 0.f, 0.f}, a1 = a0;
#pragma unroll
                for (int k = 0; k < 9; ++k) { float lo[4], hi[4]; fp8x4_to_f32(yw[u][k][j].x, lo); fp8x4_to_f32(yw[u][k][j].y, hi);
                    a0 += (f32x4){lo[0], lo[1], lo[2], lo[3]}; a1 += (f32x4){hi[0], hi[1], hi[2], hi[3]}; }
                v[u][j][0] += a0 * (1.f / YS8_SCALE); v[u][j][1] += a1 * (1.f / YS8_SCALE); }
            const int row = row0 + u;
            ln_row(v[u], g, bb, OF ? OF + (size_t)row * DM : nullptr, OB ? OB + (size_t)row * DM : nullptr, OB ? (unsigned char*)(ws + WS_XQ) + (size_t)row * DM : nullptr, C.lane); }
    }
}

template <unsigned MASK> __global__ void __launch_bounds__(NTHR, 2) mk_fwd(Args args) {
    extern __shared__ __attribute__((aligned(16))) unsigned char lds_raw[];
    Ctx C;
    C.lds = (LAS unsigned char*)lds_raw; C.tid = threadIdx.x; C.lane = C.tid & 63; C.wave = __builtin_amdgcn_readfirstlane(C.tid >> 6); C.G = gridDim.x; C.bid = blockIdx.x;
    C.ws = args.ws; C.out = args.out;
    volatile LAS unsigned* MISC = (volatile LAS unsigned*)(C.lds + MISC_OFF);
    if (C.tid < 32) MISC[C.tid] = 0u;
    __syncthreads();
    unsigned char* ws = args.ws; ArgsK* ap;
    unsigned* ctl = (unsigned*)(ws + WS_CTL);
#if MK_ONE_LAUNCH
    XcdBarrier bar = xcd_barrier_post(ctl + CW_BAR, MISC + 8);
#define GRID_BAR() xcd_barrier(bar)
#else
#define GRID_BAR() do { } while (0)
#endif
    const int lo = args.ph_lo, hi = args.ph_hi;
#if MK_ONE_LAUNCH
#define IN(k) true
#else
#define IN(k) (((MASK >> ((k) % NPH)) & 1u) && lo <= (k) && (k) < hi)
#endif
#if MK_ONE_LAUNCH
#define BOTH(k) true
#else
#define BOTH(k) (IN(k) && IN((k) + 1))
#endif
#define OPAQUE_WS() do { ap = (ArgsK*)__builtin_amdgcn_kernarg_segment_ptr(); asm volatile("" : "+s"(ap)); ws = gptr(ap->ws); } while (0)
    for (int l = 0; l < 2; ++l) {
        OPAQUE_WS();
        const int pb = l * NPH;
        float* rsq_q = (float*)(ws + WS_RSQQ); float* rsq_kv = (float*)(ws + WS_RSQKV);
        for (int rep_ = 0; rep_ < REPN(0); ++rep_) if constexpr ((MASK >> 0) & 1u) if (IN(pb + 0)) { OPAQUE_WS(); C.ws = ws; { int t_ = threadIdx.x; asm volatile("" : "+v"(t_)); C.tid = t_; C.lane = t_ & 63; C.wave = __builtin_amdgcn_readfirstlane(t_ >> 6); int b_ = blockIdx.x, g_ = gridDim.x; asm volatile("" : "+s"(b_), "+s"(g_)); C.bid = b_; C.G = g_; }     phase_convert(C, ap, l); if (BOTH(pb + 0)) GRID_BAR(); }
        for (int rep_ = 0; rep_ < REPN(1); ++rep_) if constexpr ((MASK >> 1) & 1u) if (IN(pb + 1)) { OPAQUE_WS(); C.ws = ws; { int t_ = threadIdx.x; asm volatile("" : "+v"(t_)); C.tid = t_; C.lane = t_ & 63; C.wave = __builtin_amdgcn_readfirstlane(t_ >> 6); int b_ = blockIdx.x, g_ = gridDim.x; asm volatile("" : "+s"(b_), "+s"(g_)); C.bid = b_; C.G = g_; }
            { DenseSched S; S.so.init(T, PC, C.G, C.bid); S.A = (const char*)(ws + WS_XQ); S.B = (const char*)(ws + WS_WIN); S.lda = DM; S.ldb = DM; S.nt = DM / 128;
              EpiInProj E{(bf16_t*)(ws + WS_P), rsq_q, rsq_kv};
              gm::gemm_phase<EpiInProj, DenseSched, false, false, true>(C.lds, DM, DM, S, E); }
            if (BOTH(pb + 1)) GRID_BAR(); }
        for (int rep_ = 0; rep_ < REPN(2); ++rep_) if constexpr ((MASK >> 2) & 1u) if (IN(pb + 2)) { OPAQUE_WS(); C.ws = ws; { int t_ = threadIdx.x; asm volatile("" : "+v"(t_)); C.tid = t_; C.lane = t_ & 63; C.wave = __builtin_amdgcn_readfirstlane(t_ >> 6); int b_ = blockIdx.x, g_ = gridDim.x; asm volatile("" : "+s"(b_), "+s"(g_)); C.bid = b_; C.G = g_; }
            if (rep_ == 0) phase_krope(C);
            __syncthreads();
            UpSched S{(const char*)(ws + WS_P), (const char*)(ws + WS_WUQ), (const char*)(ws + WS_WUKV), C.G, C.bid};
            EpiUp E{(bf16_t*)(ws + WS_QM), (bf16_t*)(ws + WS_KF), (bf16_t*)(ws + WS_VM), rsq_q, rsq_kv};
            gm::gemm_phase<EpiUp, UpSched, false, false>(C.lds, PC * 2, 1024, S, E);
            if (BOTH(pb + 2)) GRID_BAR(); }
        for (int rep_ = 0; rep_ < REPN(3); ++rep_) if constexpr ((MASK >> 3) & 1u) if (IN(pb + 3)) { OPAQUE_WS(); C.ws = ws; { int t_ = threadIdx.x; asm volatile("" : "+v"(t_)); C.tid = t_; C.lane = t_ & 63; C.wave = __builtin_amdgcn_readfirstlane(t_ >> 6); int b_ = blockIdx.x, g_ = gridDim.x; asm volatile("" : "+s"(b_), "+s"(g_)); C.bid = b_; C.G = g_; }     phase_attention(C, ap, l); if (BOTH(pb + 3)) GRID_BAR(); }
        for (int rep_ = 0; rep_ < REPN(4); ++rep_) if constexpr ((MASK >> 4) & 1u) if (IN(pb + 4)) { OPAQUE_WS(); C.ws = ws; { int t_ = threadIdx.x; asm volatile("" : "+v"(t_)); C.tid = t_; C.lane = t_ & 63; C.wave = __builtin_amdgcn_readfirstlane(t_ >> 6); int b_ = blockIdx.x, g_ = gridDim.x; asm volatile("" : "+s"(b_), "+s"(g_)); C.bid = b_; C.G = g_; }
            BranchSched S; S.so.init(T, DM, C.G, C.bid); S.A = (const char*)(ws + WS_O); S.B = (const char*)(ws + WS_WBR);
            EpiBranch E{(bf16_t*)(ws + WS_YB), (unsigned char*)(ws + WS_O) + 32 * MiB, (const bf16_t*)(ws + WS_P)};
            gm::gemm_phase<EpiBranch, BranchSched, false, false, true>(C.lds, DM, DM, S, E);
            if (BOTH(pb + 4)) GRID_BAR(); }
        for (int rep_ = 0; rep_ < REPN(5); ++rep_) if constexpr ((MASK >> 5) & 1u) if (IN(pb + 5)) { OPAQUE_WS(); C.ws = ws; { int t_ = threadIdx.x; asm volatile("" : "+v"(t_)); C.tid = t_; C.lane = t_ & 63; C.wave = __builtin_amdgcn_readfirstlane(t_ >> 6); int b_ = blockIdx.x, g_ = gridDim.x; asm volatile("" : "+s"(b_), "+s"(g_)); C.bid = b_; C.G = g_; }
            DenseSched S; S.so.init(T, DM, C.G, C.bid); S.A = (const char*)(ws + WS_O) + 32 * MiB; S.B = (const char*)(ws + WS_WOUT); S.lda = DM; S.ldb = DM; S.nt = DM / 128;
            EpiOut E{(bf16_t*)(ws + WS_X1F), (const bf16_t*)(ws + WS_XB)};
            gm::gemm_phase<EpiOut, DenseSched, false, true, true>(C.lds, DM, DM, S, E);
            if (BOTH(pb + 5)) GRID_BAR(); }
        for (int rep_ = 0; rep_ < REPN(6); ++rep_) if constexpr ((MASK >> 6) & 1u) if (IN(pb + 6)) { OPAQUE_WS(); C.ws = ws; { int t_ = threadIdx.x; asm volatile("" : "+v"(t_)); C.tid = t_; C.lane = t_ & 63; C.wave = __builtin_amdgcn_readfirstlane(t_ >> 6); int b_ = blockIdx.x, g_ = gridDim.x; asm volatile("" : "+s"(b_), "+s"(g_)); C.bid = b_; C.G = g_; }     phase_ln_mix(C, ap, l); if (BOTH(pb + 6)) GRID_BAR(); }
        for (int rep_ = 0; rep_ < REPN(7); ++rep_) if constexpr ((MASK >> 7) & 1u) if (IN(pb + 7)) { OPAQUE_WS(); C.ws = ws; { int t_ = threadIdx.x; asm volatile("" : "+v"(t_)); C.tid = t_; C.lane = t_ & 63; C.wave = __builtin_amdgcn_readfirstlane(t_ >> 6); int b_ = blockIdx.x, g_ = gridDim.x; asm volatile("" : "+s"(b_), "+s"(g_)); C.bid = b_; C.G = g_; }
            RouterSched S{(const char*)(ws + WS_X1B), (const char*)(ws + WS_WR), C.G, C.bid};
            EpiLogit E{(float*)(ws + WS_O1)};
            gm::gemm_phase<EpiLogit, RouterSched, false, false>(C.lds, DM * 2, DM * 2, S, E);
            if (BOTH(pb + 7)) GRID_BAR(); }
        for (int rep_ = 0; rep_ < REPN(8); ++rep_) if constexpr ((MASK >> 8) & 1u) if (IN(pb + 8)) { OPAQUE_WS(); C.ws = ws; { int t_ = threadIdx.x; asm volatile("" : "+v"(t_)); C.tid = t_; C.lane = t_ & 63; C.wave = __builtin_amdgcn_readfirstlane(t_ >> 6); int b_ = blockIdx.x, g_ = gridDim.x; asm volatile("" : "+s"(b_), "+s"(g_)); C.bid = b_; C.G = g_; }     phase_route(C, ap, l); if (BOTH(pb + 8)) GRID_BAR(); }
        for (int rep_ = 0; rep_ < REPN(9); ++rep_) if constexpr ((MASK >> 9) & 1u) if (IN(pb + 9)) { OPAQUE_WS(); C.ws = ws; { int t_ = threadIdx.x; asm volatile("" : "+v"(t_)); C.tid = t_; C.lane = t_ & 63; C.wave = __builtin_amdgcn_readfirstlane(t_ >> 6); int b_ = blockIdx.x, g_ = gridDim.x; asm volatile("" : "+s"(b_), "+s"(g_)); C.bid = b_; C.G = g_; }     phase_scatter(C, l); if (BOTH(pb + 9)) GRID_BAR(); }
        for (int rep_ = 0; rep_ < REPN(10); ++rep_) if constexpr ((MASK >> 10) & 1u) if (IN(pb + 10)) { OPAQUE_WS(); C.ws = ws; { int t_ = threadIdx.x; asm volatile("" : "+v"(t_)); C.tid = t_; C.lane = t_ & 63; C.wave = __builtin_amdgcn_readfirstlane(t_ >> 6); int b_ = blockIdx.x, g_ = gridDim.x; asm volatile("" : "+s"(b_), "+s"(g_)); C.bid = b_; C.G = g_; }
            build_moe_tables<false>(C, l, (LAS int*)C.lds);
            LAS unsigned char* tab = C.lds + TAB_OFF;
            {
                const LAS int* misc = (const LAS int*)(tab + TAB_MISC); const int nrt = misc[0], ntl = misc[1]; const int* stok = (const int*)(ws + WS_STOK);
                LAS unsigned* idx = (LAS unsigned*)(tab + TAB_IDX);
#pragma nounroll
                for (int i = 0; i < 10; ++i) { const int L = xcd_chunk_unit(i, C.bid, C.G, ntl * 4); if (L < 0) break; const int tile = L >> 2;
                    if (C.tid < 256) { idx[i * 256 + C.tid] = tile < nrt ? (unsigned)stok[tile * 256 + C.tid] : (unsigned)((tile - nrt) * 256 + C.tid);
                        ((LAS float*)(tab + TAB_SW))[i * 256 + C.tid] = tile < nrt ? ((const float*)(ws + WS_SW))[tile * 256 + C.tid] : 1.f; } }
                __syncthreads();
            }
            Moe1Sched S1{tab, (const char*)(ws + WS_X1Q), (const char*)(ws + WS_W13), C.G, C.bid};
            EpiMoe1 E1{(unsigned char*)(ws + WS_HID), (const LAS float*)(tab + TAB_SW)};
            gm::gemm_phase<EpiMoe1, Moe1Sched, true, false, true>(C.lds, DM, DM, S1, E1);
#if MK_ONE_LAUNCH
            GRID_BAR();
#endif
        }
        if constexpr (((MASK >> 10) & 1u) && MK_ONE_LAUNCH) if (IN(pb + 10)) { OPAQUE_WS(); C.ws = ws; { int t_ = threadIdx.x; asm volatile("" : "+v"(t_)); C.tid = t_; C.lane = t_ & 63; C.wave = __builtin_amdgcn_readfirstlane(t_ >> 6); int b_ = blockIdx.x, g_ = gridDim.x; asm volatile("" : "+s"(b_), "+s"(g_)); C.bid = b_; C.G = g_; }
            LAS unsigned char* tab = C.lds + TAB_OFF;
            Moe2Sched S2{tab, (const char*)(ws + WS_HID), (const char*)(ws + WS_W2), C.G, C.bid};
            EpiMoe2 E2{(unsigned char*)(ws + WS_YS)};
            for (int rep_ = 0; rep_ < REPN(11); ++rep_) { gm::gemm_phase<EpiMoe2, Moe2Sched, false, false, true>(C.lds, FF, FF, S2, E2);
            GRID_BAR(); }
            for (int rep_ = 0; rep_ < REPN(12); ++rep_) { phase_combine(C, ap, l);
            if (l == 0 || rep_ + 1 < REPN(12)) GRID_BAR(); }
        }
    }
#undef IN
#undef BOTH
}

#if !MK_ONE_LAUNCH
__global__ void __launch_bounds__(NTHR, 2) mk_moe2(Args args, int l) {
    extern __shared__ __attribute__((aligned(16))) unsigned char lds_raw[];
    Ctx C; C.lds = (LAS unsigned char*)lds_raw; C.tid = threadIdx.x; C.lane = C.tid & 63; C.wave = __builtin_amdgcn_readfirstlane(C.tid >> 6); C.G = gridDim.x; C.bid = blockIdx.x; C.ws = args.ws; C.out = args.out;
    build_moe_tables<false>(C, l, (LAS int*)C.lds);
    LAS unsigned char* tab = C.lds + TAB_OFF; unsigned char* ws = args.ws;
    Moe2Sched S2{tab, (const char*)(ws + WS_HID), (const char*)(ws + WS_W2), C.G, C.bid};
    EpiMoe2 E2{(unsigned char*)(ws + WS_YS)};
    gm::gemm_phase<EpiMoe2, Moe2Sched, false, false, true>(C.lds, FF, FF, S2, E2);
}
__global__ void __launch_bounds__(NTHR, 2) mk_combine(Args args, int l) {
    extern __shared__ __attribute__((aligned(16))) unsigned char lds_raw[];
    Ctx C; C.lds = (LAS unsigned char*)lds_raw; C.tid = threadIdx.x; C.lane = C.tid & 63; C.wave = __builtin_amdgcn_readfirstlane(C.tid >> 6); C.G = gridDim.x; C.bid = blockIdx.x; C.ws = args.ws; C.out = args.out;
    phase_combine(C, (ArgsK*)__builtin_amdgcn_kernarg_segment_ptr(), l);
}
#endif


#ifdef DBG_STOP
__global__ void dbg_gather(const unsigned short* H, const unsigned short* YS, const int* rpos, float* out, int mode) {
    const size_t n = (size_t)T * DM;
    for (size_t i = (size_t)blockIdx.x * blockDim.x + threadIdx.x; i < n; i += (size_t)gridDim.x * blockDim.x) {
        if (mode == 9) { const size_t q = i % 131072; const int p = rpos[q]; const int* stok = (const int*)H; const float* sw = (const float*)YS; const bool oor = (p < 0 || p >= 147456);
#if DBG_SUB == 0
            out[i] = oor ? 1.f : 0.f;
#elif DBG_SUB == 1
            out[i] = oor ? 0.f : (stok[p] != (int)(q / 8) ? 1.f : 0.f);
#else
            out[i] = oor ? 0.f : sw[p];
#endif
            }
        else if (mode == 10) { const size_t t = i / 4096, k = (i / 512) % 8, c = i % 512; out[i] = __uint_as_float(((unsigned)H[(size_t)rpos[t * 8 + k] * 512 + c]) << 16); }
        else { const size_t t = i / 2048, c = i % 2048; float s = 0.f; for (int k = 0; k < 8; ++k) s += __uint_as_float(((unsigned)YS[(size_t)rpos[t * 8 + k] * 2048 + c]) << 16); out[i] = s; }
    }
}
__global__ void dbg_copy(const void* src, int is_f32, float* out, size_t n, size_t nsrc) {
    for (size_t i = (size_t)blockIdx.x * blockDim.x + threadIdx.x; i < n; i += (size_t)gridDim.x * blockDim.x) {
        const size_t j = i % nsrc; out[i] = is_f32 ? ((const float*)src)[j] : __uint_as_float(((unsigned)((const unsigned short*)src)[j]) << 16); }
}
#endif
#if MK_ONE_LAUNCH
static hipError_t set_attr_all() { return hipFuncSetAttribute((const void*)mk_fwd<0x7ffu>, hipFuncAttributeMaxDynamicSharedMemorySize, LDS_BYTES); }
#else
template <unsigned M> static hipError_t set_attr_one() { return hipFuncSetAttribute((const void*)mk_fwd<M>, hipFuncAttributeMaxDynamicSharedMemorySize, LDS_BYTES); }
static hipError_t set_attr_all() { hipError_t e = hipSuccess, r;
    r = set_attr_one<1u>(); if (r != hipSuccess) e = r; r = set_attr_one<2u>(); if (r != hipSuccess) e = r; r = set_attr_one<4u>(); if (r != hipSuccess) e = r; r = set_attr_one<8u>(); if (r != hipSuccess) e = r;
    r = set_attr_one<16u>(); if (r != hipSuccess) e = r; r = set_attr_one<32u>(); if (r != hipSuccess) e = r; r = set_attr_one<64u>(); if (r != hipSuccess) e = r; r = set_attr_one<128u>(); if (r != hipSuccess) e = r;
    r = set_attr_one<256u>(); if (r != hipSuccess) e = r; r = set_attr_one<512u>(); if (r != hipSuccess) e = r; r = set_attr_one<1024u>(); if (r != hipSuccess) e = r; return e; }
static void launch_phase(int k, int grid, hipStream_t stream, const Args& a) {
    switch (k) {
    case 0: hipLaunchKernelGGL(mk_fwd<1u>, dim3(grid), dim3(NTHR), LDS_BYTES, stream, a); break;
    case 1: hipLaunchKernelGGL(mk_fwd<2u>, dim3(grid), dim3(NTHR), LDS_BYTES, stream, a); break;
    case 2: hipLaunchKernelGGL(mk_fwd<4u>, dim3(grid), dim3(NTHR), LDS_BYTES, stream, a); break;
    case 3: hipLaunchKernelGGL(mk_fwd<8u>, dim3(grid), dim3(NTHR), LDS_BYTES, stream, a); break;
    case 4: hipLaunchKernelGGL(mk_fwd<16u>, dim3(grid), dim3(NTHR), LDS_BYTES, stream, a); break;
    case 5: hipLaunchKernelGGL(mk_fwd<32u>, dim3(grid), dim3(NTHR), LDS_BYTES, stream, a); break;
    case 6: hipLaunchKernelGGL(mk_fwd<64u>, dim3(grid), dim3(NTHR), LDS_BYTES, stream, a); break;
    case 7: hipLaunchKernelGGL(mk_fwd<128u>, dim3(grid), dim3(NTHR), LDS_BYTES, stream, a); break;
    case 8: hipLaunchKernelGGL(mk_fwd<256u>, dim3(grid), dim3(NTHR), LDS_BYTES, stream, a); break;
    case 9: hipLaunchKernelGGL(mk_fwd<512u>, dim3(grid), dim3(NTHR), LDS_BYTES, stream, a); break;
    default: hipLaunchKernelGGL(mk_fwd<1024u>, dim3(grid), dim3(NTHR), LDS_BYTES, stream, a); break;
    }
}
#endif

extern "C" void kernel_launch(void* const* d_in, const int* in_sizes, int n_in, void* d_out, int out_size, void* d_ws, size_t ws_size, hipStream_t stream) {
    static int grid = 0;
    if (grid == 0) {
        if (n_in != 26 || out_size != T * DM || ws_size < WS_END) { fprintf(stderr, "kernel_launch: unexpected shapes (n_in %d out %d ws %zu need %zu)\n", n_in, out_size, ws_size, (size_t)WS_END); grid = -1; return; }
        int dev = 0, cus = 0;
        if (hipGetDevice(&dev) != hipSuccess || hipDeviceGetAttribute(&cus, hipDeviceAttributeMultiprocessorCount, dev) != hipSuccess) { grid = -1; return; }
        if (set_attr_all() != hipSuccess) { fprintf(stderr, "kernel_launch: hipFuncSetAttribute failed\n"); grid = -1; return; }
#if !MK_ONE_LAUNCH
        (void)hipFuncSetAttribute((const void*)mk_moe2, hipFuncAttributeMaxDynamicSharedMemorySize, LDS_BYTES);
        (void)hipFuncSetAttribute((const void*)mk_combine, hipFuncAttributeMaxDynamicSharedMemorySize, LDS_BYTES);
#endif
        int per_cu = 0;
        if (hipOccupancyMaxActiveBlocksPerMultiprocessor(&per_cu, (const void*)mk_fwd<MK_ONE_LAUNCH ? 0x7ffu : 0x2u>, NTHR, LDS_BYTES) != hipSuccess || per_cu < 1) fprintf(stderr, "kernel_launch: occupancy query says %d\n", per_cu);
        (void)hipGetLastError();
        grid = cus > 256 ? 256 : cus;
    }
    if (grid < 0) return;
    (void)hipMemsetAsync((char*)d_ws + WS_CTL, 0, CTL_ZERO_BYTES, stream);
    Args a{};
    for (int i = 0; i < 26; ++i) a.in[i] = (const float*)d_in[i];
    a.out = (float*)d_out; a.ws = (unsigned char*)d_ws;
    for (int j = 0; j < 8; ++j) a.invf[j] = (float)pow(500000.0, -(double)(2 * j) / 16.0);
    for (int j = 0; j < 32; ++j) a.invf[8 + j] = (float)pow(500000.0, -(double)(2 * j) / 64.0);
    for (int j = 0; j < 16; ++j) a.invf[40 + j] = (float)pow(500000.0, -(double)(2 * j) / 32.0);
#if MK_ONE_LAUNCH
    a.ph_lo = 0; a.ph_hi = 2 * NPH;
    hipLaunchKernelGGL(mk_fwd<0x7ffu>, dim3(grid), dim3(NTHR), LDS_BYTES, stream, a);
#else
#ifdef DBG_STOP
    {
        const int l = 0;
        for (int k = 0; k < NPH && k <= DBG_STOP; ++k) { a.ph_lo = l * NPH + k; a.ph_hi = a.ph_lo + 1; launch_phase(k, grid, stream, a); }
        if (DBG_STOP >= 11) hipLaunchKernelGGL(mk_moe2, dim3(grid), dim3(NTHR), LDS_BYTES, stream, a, l);
        if (DBG_STOP >= 12) hipLaunchKernelGGL(mk_combine, dim3(grid), dim3(NTHR), LDS_BYTES, stream, a, l);
        const size_t n = (size_t)T * DM; unsigned char* w = (unsigned char*)d_ws;
        const void* src; int f32 = 0; size_t nsrc = n;
        switch (DBG_STOP) {
        case 0: src = w + WS_WIN; nsrc = (size_t)10240 * 2048; break;
        case 1: src = w + WS_P; break;
        case 2: src = w + WS_QM; nsrc = (size_t)T * (1536 + 1536 + 1024); break;
        case 3: src = w + WS_O; break;
        case 4: src = w + WS_YB; break;
        case 5: src = w + WS_X1F; f32 = 1; break;
        case 6: src = w + WS_X1B; break;
        case 7: src = w + WS_LOGIT; f32 = 1; nsrc = (size_t)T * 64; break;
        case 8: src = w + WS_RW; f32 = 1; nsrc = (size_t)T * 8; break;
        default: src = w + WS_X2F; f32 = 1; break;
        }
        if (DBG_STOP == 9) hipLaunchKernelGGL(dbg_gather, dim3(1024), dim3(256), 0, stream, (const unsigned short*)(w + WS_STOK), (const unsigned short*)(w + WS_SW), (const int*)(w + WS_RPOS), (float*)d_out, 9);
        else if (DBG_STOP == 10 || DBG_STOP == 11) hipLaunchKernelGGL(dbg_gather, dim3(1024), dim3(256), 0, stream, (const unsigned short*)(w + WS_HID), (const unsigned short*)(w + WS_YS), (const int*)(w + WS_RPOS), (float*)d_out, (int)DBG_STOP);
        else hipLaunchKernelGGL(dbg_copy, dim3(1024), dim3(256), 0, stream, src, f32, (float*)d_out, n, nsrc);
    }
#else
    for (int l = 0; l < 2; ++l) {
        for (int k = 0; k < NPH; ++k) { a.ph_lo = l * NPH + k; a.ph_hi = a.ph_lo + 1; launch_phase(k, grid, stream, a); }
        hipLaunchKernelGGL(mk_moe2, dim3(grid), dim3(NTHR), LDS_BYTES, stream, a, l);
        hipLaunchKernelGGL(mk_combine, dim3(grid), dim3(NTHR), LDS_BYTES, stream, a, l);
    }
#endif
#endif
}
```

```cpp
#include <hip/hip_runtime.h>
#include <cstdio>
#include <cstdint>
#include <cmath>

#ifndef REP_MASK
#define REP_MASK 0
#endif
#define REPN(k) (((REP_MASK >> (k)) & 1) ? 2 : 1)
#ifndef MK_ONE_LAUNCH
#define MK_ONE_LAUNCH 1
#endif

#define LAS __attribute__((address_space(3)))
#define GAS __attribute__((address_space(1)))
typedef unsigned short bf16_t;
typedef short bf16x8 __attribute__((ext_vector_type(8)));
typedef short s16x4 __attribute__((ext_vector_type(4)));
typedef float f32x4 __attribute__((ext_vector_type(4)));
typedef float f32x2 __attribute__((ext_vector_type(2)));
typedef float f32x16 __attribute__((ext_vector_type(16)));
typedef unsigned u32x4 __attribute__((ext_vector_type(4)));
typedef unsigned u32x2 __attribute__((ext_vector_type(2)));
typedef int v4i16_t __attribute__((ext_vector_type(2)));

constexpr int NB = 8, SEQ = 2048, T = NB * SEQ, DM = 2048;
constexpr int PC = 10240;
constexpr int C_DQ = 0, C_DK = 512, C_DV = 1024, C_CQ = 1536, C_CKV = 2048, C_MQ = 2304, C_MK = 2816, C_MV = 3328, C_G = 3840, C_KPE = 9984;
constexpr int IN_COLS = 10048;
constexpr int NEXP = 64, FF = 512;
constexpr int RT_ROWS = 147456;
constexpr int SR_ROWS = RT_ROWS + T;
constexpr int NRT = 56;
constexpr float NORM_EPS = 1e-5f;
constexpr float DN_ALPHA = 1.4142135623730951f;
constexpr int NPH = 11;

constexpr size_t MiB = 1u << 20;
constexpr size_t WS_CTL = 0, CTL_ZERO_BYTES = 1 * MiB;
constexpr int CW_BAR = 4096;
constexpr int CW_AQ = 8448;
#ifndef CVT_NC
#define CVT_NC 96
#endif
constexpr int CW_ECNT = 8192;
constexpr size_t WS_RSQQ = 52 * MiB, WS_RSQKV = 53 * MiB;
constexpr size_t WS_COS = 1 * MiB, WS_SIN = 5 * MiB;
constexpr size_t WS_KMEAN = 9 * MiB;
constexpr size_t WS_LOGIT = 10 * MiB;
constexpr size_t WS_RIDX = 14 * MiB, WS_RW = 14 * MiB + 512 * 1024, WS_RPOS = 15 * MiB, WS_BBASE = 15 * MiB + 512 * 1024;
constexpr size_t WS_STOK = 16 * MiB, WS_SW = 17 * MiB;
constexpr size_t WS_O1 = 18 * MiB;
constexpr size_t WS_WIN = 64 * MiB, WS_WUQ = 104 * MiB, WS_WUKV = 106 * MiB, WS_WR = 108 * MiB, WS_WBR = 109 * MiB, WS_WOUT = 117 * MiB;
constexpr size_t WS_W13 = 125 * MiB, WS_W2 = 385 * MiB;
constexpr size_t WS_XB = 515 * MiB, WS_X1F = 579 * MiB, WS_X1B = 707 * MiB, WS_X2F = 771 * MiB, WS_HID = 899 * MiB;
constexpr size_t WS_BIG = 1059 * MiB;
constexpr size_t WS_P = WS_BIG, WS_QM = WS_P + 320 * MiB, WS_KF = WS_QM + 48 * MiB, WS_VM = WS_KF + 48 * MiB, WS_O = WS_VM + 32 * MiB, WS_YB = WS_O + 64 * MiB;
constexpr size_t WS_X1Q = WS_HID + 80 * MiB;
constexpr size_t WS_XQ = WS_X1Q + 32 * MiB;
constexpr size_t WS_WINQ = WS_WIN + 20 * MiB;
static_assert(WS_XQ + 32 * MiB <= WS_BIG, "ws map");
constexpr size_t WS_YS = WS_BIG;
constexpr size_t WS_MIXALT = WS_BIG + 640 * MiB;
constexpr size_t MIXOFS1 = WS_MIXALT - WS_WIN;
constexpr size_t WS_END = WS_MIXALT + 61 * MiB;
static_assert(WS_YB + 64 * MiB <= WS_MIXALT && WS_HID + (size_t)SR_ROWS * FF * 2 <= WS_BIG, "ws map");

constexpr int RING_BYTES = 131072;
constexpr int TAB_OFF = RING_BYTES;
constexpr int TAB_BYTES = 24576;
constexpr int MISC_OFF = TAB_OFF + TAB_BYTES;
constexpr int LDS_BYTES = 157696;
static_assert(MISC_OFF + 128 <= LDS_BYTES, "lds map");
constexpr int NWAVES = 8, NTHR = 512;

__device__ __forceinline__ unsigned cvt_pk_bf16(float lo, float hi) { unsigned r; asm volatile("v_cvt_pk_bf16_f32 %0, %1, %2" : "=v"(r) : "v"(lo), "v"(hi)); return r; }
__device__ __forceinline__ float bf2f(unsigned short b) { return __uint_as_float(((unsigned)b) << 16); }
__device__ __forceinline__ float bflo(unsigned w) { return __uint_as_float(w << 16); }
__device__ __forceinline__ float bfhi(unsigned w) { return __uint_as_float(w & 0xffff0000u); }
__device__ __forceinline__ bf16x8 pack8(f32x4 a, f32x4 b) { u32x4 w = {cvt_pk_bf16(a[0], a[1]), cvt_pk_bf16(a[2], a[3]), cvt_pk_bf16(b[0], b[1]), cvt_pk_bf16(b[2], b[3])}; return __builtin_bit_cast(bf16x8, w); }
typedef int v8i32 __attribute__((ext_vector_type(8)));
__device__ __forceinline__ unsigned pk4_fp8(float a, float b, float c, float d) { unsigned w = 0; w = __builtin_amdgcn_cvt_pk_fp8_f32(a, b, w, false); w = __builtin_amdgcn_cvt_pk_fp8_f32(c, d, w, true); return w; }
__device__ __forceinline__ float clamp8(float v) { return __builtin_amdgcn_fmed3f(v, -440.f, 440.f); }
constexpr float W8_SCALE = 64.f, H8_SCALE = 8.f, O8_SCALE = 16.f, Y8_SCALE = 8.f, YS8_SCALE = 16.f;
__device__ __forceinline__ void fp8x4_to_f32(unsigned w, float (&o)[4]) { const f32x2 a = __builtin_amdgcn_cvt_pk_f32_fp8((int)w, false), b = __builtin_amdgcn_cvt_pk_f32_fp8((int)w, true); o[0] = a[0]; o[1] = a[1]; o[2] = b[0]; o[3] = b[1]; }
__device__ __forceinline__ float wave_sum(float v) {
#pragma unroll
    for (int o = 1; o < 64; o <<= 1) v += __shfl_xor(v, o);
    return v;
}
__device__ __forceinline__ float sigmoidf_(float x) { return __builtin_amdgcn_rcpf(1.f + __builtin_amdgcn_exp2f(x * -1.4426950408889634f)); }

#define XB_TMO      128
#define XB_XCNT(j)  (256  + 64 * (j))
#define XB_XSUB(j)  (1280 + 64 * (j))
#define XB_XGEN(j)  (2304 + 64 * (j))
#define XB_TOP      3328
#define XB_TOPGEN   3392
#define XCD_BAR_WORDS 3456
#define XB_SPIN_CAP (1u << 20)
__device__ __forceinline__ unsigned xb_ld(unsigned* p)              { return __hip_atomic_load(p, __ATOMIC_RELAXED, __HIP_MEMORY_SCOPE_AGENT); }
__device__ __forceinline__ unsigned xb_add(unsigned* p, unsigned v) { return __hip_atomic_fetch_add(p, v, __ATOMIC_RELAXED, __HIP_MEMORY_SCOPE_AGENT); }
__device__ __forceinline__ unsigned xb_xcc_id() { return (unsigned)__builtin_amdgcn_s_getreg((3 << 11) | 20) & 0xFu; }
#define XB_SPIN(cond, bar) do { unsigned _sp = 0; while (cond) { __builtin_amdgcn_s_sleep(1); \
    if ((++_sp & 255u) == 0u) { if (xb_ld(&(bar)[XB_TMO])) break; if (_sp > XB_SPIN_CAP) { atomicAdd(&(bar)[XB_TMO], 1u); break; } } } } while (0)
struct XcdBarrier { unsigned* bar; unsigned x; volatile LAS unsigned* st; };
__device__ __forceinline__ XcdBarrier xcd_barrier_post(unsigned* bar, volatile LAS unsigned* st) {
    XcdBarrier b; b.bar = bar; b.x = xb_xcc_id(); b.st = st;
    if (threadIdx.x == 0) (void)xb_add(&bar[XB_XCNT(b.x)], 1u);
    return b;
}
__device__ __forceinline__ void xcd_barrier_complete(unsigned* bar, unsigned x, unsigned& nloc, unsigned& nx) {
    asm volatile("" : "+v"(x));
    const unsigned G = gridDim.x * gridDim.y * gridDim.z;
    unsigned sum, cnt, mine, sp = 0u;
    for (;;) {
        sum = 0u; cnt = 0u; mine = 0u;
#pragma unroll
        for (unsigned j = 0; j < 16; ++j) { const unsigned c = xb_ld(&bar[XB_XCNT(j)]); sum += c; cnt += (c > 0u) ? 1u : 0u; mine = (j == x) ? c : mine; }
        if (sum == G) break;
        __builtin_amdgcn_s_sleep(1);
        if ((++sp & 255u) == 0u) { if (xb_ld(&bar[XB_TMO])) break; if (sp > XB_SPIN_CAP) { atomicAdd(&bar[XB_TMO], 1u); break; } }
    }
    nloc = mine > 0u ? mine : 1u; nx = cnt > 0u ? cnt : 1u;
}
__device__ __forceinline__ void xcd_barrier(const XcdBarrier& b) {
    asm volatile("s_waitcnt vmcnt(0)" ::: "memory");
    __syncthreads();
    if (threadIdx.x == 0) {
        GAS unsigned* barg_ = (GAS unsigned*)b.bar; asm volatile("" : "+v"(barg_)); unsigned* bar = (unsigned*)barg_;
        __builtin_amdgcn_s_waitcnt(0);
        unsigned nloc = b.st[0], nx = b.st[1];
        if (nloc == 0u) { xcd_barrier_complete(bar, b.x, nloc, nx); b.st[0] = nloc; b.st[1] = nx; }
        const unsigned old = xb_add(&bar[XB_XSUB(b.x)], 1u);
        const unsigned gen = old / nloc;
        if (old + 1u == (gen + 1u) * nloc) {
            __builtin_amdgcn_fence(__ATOMIC_RELEASE, "agent");
            asm volatile("s_waitcnt vmcnt(0)" ::: "memory");
            const unsigned og = xb_add(&bar[XB_TOP], 1u);
            const unsigned tg = og / nx;
            if (og + 1u == (tg + 1u) * nx) xb_add(&bar[XB_TOPGEN], 1u);
            else XB_SPIN(xb_ld(&bar[XB_TOPGEN]) == tg, bar);
            __builtin_amdgcn_fence(__ATOMIC_ACQUIRE, "agent");
            xb_add(&bar[XB_XGEN(b.x)], 1u);
            asm volatile("s_waitcnt vmcnt(0)" ::: "memory");
        } else {
            XB_SPIN(xb_ld(&bar[XB_XGEN(b.x)]) == gen, bar);
            __builtin_amdgcn_fence(__ATOMIC_ACQUIRE, "agent");
            asm volatile("s_waitcnt vmcnt(0)" ::: "memory");
        }
    }
    __syncthreads();
}

namespace gm {
constexpr int BM = 256, BK = 64, HALF = 128, HTB = HALF * BK * 2, STAGE_BYTES = 8 * HTB, NXCD = 8, WGM = 8;
__device__ __forceinline__ int lds_byte(int r, int c) { const int st = (r >> 4) * 2 + (c >> 5), rr = r & 15, cc = c & 31, ob = rr * 64 + cc * 2; return st * 1024 + (ob ^ (((ob >> 9) & 1) << 5)); }
__device__ __forceinline__ void stage_rc(int b, int& R, int& C) { const int st = b / 1024, sb = b % 1024, swz = sb ^ (((sb >> 9) & 1) << 5); R = (st >> 1) * 16 + swz / 64; C = (st & 1) * 32 + (swz % 64) / 2; }
__device__ __forceinline__ int perm32(int rho) { const int n = rho >> 4, i = rho & 15; return 8 * (i >> 2) + 4 * n + (i & 3); }
struct Unit { int pm, pn; };
struct StaticOrder {
    int nM, nN, nwg, G, c;
    __device__ void init(int M, int N, int G_, int c_) { nM = M / BM; nN = N / BM; nwg = nM * nN; G = G_; c = c_; }
    __device__ bool next(int i, Unit& u) const {
        const long L = (long)i * G + c; if (L >= nwg) return false;
        int wgid = (int)L; { const int q = nwg / NXCD, r = nwg % NXCD, xcd = wgid % NXCD, off = wgid / NXCD; wgid = (xcd < r ? xcd * (q + 1) : r * (q + 1) + (xcd - r) * q) + off; }
        const int nig = WGM * nN, gid = wgid / nig, fm = gid * WGM, gsz = (nM - fm) < WGM ? (nM - fm) : WGM;
        u.pm = fm + ((wgid % nig) % gsz); u.pn = (wgid % nig) / gsz; return true;
    }
};
struct GUnit { const char* A; const char* B; int nt; int pm; int pn; int aux; int idx; };

template <class Epi, class Sched, bool GATHER, bool ALIGN_EPI, bool F8 = false>
__device__ __forceinline__ void gemm_phase(LAS unsigned char* lds, const unsigned lda, const unsigned ldb, const Sched& S, const Epi& E) {
    int tid_ = threadIdx.x; asm volatile("" : "+v"(tid_));
    const int tid = tid_, wid = __builtin_amdgcn_readfirstlane(tid >> 6), lane = tid & 63, wr = wid >> 2, wc = wid & 3, fr = lane & 15, fq = lane >> 4;
    unsigned voffA[2], voffB[2], colA[2]; int RA[2];
#pragma unroll
    for (int i = 0; i < 2; ++i) { int R, C; stage_rc(tid * 16 + i * 8192, R, C); const int Rb = (R & ~31) + perm32(R & 31);
        RA[i] = R; colA[i] = (unsigned)C * 2u; voffA[i] = (unsigned)R * lda + (unsigned)C * 2u; voffB[i] = (unsigned)(Epi::COL16 ? (16 * (Rb >> 3) + (Rb & 7)) : Rb) * ldb + (unsigned)C * 2u; }
    const size_t kstep = (size_t)(BK * 2);
    const size_t hA = GATHER ? 0 : (size_t)HALF * lda, hB = (size_t)(Epi::COL16 ? 8 : HALF) * ldb;
    const unsigned ldsw = (unsigned)wid * 1024u;
    const int aoff = lds_byte(wr * 64 + fr, fq * 8), boff = lds_byte(wc * 32 + fr, fq * 8);
    unsigned gcur[2][2];
#define GM_SA(b, h) (((b) * 2 + (h)) * HTB)
#define GM_SB(b, h) ((4 + (b) * 2 + (h)) * HTB)
#define GM_STAGE_B(bufoff, gbase) do { _Pragma("unroll") for (int _i = 0; _i < 2; ++_i) \
        __builtin_amdgcn_global_load_lds((const unsigned*)((const char*)(gbase) + voffB[_i]), (LAS unsigned*)(lds + (bufoff) + ldsw + _i * 8192), 16, 0, 0); } while (0)
#define GM_STAGE_A(bufoff, gbase, h, nx) do { _Pragma("unroll") for (int _i = 0; _i < 2; ++_i) { \
        unsigned _vo = GATHER ? gcur[h][_i] : voffA[_i]; if (GATHER && (nx) && has_next) _vo = S.rowoff(ui + 1, (h) * HALF + RA[_i]) * lda + colA[_i]; \
        __builtin_amdgcn_global_load_lds((const unsigned*)((const char*)(gbase) + (size_t)(h) * hA + _vo), (LAS unsigned*)(lds + (bufoff) + ldsw + _i * 8192), 16, 0, 0); } } while (0)
#define GM_LD8(p_) ({ const u32x4 lo_ = *(const LAS u32x4*)(p_), hi_ = *(const LAS u32x4*)((p_) + 1024); (v8i32){(int)lo_.x, (int)lo_.y, (int)lo_.z, (int)lo_.w, (int)hi_.x, (int)hi_.y, (int)hi_.z, (int)hi_.w}; })
#define GM_LDA(dst, b, h) do { if constexpr (F8) { _Pragma("unroll") for (int m = 0; m < 4; ++m) dst##8[m] = GM_LD8(lds + GM_SA(b, h) + aoff + m * 2048); } \
        else { _Pragma("unroll") for (int m = 0; m < 4; ++m) _Pragma("unroll") for (int k = 0; k < 2; ++k) dst[m][k] = *(const LAS bf16x8*)(lds + GM_SA(b, h) + aoff + m * 2048 + k * 1024); } } while (0)
#define GM_LDB(dst, b, h) do { if constexpr (F8) { _Pragma("unroll") for (int n = 0; n < 2; ++n) dst##8[n] = GM_LD8(lds + GM_SB(b, h) + boff + n * 2048); } \
        else { _Pragma("unroll") for (int n = 0; n < 2; ++n) _Pragma("unroll") for (int k = 0; k < 2; ++k) dst[n][k] = *(const LAS bf16x8*)(lds + GM_SB(b, h) + boff + n * 2048 + k * 1024); } } while (0)
#define GM_MMA(ai, bj, At, Bt) do { __builtin_amdgcn_s_setprio(1); _Pragma("unroll") for (int m = 0; m < 4; ++m) _Pragma("unroll") for (int n = 0; n < 2; ++n) { \
        if constexpr (F8) { asm volatile("v_mfma_scale_f32_16x16x128_f8f6f4 %0, %1, %2, %0, %3, %4 op_sel_hi:[0,0,0]" : "+v"(acc[ai][bj][m][n]) : "v"(Bt##8[n]), "v"(At##8[m]), "v"(sc_w), "v"(sc_one)); }   \
        else { _Pragma("unroll") for (int k = 0; k < 2; ++k) acc[ai][bj][m][n] = __builtin_amdgcn_mfma_f32_16x16x32_bf16(Bt[n][k], At[m][k], acc[ai][bj][m][n], 0, 0, 0); } } \
        __builtin_amdgcn_s_setprio(0); } while (0)
#define GM_WAIT_V(n) asm volatile("s_waitcnt vmcnt(" #n ")" ::: "memory")
#define GM_WAIT_L(n) asm volatile("s_waitcnt lgkmcnt(" #n ")" ::: "memory")
#define GM_BAR __builtin_amdgcn_s_barrier()
#define GM_SCHED __builtin_amdgcn_sched_barrier(0)
    GUnit cur, nxt; int ui = 0;
    if (!S.next(0, cur)) return;
    if constexpr (GATHER) {
#pragma unroll
        for (int h = 0; h < 2; ++h)
#pragma unroll
            for (int i = 0; i < 2; ++i) gcur[h][i] = S.rowoff(0, h * HALF + RA[i]) * lda + colA[i];
    }
    f32x4 acc[2][2][4][2];
#pragma unroll
    for (int a = 0; a < 2; ++a)
#pragma unroll
        for (int b = 0; b < 2; ++b)
#pragma unroll
            for (int m = 0; m < 4; ++m)
#pragma unroll
                for (int n = 0; n < 2; ++n) acc[a][b][m][n] = (f32x4){0.f, 0.f, 0.f, 0.f};
    int sc_one = 0x7f7f7f7f, sc_w = 0x01010101 * (127 - Epi::BSH); if constexpr (F8) { asm volatile("" : "+v"(sc_one)); asm volatile("" : "+v"(sc_w)); }
    bf16x8 At[4][2], B0[2][2], B1[2][2]; v8i32 At8[4], B08[2], B18[2];
    const char* cA = cur.A; const char* cB = cur.B;
    {
    const bool has_next = false;
    GM_STAGE_B(GM_SB(0, 0), cB); GM_STAGE_B(GM_SB(0, 1), cB + hB); GM_STAGE_A(GM_SA(0, 0), cA, 0, false); GM_STAGE_A(GM_SA(0, 1), cA, 1, false);
    if (wr == 1) GM_BAR;
    GM_WAIT_V(2); GM_BAR;
    GM_STAGE_B(GM_SB(1, 0), cB + kstep); GM_STAGE_A(GM_SA(1, 0), cA + kstep, 0, false); GM_STAGE_B(GM_SB(1, 1), cB + hB + kstep);
    GM_WAIT_V(6); GM_BAR;
    }
    for (;;) {
        const bool has_next = S.next(ui + 1, nxt);
        const char* nA = has_next ? nxt.A : cA; const char* nB = has_next ? nxt.B : cB;
        const int nt = cur.nt;
#pragma nounroll
        for (int t = 0; t < nt; t += 2) {
            const bool last = (t == nt - 2);
            const char* a1 = cA + (size_t)(t + 1) * kstep;
            const char* a2 = last ? nA : cA + (size_t)(t + 2) * kstep; const char* b2 = last ? nB : cB + (size_t)(t + 2) * kstep;
            const char* a3 = a2 + kstep; const char* b3 = b2 + kstep;
            GM_LDB(B0, 0, 0); GM_LDB(B1, 0, 1); GM_SCHED; GM_LDA(At, 0, 0); GM_STAGE_A(GM_SA(1, 1), a1, 1, false);
            GM_WAIT_V(8); GM_WAIT_L(0); GM_BAR; GM_MMA(0, 0, At, B0); GM_MMA(0, 1, At, B1); GM_BAR; GM_SCHED;
            GM_LDA(At, 0, 1); GM_STAGE_B(GM_SB(0, 0), b2); GM_STAGE_B(GM_SB(0, 1), b2 + hB); GM_STAGE_A(GM_SA(0, 0), a2, 0, last);
            GM_WAIT_V(8); GM_WAIT_L(0); GM_BAR; GM_MMA(1, 0, At, B0); GM_MMA(1, 1, At, B1); GM_BAR; GM_SCHED;
            GM_LDB(B0, 1, 0); GM_LDB(B1, 1, 1); GM_SCHED; GM_LDA(At, 1, 0); GM_STAGE_A(GM_SA(0, 1), a2, 1, last);
            GM_WAIT_V(8); GM_WAIT_L(0); GM_BAR; GM_MMA(0, 0, At, B0); GM_MMA(0, 1, At, B1); GM_BAR; GM_SCHED;
            GM_LDA(At, 1, 1); GM_STAGE_B(GM_SB(1, 0), b3); GM_STAGE_B(GM_SB(1, 1), b3 + hB); GM_STAGE_A(GM_SA(1, 0), a3, 0, last);
            GM_WAIT_V(8); GM_WAIT_L(0); GM_BAR; GM_MMA(1, 0, At, B0); GM_MMA(1, 1, At, B1); GM_BAR; GM_SCHED;
        }
        if constexpr (ALIGN_EPI) { if (wr == 0) GM_BAR; }
        if constexpr (F8) asm volatile("s_nop 15\n\ts_nop 15" ::: "memory");
        E(acc, cur, wr, wc, fr, fq);
        if (!has_next) break;
#pragma unroll
        for (int a = 0; a < 2; ++a)
#pragma unroll
            for (int b = 0; b < 2; ++b)
#pragma unroll
                for (int m = 0; m < 4; ++m)
#pragma unroll
                    for (int n = 0; n < 2; ++n) acc[a][b][m][n] = (f32x4){0.f, 0.f, 0.f, 0.f};
        cur = nxt; cA = nA; cB = nB; ++ui;
        if constexpr (GATHER) {
#pragma unroll
            for (int h = 0; h < 2; ++h)
#pragma unroll
                for (int i = 0; i < 2; ++i) gcur[h][i] = S.rowoff(ui, h * HALF + RA[i]) * lda + colA[i];
        }
        if constexpr (ALIGN_EPI) { if (wr == 1) GM_BAR; }
    }
    GM_WAIT_V(0);
    if constexpr (!ALIGN_EPI) { if (wr == 0) GM_BAR; }
    GM_BAR;
#undef GM_SA
#undef GM_SB
#undef GM_STAGE_A
#undef GM_STAGE_B
#undef GM_LDA
#undef GM_LDB
#undef GM_MMA
#undef GM_LD8
#undef GM_WAIT_V
#undef GM_WAIT_L
#undef GM_BAR
#undef GM_SCHED
}
}
using gm::GUnit;
typedef f32x4 AccT[2][2][4][2];

struct Args { const float* in[26]; float* out; unsigned char* ws; float invf[NRT]; int ph_lo, ph_hi; };
typedef const __attribute__((address_space(4))) Args ArgsK;
template <class Tp> __device__ __forceinline__ Tp* gptr(Tp* p) { return (Tp*)(GAS Tp*)p; }
struct Ctx {
    LAS unsigned char* lds; int tid, lane, wave, G, bid;
    unsigned char* ws;
    float* out;
};

struct DenseSched {
    gm::StaticOrder so; const char* A; const char* B; unsigned lda, ldb; int nt;
    __device__ __forceinline__ bool next(int i, GUnit& u) const { gm::Unit t; if (!so.next(i, t)) return false; u.pm = t.pm; u.pn = t.pn; u.aux = 0;
        u.A = A + (size_t)t.pm * 256 * lda; u.B = B + (size_t)t.pn * 256 * ldb; u.nt = nt; return true; }
    __device__ __forceinline__ unsigned rowoff(int, int) const { return 0; }
};
struct BranchSched {
    gm::StaticOrder so; const char* A; const char* B;
    __device__ __forceinline__ bool next(int j, GUnit& u) const { const int jt = j / 3, br = j - 3 * jt; gm::Unit t; if (!so.next(jt, t)) return false;
        const int koff = br == 0 ? 0 : (br == 1 ? 512 : 1536); u.pm = t.pm; u.pn = t.pn; u.aux = br; u.nt = br == 1 ? 8 : 4;
        u.A = A + (size_t)t.pm * 256 * 2048 + koff; u.B = B + (size_t)t.pn * 256 * 2048 + koff; return true; }
    __device__ __forceinline__ unsigned rowoff(int, int) const { return 0; }
};
struct UpSched {
    const char* P; const char* Wq; const char* Wkv; int G, c;
    __device__ __forceinline__ bool next(int i, GUnit& u) const {
        int L;
        if (G == 256) { if (c < 128) { if (i > 2) return false; L = i == 0 ? c : (i == 1 ? 128 + c : 384 + c); }
                        else { if (i > 3) return false; const int d = c - 128; L = i == 0 ? 256 + d : 384 + 128 * i + d; } }
        else { L = i * G + c; if (L >= 896) return false; }
        if (L < 384) { u.pm = L / 6; u.pn = L % 6; u.aux = 0; u.nt = 8; u.A = P + (size_t)u.pm * 256 * (PC * 2) + C_CQ * 2; u.B = Wq + (size_t)u.pn * 256 * 1024; }
        else { const int v = L - 384; u.pm = v / 8; u.pn = v % 8; u.aux = 1; u.nt = 4; u.A = P + (size_t)u.pm * 256 * (PC * 2) + C_CKV * 2; u.B = Wkv + (size_t)u.pn * 256 * 1024; }
        return true; }
    __device__ __forceinline__ unsigned rowoff(int, int) const { return 0; }
};
struct RouterSched {
    const char* X; const char* W; int G, c;
    __device__ __forceinline__ bool next(int i, GUnit& u) const { const int L = i * G + c; if (L >= 256) return false;
        u.pm = L >> 2; u.pn = 0; u.aux = L & 3; u.nt = 8; u.A = X + (size_t)u.pm * 256 * 4096 + (size_t)u.aux * 1024; u.B = W + (size_t)u.aux * 1024; return true; }
    __device__ __forceinline__ unsigned rowoff(int, int) const { return 0; }
};
__device__ __forceinline__ int xcd_chunk_unit(int i, int c, int G, int U) {
    if (G % 8 != 0) { const int L = i * G + c; return L < U ? L : -1; }
    const int per = G / 8, x = c % 8, j = c / 8, q = (U + 7) / 8, lo = x * q, hi = (lo + q < U) ? lo + q : U;
    const int L = lo + i * per + j; return L < hi ? L : -1;
}
constexpr int TAB_TILEE = 0, TAB_MISC = 704 * 4, TAB_IDX = 704 * 4 + 64, TAB_SW = TAB_IDX + 10 * 256 * 4;
struct Moe1Sched {
    LAS unsigned char* tab; const char* X; const char* W13; int G, c;
    __device__ __forceinline__ bool next(int i, GUnit& u) const { const LAS int* misc = (const LAS int*)(tab + TAB_MISC); const int nrt = misc[0], ntl = misc[1];
        const int L = xcd_chunk_unit(i, c, G, ntl * 4); if (L < 0 || i >= 10) return false; const int tile = L >> 2, pn = L & 3; const int e = ((const LAS int*)(tab + TAB_TILEE))[tile];
        u.pm = tile < nrt ? tile * 256 : RT_ROWS + (tile - nrt) * 256; u.pn = pn; u.aux = e; u.idx = i; u.nt = 16; u.A = X; u.B = W13 + (size_t)e * (2 * MiB) + (size_t)pn * 256 * 2048; return true; }
    __device__ __forceinline__ unsigned rowoff(int ui, int r) const { return ((const LAS unsigned*)(tab + TAB_IDX))[ui * 256 + r]; }
};
struct Moe2Sched {
    LAS unsigned char* tab; const char* H; const char* W2; int G, c;
    __device__ __forceinline__ bool next(int i, GUnit& u) const { const LAS int* misc = (const LAS int*)(tab + TAB_MISC); const int nrt = misc[0], ntl = misc[1];
        const int L = xcd_chunk_unit(i, c, G, ntl * 8); if (L < 0) return false; const int tile = L >> 3, pn = L & 7; const int e = ((const LAS int*)(tab + TAB_TILEE))[tile];
        u.pm = tile < nrt ? tile * 256 : RT_ROWS + (tile - nrt) * 256; u.pn = pn; u.aux = e; u.nt = 8; u.nt = 4; u.A = H + (size_t)u.pm * 512; u.B = W2 + (size_t)e * (1 * MiB) + (size_t)pn * 256 * 512; return true; }
    __device__ __forceinline__ unsigned rowoff(int, int) const { return 0; }
};

__device__ __forceinline__ u32x4 pk8(f32x4 v0, f32x4 v1) { u32x4 w; w.x = cvt_pk_bf16(v0[0], v0[1]); w.y = cvt_pk_bf16(v0[2], v0[3]); w.z = cvt_pk_bf16(v1[0], v1[1]); w.w = cvt_pk_bf16(v1[2], v1[3]); return w; }
struct EpiInProj {
    static constexpr bool COL16 = true;
    static constexpr int BSH = 6;
    bf16_t* P; float* rsq_q; float* rsq_kv;
    __device__ __forceinline__ void operator()(const AccT& acc, const GUnit& u, int wr, int wc, int fr, int fq) const {
        const int row0 = u.pm * 256 + wr * 64 + fr, col0 = u.pn * 256 + wc * 64 + 16 * fq;
        const bool sig = (u.pn >= 15 && u.pn < 39); const int sq = (u.pn == 6 || u.pn == 7) ? 1 : (u.pn == 8 ? 2 : 0);
        bf16_t* rowp0 = P + (size_t)row0 * PC + col0;
        if (sig) {
#pragma unroll
            for (int ai = 0; ai < 2; ++ai)
#pragma unroll
                for (int m = 0; m < 4; ++m) { bf16_t* rowp = rowp0 + (size_t)(ai * 128 + m * 16) * PC;
#pragma unroll
                    for (int bj = 0; bj < 2; ++bj) { const f32x4 v0 = acc[ai][bj][m][0], v1 = acc[ai][bj][m][1]; u32x4 w;
                        w.x = __builtin_bit_cast(unsigned, __builtin_amdgcn_cvt_pkrtz(sigmoidf_(v0[0]), sigmoidf_(v0[1]))); w.y = __builtin_bit_cast(unsigned, __builtin_amdgcn_cvt_pkrtz(sigmoidf_(v0[2]), sigmoidf_(v0[3])));
                        w.z = __builtin_bit_cast(unsigned, __builtin_amdgcn_cvt_pkrtz(sigmoidf_(v1[0]), sigmoidf_(v1[1]))); w.w = __builtin_bit_cast(unsigned, __builtin_amdgcn_cvt_pkrtz(sigmoidf_(v1[2]), sigmoidf_(v1[3])));
                        *(u32x4*)(rowp + bj * 8) = w; } }
        } else {
#pragma unroll
            for (int ai = 0; ai < 2; ++ai)
#pragma unroll
                for (int m = 0; m < 4; ++m) { const int row = row0 + ai * 128 + m * 16; bf16_t* rowp = rowp0 + (size_t)(ai * 128 + m * 16) * PC;
#pragma unroll
                    for (int bj = 0; bj < 2; ++bj) *(u32x4*)(rowp + bj * 8) = pk8(acc[ai][bj][m][0], acc[ai][bj][m][1]);
                    if (sq) { float ss = 0.f;
#pragma unroll
                        for (int bj = 0; bj < 2; ++bj) { const f32x4 v0 = acc[ai][bj][m][0], v1 = acc[ai][bj][m][1];
                            ss += (v0[0] * v0[0] + v0[1] * v0[1]) + (v0[2] * v0[2] + v0[3] * v0[3]) + (v1[0] * v1[0] + v1[1] * v1[1]) + (v1[2] * v1[2] + v1[3] * v1[3]); }
                        ss += __shfl_xor(ss, 16); ss += __shfl_xor(ss, 32); if (fq == 0) { if (sq == 1) rsq_q[row * 8 + (u.pn - 6) * 4 + wc] = ss; else rsq_kv[row * 4 + wc] = ss; } } }
        }
    }
};
struct EpiUp {
    static constexpr bool COL16 = false;
    static constexpr int BSH = 0;
    bf16_t* Qm; bf16_t* Kf; bf16_t* Vm; const float* rsq_q; const float* rsq_kv;
    __device__ __forceinline__ void operator()(const AccT& acc, const GUnit& u, int wr, int wc, int fr, int fq) const {
        const int row0 = u.pm * 256 + wr * 64 + fr, cw = wc * 32 + 8 * fq; const bool kv = u.aux != 0;
#pragma unroll
        for (int ai = 0; ai < 2; ++ai)
#pragma unroll
            for (int m = 0; m < 4; ++m) { const int row = row0 + ai * 128 + m * 16;
                float rs; if (kv) { const f32x4 p = *(const f32x4*)(rsq_kv + row * 4); rs = rsqrtf(((p[0] + p[1]) + (p[2] + p[3])) * (1.f / 256.f) + NORM_EPS); }
                else { const f32x4 p = *(const f32x4*)(rsq_q + row * 8), q = *(const f32x4*)(rsq_q + row * 8 + 4); rs = rsqrtf((((p[0] + p[1]) + (p[2] + p[3])) + ((q[0] + q[1]) + (q[2] + q[3]))) * (1.f / 512.f) + NORM_EPS); }
#pragma unroll
                for (int bj = 0; bj < 2; ++bj) { const f32x4 v0 = acc[ai][bj][m][0] * rs, v1 = acc[ai][bj][m][1] * rs;
                    bf16_t* dst = kv ? (bj == 0 ? Kf + (size_t)row * 1536 + u.pn * 192 + cw : Vm + (size_t)row * 1024 + u.pn * 128 + cw) : Qm + (size_t)row * 1536 + u.pn * 256 + bj * 128 + cw;
                    *(u32x4*)dst = pk8(v0, v1); } }
    }
};
typedef _Float16 h16x8 __attribute__((ext_vector_type(8)));
struct EpiBranch {
    static constexpr bool COL16 = true;
    static constexpr int BSH = 10;
    bf16_t* YB; unsigned char* YQ; const bf16_t* P;
    __device__ __forceinline__ void operator()(const AccT& acc, const GUnit& u, int wr, int wc, int fr, int fq) const {
        const int row0 = u.pm * 256 + wr * 64 + fr, col0 = u.pn * 256 + wc * 64 + 16 * fq; const int br = u.aux;
        const bf16_t* gp = P + (size_t)row0 * PC + C_G + br * 2048 + col0; bf16_t* yp = YB + (size_t)row0 * 2048 + col0; unsigned char* qp = YQ + (size_t)row0 * 2048 + col0;
#pragma unroll
        for (int ai = 0; ai < 2; ++ai) { h16x8 gg[4][2], yy[4][2];
#pragma unroll
            for (int m = 0; m < 4; ++m)
#pragma unroll
                for (int bj = 0; bj < 2; ++bj) { const int ro = ai * 128 + m * 16;
                    gg[m][bj] = *(const h16x8*)(gp + (size_t)ro * PC + bj * 8);
                    yy[m][bj] = br != 0 ? *(const h16x8*)(yp + (size_t)ro * 2048 + bj * 8) : (h16x8){0, 0, 0, 0, 0, 0, 0, 0}; }
#pragma unroll
            for (int m = 0; m < 4; ++m)
#pragma unroll
                for (int bj = 0; bj < 2; ++bj) { const int ro = ai * 128 + m * 16; const h16x8 g = gg[m][bj], y = yy[m][bj]; float v[8];
#pragma unroll
                    for (int j = 0; j < 8; ++j) v[j] = acc[ai][bj][m][j >> 2][j & 3] * (float)g[j] + (float)y[j];
                    if (br == 2) { u32x2 q; q.x = pk4_fp8(clamp8(v[0] * Y8_SCALE), clamp8(v[1] * Y8_SCALE), clamp8(v[2] * Y8_SCALE), clamp8(v[3] * Y8_SCALE));
                        q.y = pk4_fp8(clamp8(v[4] * Y8_SCALE), clamp8(v[5] * Y8_SCALE), clamp8(v[6] * Y8_SCALE), clamp8(v[7] * Y8_SCALE)); *(u32x2*)(qp + (size_t)ro * 2048 + bj * 8) = q; }
                    else { u32x4 w; w.x = __builtin_bit_cast(unsigned, __builtin_amdgcn_cvt_pkrtz(v[0], v[1])); w.y = __builtin_bit_cast(unsigned, __builtin_amdgcn_cvt_pkrtz(v[2], v[3]));
                        w.z = __builtin_bit_cast(unsigned, __builtin_amdgcn_cvt_pkrtz(v[4], v[5])); w.w = __builtin_bit_cast(unsigned, __builtin_amdgcn_cvt_pkrtz(v[6], v[7])); *(u32x4*)(yp + (size_t)ro * 2048 + bj * 8) = w; } } }
    }
};
struct EpiOut {
    static constexpr bool COL16 = true;
    static constexpr int BSH = 9;
    bf16_t* Z; const bf16_t* xres;
    __device__ __forceinline__ void operator()(const AccT& acc, const GUnit& u, int wr, int wc, int fr, int fq) const {
        const int row0 = u.pm * 256 + wr * 64 + fr, col0 = u.pn * 256 + wc * 64 + 16 * fq;
#pragma unroll
        for (int ai = 0; ai < 2; ++ai) { u32x4 xr[4][2];
#pragma unroll
            for (int m = 0; m < 4; ++m)
#pragma unroll
                for (int bj = 0; bj < 2; ++bj) xr[m][bj] = *(const u32x4*)(xres + (size_t)(row0 + ai * 128 + m * 16) * 2048 + col0 + bj * 8);
#pragma unroll
            for (int m = 0; m < 4; ++m) { const size_t ro = (size_t)(row0 + ai * 128 + m * 16) * 2048 + col0;
#pragma unroll
                for (int bj = 0; bj < 2; ++bj) { const u32x4 x = xr[m][bj]; f32x4 v0 = acc[ai][bj][m][0], v1 = acc[ai][bj][m][1];
                    v0[0] += DN_ALPHA * bflo(x.x); v0[1] += DN_ALPHA * bfhi(x.x); v0[2] += DN_ALPHA * bflo(x.y); v0[3] += DN_ALPHA * bfhi(x.y);
                    v1[0] += DN_ALPHA * bflo(x.z); v1[1] += DN_ALPHA * bfhi(x.z); v1[2] += DN_ALPHA * bflo(x.w); v1[3] += DN_ALPHA * bfhi(x.w);
                    *(u32x4*)(Z + ro + bj * 8) = pk8(v0, v1); } } }
    }
};
struct EpiLogit {
    static constexpr bool COL16 = false;
    static constexpr int BSH = 0;
    float* L;
    __device__ __forceinline__ void operator()(const AccT& acc, const GUnit& u, int wr, int wc, int fr, int fq) const {
        if (wc >= 2) return; const int row0 = u.pm * 256 + wr * 64 + fr, col0 = wc * 32 + 8 * fq;
#pragma unroll
        for (int ai = 0; ai < 2; ++ai)
#pragma unroll
            for (int m = 0; m < 4; ++m) { float* d = L + (size_t)u.aux * T * 64 + (size_t)(row0 + ai * 128 + m * 16) * 64 + col0; *(f32x4*)d = acc[ai][0][m][0]; *(f32x4*)(d + 4) = acc[ai][0][m][1]; }
    }
};
struct EpiMoe1 {
    static constexpr bool COL16 = false;
    static constexpr int BSH = 6;
    unsigned char* H; const LAS float* sw;
    __device__ __forceinline__ void operator()(const AccT& acc, const GUnit& u, int wr, int wc, int fr, int fq) const {
        const int row0 = u.pm + wr * 64 + fr, col0 = u.pn * 128 + wc * 32 + 8 * fq; const LAS float* swu = sw + u.idx * 256 + wr * 64 + fr;
        float w8[2][4];
#pragma unroll
        for (int ai = 0; ai < 2; ++ai)
#pragma unroll
            for (int m = 0; m < 4; ++m) w8[ai][m] = swu[ai * 128 + m * 16];
#pragma unroll
        for (int ai = 0; ai < 2; ++ai)
#pragma unroll
            for (int m = 0; m < 4; ++m) { const int srow = row0 + ai * 128 + m * 16; const float w = w8[ai][m] * H8_SCALE;
                float h0[4], h1[4];
#pragma unroll
                for (int j = 0; j < 4; ++j) { const float g0 = acc[ai][0][m][0][j], g1 = acc[ai][0][m][1][j];
                    h0[j] = clamp8(g0 * sigmoidf_(g0) * acc[ai][1][m][0][j] * w); h1[j] = clamp8(g1 * sigmoidf_(g1) * acc[ai][1][m][1][j] * w); }
                u32x2 o; o.x = pk4_fp8(h0[0], h0[1], h0[2], h0[3]); o.y = pk4_fp8(h1[0], h1[1], h1[2], h1[3]);
                *(u32x2*)(H + (size_t)srow * FF + col0) = o; }
    }
};
struct EpiMoe2 {
    static constexpr bool COL16 = true;
    static constexpr int BSH = 5;
    unsigned char* Y;
    __device__ __forceinline__ void operator()(const AccT& acc, const GUnit& u, int wr, int wc, int fr, int fq) const {
        const int row0 = u.pm + wr * 64 + fr, col0 = u.pn * 256 + wc * 64 + 16 * fq;
#pragma unroll
        for (int ai = 0; ai < 2; ++ai)
#pragma unroll
            for (int m = 0; m < 4; ++m) { u32x4 q;
                q.x = pk4_fp8(acc[ai][0][m][0][0], acc[ai][0][m][0][1], acc[ai][0][m][0][2], acc[ai][0][m][0][3]); q.y = pk4_fp8(acc[ai][0][m][1][0], acc[ai][0][m][1][1], acc[ai][0][m][1][2], acc[ai][0][m][1][3]);
                q.z = pk4_fp8(acc[ai][1][m][0][0], acc[ai][1][m][0][1], acc[ai][1][m][0][2], acc[ai][1][m][0][3]); q.w = pk4_fp8(acc[ai][1][m][1][0], acc[ai][1][m][1][1], acc[ai][1][m][1][2], acc[ai][1][m][1][3]);
                *(u32x4*)(Y + (size_t)(row0 + ai * 128 + m * 16) * 2048 + col0) = q; }
    }
};

struct CvtJob { const float* src; int pitch; int K; int N; const float* kscale; bf16_t* dst; int dpitch; int grp; int gstride; int rbase; size_t sbs; size_t dbs; int nbatch; int f8; };
template <int NT, int NP> __device__ __forceinline__ void cvt_load(const Ctx& C, const CvtJob& J, f32x4 (&dst)[NP], int it, int per, int nnb) {
    constexpr int TPR = NT / 4, RPP = 512 / TPR;
    const int rr = C.tid / TPR, c4 = (C.tid % TPR) * 4;
    const int e_ = it / per, r_ = it - e_ * per, kb_ = r_ / nnb, nb_ = r_ - kb_ * nnb;
    const float* s_ = J.src + (size_t)e_ * J.sbs + (size_t)(kb_ * 128) * J.pitch + nb_ * NT;
#pragma unroll
    for (int p = 0; p < NP; ++p) { const int k = p * RPP + rr; dst[p] = __builtin_nontemporal_load((const f32x4*)(s_ + (size_t)k * J.pitch + c4)); }
}
template <int NT, int NP> __device__ __forceinline__ void cvt_step(const Ctx& C, const CvtJob& J, f32x4 (&v)[NP], int it, int total, int per, int nnb) {
    LAS float* scr = (LAS float*)C.lds;
    constexpr int TPR = NT / 4, RPP = 512 / TPR, PT = NT + 1, NQ = NT * 16 / 512;
    const int rr = C.tid / TPR, c4 = (C.tid % TPR) * 4;
    const int e = it / per, r = it - e * per, kb = r / nnb, nb = r - kb * nnb;
#pragma unroll
    for (int p = 0; p < NP; ++p) { const int k = p * RPP + rr; f32x4 x = v[p]; if (J.kscale) x = x * J.kscale[kb * 128 + k];
        scr[k * PT + c4 + 0] = x[0]; scr[k * PT + c4 + 1] = x[1]; scr[k * PT + c4 + 2] = x[2]; scr[k * PT + c4 + 3] = x[3]; }
    __syncthreads();
    if (it + 3 * C.G < total) cvt_load<NT, NP>(C, J, v, it + 3 * C.G, per, nnb);
    const int j0 = nb * NT; const int drow0 = (j0 / J.grp) * J.gstride + (j0 % J.grp) + J.rbase;
    if (J.f8) { unsigned char* d8 = (unsigned char*)J.dst + (size_t)e * J.dbs + (size_t)drow0 * J.dpitch + kb * 128;
#pragma unroll
        for (int q = 0; q < NQ; ++q) { const int ch = (C.tid & 7) | ((q & 1) << 3), n = (C.tid >> 3) + 64 * (q >> 1); const LAS float* sp = scr + (8 * ch) * PT + n;
            u32x2 o; o.x = pk4_fp8(sp[0] * W8_SCALE, sp[PT] * W8_SCALE, sp[2 * PT] * W8_SCALE, sp[3 * PT] * W8_SCALE); o.y = pk4_fp8(sp[4 * PT] * W8_SCALE, sp[5 * PT] * W8_SCALE, sp[6 * PT] * W8_SCALE, sp[7 * PT] * W8_SCALE);
            *(u32x2*)(d8 + (size_t)n * J.dpitch + 8 * ch) = o; }
    } else {
        bf16_t* d = J.dst + (size_t)e * J.dbs + (size_t)drow0 * J.dpitch + kb * 128;
#pragma unroll
        for (int q = 0; q < NQ; ++q) { const int ch = (C.tid & 7) | ((q & 1) << 3), n = (C.tid >> 3) + 64 * (q >> 1); const LAS float* sp = scr + (8 * ch) * PT + n;
            u32x4 o; o.x = cvt_pk_bf16(sp[0], sp[PT]); o.y = cvt_pk_bf16(sp[2 * PT], sp[3 * PT]); o.z = cvt_pk_bf16(sp[4 * PT], sp[5 * PT]); o.w = cvt_pk_bf16(sp[6 * PT], sp[7 * PT]);
            *(u32x4*)(d + (size_t)n * J.dpitch + 8 * ch) = o; }
    }
    __syncthreads();
}
template <int NT> __device__ __forceinline__ void cvt_job_t(const Ctx& C, const CvtJob& J, int& rot) {
    constexpr int TPR = NT / 4, RPP = 512 / TPR, NP = 128 / RPP;
    const int nkb = J.K / 128, nnb = J.N / NT, per = nkb * nnb, total = per * J.nbatch;
    int start = C.bid - rot; if (start < 0) start += C.G;
    f32x4 va[NP], vb[NP], vc[NP];
    if (start < total) cvt_load<NT, NP>(C, J, va, start, per, nnb);
    if (start + C.G < total) cvt_load<NT, NP>(C, J, vb, start + C.G, per, nnb);
    if (start + 2 * C.G < total) cvt_load<NT, NP>(C, J, vc, start + 2 * C.G, per, nnb);
#pragma nounroll
    for (int it = start; it < total; it += 3 * C.G) {
        cvt_step<NT, NP>(C, J, va, it, total, per, nnb);
        if (it + C.G < total) cvt_step<NT, NP>(C, J, vb, it + C.G, total, per, nnb);
        if (it + 2 * C.G < total) cvt_step<NT, NP>(C, J, vc, it + 2 * C.G, total, per, nnb);
    }
    rot = (rot + total) % C.G;
}
__device__ __forceinline__ void ld_nt_async(f32x4& v, const float* p) { asm volatile("global_load_dwordx4 %0, %1, off nt" : "=v"(v) : "v"(p)); }
#define CVT_W8(v) "+v"(v[0]), "+v"(v[1]), "+v"(v[2]), "+v"(v[3]), "+v"(v[4]), "+v"(v[5]), "+v"(v[6]), "+v"(v[7])
__device__ __forceinline__ void cvt_loada(const Ctx& C, const CvtJob& J, f32x4 (&dst)[8], int it, int total, int per, int nnb) {
    const int rr = C.tid >> 5, c4 = (C.tid & 31) * 4;
    const bool ok = it < total; const int itc = ok ? it : 0;
    const int e_ = itc / per, r_ = itc - e_ * per, kb_ = r_ / nnb, nb_ = r_ - kb_ * nnb;
    const float* s_ = J.src + (size_t)e_ * J.sbs + (size_t)(kb_ * 128) * J.pitch + nb_ * 128;
#pragma unroll
    for (int p = 0; p < 8; ++p) { const int k = p * 16 + rr; const float* a = ok ? s_ + (size_t)k * J.pitch + c4 : J.src; ld_nt_async(dst[p], a); }
}
__device__ __forceinline__ void cvt_dummy4(const Ctx& C) {
    unsigned char* dp = C.ws + WS_X2F + ((size_t)C.bid * NTHR + C.tid) * 16; u32x2 z = (u32x2){0u, 0u};
#pragma unroll
    for (int q = 0; q < 4; ++q) asm volatile("global_store_dwordx2 %0, %1, off" :: "v"(dp), "v"(z) : "memory");
}
__device__ __forceinline__ void cvt_stepa(const Ctx& C, const CvtJob& J, f32x4 (&v)[8], int it, int total, int per, int nnb, int& par) {
    LAS float* scr = (LAS float*)(C.lds + par * 65536); par ^= 1;
    const int rr = C.tid >> 5, cg = C.tid & 31;
    const int e = it / per, r = it - e * per, kb = r / nnb, nb = r - kb * nnb;
    asm volatile("s_waitcnt vmcnt(28)" : CVT_W8(v));
#pragma unroll
    for (int p = 0; p < 8; ++p) { const int k = p * 16 + rr; f32x4 x = v[p]; if (J.kscale) x = x * J.kscale[kb * 128 + k];
        *(LAS f32x4*)(scr + k * 128 + ((cg ^ ((k >> 3) & 15)) << 2)) = x; }
    __syncthreads();
    cvt_loada(C, J, v, it + 3 * C.G, total, per, nnb);
    const int j0 = nb * 128; const int drow0 = (j0 / J.grp) * J.gstride + (j0 % J.grp) + J.rbase;
    const int k8 = C.tid & 15, g = C.tid >> 4;
    f32x4 x[8];
#pragma unroll
    for (int j = 0; j < 8; ++j) x[j] = *(const LAS f32x4*)(scr + (k8 * 8 + j) * 128 + ((g ^ k8) << 2));
    if (J.f8) { unsigned char* d8 = (unsigned char*)J.dst + (size_t)e * J.dbs + (size_t)drow0 * J.dpitch + kb * 128 + k8 * 8;
#pragma unroll
        for (int q = 0; q < 4; ++q) {
            u32x2 o; o.x = pk4_fp8(x[0][q] * W8_SCALE, x[1][q] * W8_SCALE, x[2][q] * W8_SCALE, x[3][q] * W8_SCALE); o.y = pk4_fp8(x[4][q] * W8_SCALE, x[5][q] * W8_SCALE, x[6][q] * W8_SCALE, x[7][q] * W8_SCALE);
            __builtin_nontemporal_store(o, (u32x2*)(d8 + (size_t)(4 * g + q) * J.dpitch)); }
    } else {
        bf16_t* d = J.dst + (size_t)e * J.dbs + (size_t)drow0 * J.dpitch + kb * 128 + k8 * 8;
#pragma unroll
        for (int q = 0; q < 4; ++q) {
            u32x4 o; o.x = cvt_pk_bf16(x[0][q], x[1][q]); o.y = cvt_pk_bf16(x[2][q], x[3][q]); o.z = cvt_pk_bf16(x[4][q], x[5][q]); o.w = cvt_pk_bf16(x[6][q], x[7][q]);
            __builtin_nontemporal_store(o, (u32x4*)(d + (size_t)(4 * g + q) * J.dpitch)); }
    }
}
__device__ __forceinline__ void cvt_job_a(const Ctx& C, const CvtJob& J, int& rot) {
    const int nkb = J.K / 128, nnb = J.N / 128, per = nkb * nnb, total = per * J.nbatch;
    int start = C.bid - rot; if (start < 0) start += C.G;
    f32x4 va[8], vb[8], vc[8]; int par = 0;
    cvt_loada(C, J, va, start, total, per, nnb); cvt_dummy4(C);
    cvt_loada(C, J, vb, start + C.G, total, per, nnb); cvt_dummy4(C);
    cvt_loada(C, J, vc, start + 2 * C.G, total, per, nnb); cvt_dummy4(C);
#pragma nounroll
    for (int it = start; it < total; it += 3 * C.G) {
        cvt_stepa(C, J, va, it, total, per, nnb, par);
        if (it + C.G < total) cvt_stepa(C, J, vb, it + C.G, total, per, nnb, par);
        if (it + 2 * C.G < total) cvt_stepa(C, J, vc, it + 2 * C.G, total, per, nnb, par);
    }
    asm volatile("s_waitcnt vmcnt(0)" : CVT_W8(va), CVT_W8(vb), CVT_W8(vc));
    __syncthreads();
    rot = (rot + total) % C.G;
}
__device__ __forceinline__ void cvt_job(const Ctx& C, const CvtJob& J, int& rot) { if (J.N % 128 == 0) cvt_job_a(C, J, rot); else cvt_job_t<64>(C, J, rot); }
__device__ __forceinline__ void zero_fill16(const Ctx& C, void* p, size_t bytes) {
    u32x4* q = (u32x4*)p; const size_t n = bytes / 16;
    unsigned z_; asm volatile("v_mov_b32 %0, 0" : "=v"(z_));
    for (size_t i = (size_t)C.bid * NTHR + C.tid; i < n; i += (size_t)C.G * NTHR) q[i] = (u32x4){z_, z_, z_, z_};
}
__device__ __forceinline__ void phase_convert_mixer(const Ctx& C, ArgsK* A, int l, int& rot) {
    unsigned char* ws = C.ws + (l ? MIXOFS1 : 0);
    const float* w_in = gptr(A->in[2]) + (size_t)l * DM * IN_COLS;
    bf16_t* WinT = (bf16_t*)(ws + WS_WIN);
    const int BIG = 1 << 30;
    { CvtJob J{w_in, IN_COLS, DM, 2304, nullptr, WinT, DM, BIG, 0, 0, 0, 0, 1, 1}; cvt_job(C, J, rot); }
    { CvtJob J{w_in + 2368, IN_COLS, DM, 7680, nullptr, WinT, DM, BIG, 0, 2304, 0, 0, 1, 1}; cvt_job(C, J, rot); }
    { CvtJob J{w_in + 2304, IN_COLS, DM, 64, nullptr, WinT, DM, BIG, 0, 9984, 0, 0, 1, 1}; cvt_job(C, J, rot); }
    zero_fill16(C, (unsigned char*)WinT + (size_t)10048 * DM, (size_t)192 * DM);
    { CvtJob J{gptr(A->in[9]) + (size_t)l * 512 * 1536, 1536, 512, 1536, gptr(A->in[8]) + l * 512, (bf16_t*)(ws + WS_WUQ), 512, BIG, 0, 0, 0, 0, 1, 0}; cvt_job(C, J, rot); }
    { CvtJob J{gptr(A->in[11]) + (size_t)l * 256 * 2048, 2048, 256, 2048, gptr(A->in[10]) + l * 256, (bf16_t*)(ws + WS_WUKV), 512, BIG, 0, 0, 0, 0, 1, 0}; cvt_job(C, J, rot); }
    { CvtJob J{gptr(A->in[16]) + (size_t)l * DM * 64, 64, DM, 64, nullptr, (bf16_t*)(ws + WS_WR), DM, BIG, 0, 0, 0, 0, 1, 0}; cvt_job(C, J, rot); }
    zero_fill16(C, (bf16_t*)(ws + WS_WR) + (size_t)64 * DM, (size_t)192 * DM * 2);
    { CvtJob J{gptr(A->in[12]) + (size_t)l * DM * DM, DM, DM, DM, nullptr, (bf16_t*)(ws + WS_WBR), DM, BIG, 0, 0, 0, 0, 1, 1}; cvt_job(C, J, rot); }
    { CvtJob J{gptr(A->in[13]) + (size_t)l * DM * DM, DM, DM, DM, nullptr, (bf16_t*)(ws + WS_WOUT), DM, BIG, 0, 0, 0, 0, 1, 1}; cvt_job(C, J, rot); }
}
__device__ __forceinline__ void phase_convert(const Ctx& C, ArgsK* A, int l) {
    const __attribute__((address_space(4))) float* invf = A->invf;
    unsigned char* ws = C.ws; int rot = 0;
    if (C.bid == 0 && C.tid < 128) ((unsigned*)(ws + WS_CTL))[CW_ECNT + C.tid] = 0u;
    phase_convert_mixer(C, A, 0, rot);
    if (l == 0) {
        const float* x = gptr(A->in[0]); bf16_t* XB = (bf16_t*)(ws + WS_XB);
        for (size_t i = ((size_t)C.bid * NTHR + C.tid) * 8; i < (size_t)T * DM; i += (size_t)C.G * NTHR * 8) {
            const f32x4 a = *(const f32x4*)(x + i), b = *(const f32x4*)(x + i + 4); *(u32x4*)(XB + i) = pk8(a, b);
            u32x2 q; q.x = pk4_fp8(a[0], a[1], a[2], a[3]); q.y = pk4_fp8(b[0], b[1], b[2], b[3]); *(u32x2*)((unsigned char*)(ws + WS_XQ) + i) = q; }
        const int* pos = (const int*)gptr(A->in[1]); float* cosT = (float*)(ws + WS_COS); float* sinT = (float*)(ws + WS_SIN);
        for (int i = C.bid * NTHR + C.tid; i < T * NRT; i += C.G * NTHR) { const int t = i / NRT, j = i - t * NRT;
            const float ang = (float)pos[t] * invf[j];
            const double rev = (double)ang * 0.15915494309189535; const float fr = (float)(rev - floor(rev));
            cosT[i] = __builtin_amdgcn_cosf(fr); sinT[i] = __builtin_amdgcn_sinf(fr); }
    }
}
__device__ __forceinline__ void phase_convert_moe(const Ctx& C, ArgsK* A, int l) {
    unsigned char* ws = C.ws; int rot = 0;
    const int BIG = 1 << 30;
    bf16_t* W13 = (bf16_t*)(ws + WS_W13); bf16_t* W2 = (bf16_t*)(ws + WS_W2);
    const size_t EW = (size_t)DM * FF;
    { CvtJob J{gptr(A->in[18]) + (size_t)l * NEXP * EW, FF, DM, FF, nullptr, W13, DM, 128, 256, 0, EW, (size_t)1024 * DM, NEXP, 1}; cvt_job(C, J, rot); }
    { CvtJob J{gptr(A->in[19]) + (size_t)l * NEXP * EW, FF, DM, FF, nullptr, W13, DM, 128, 256, 128, EW, (size_t)1024 * DM, NEXP, 1}; cvt_job(C, J, rot); }
    { CvtJob J{gptr(A->in[20]) + (size_t)l * NEXP * EW, DM, FF, DM, nullptr, W2, FF, BIG, 0, 0, EW, (size_t)DM * FF, NEXP, 1}; cvt_job(C, J, rot); }
    { CvtJob J{gptr(A->in[21]) + (size_t)l * EW, FF, DM, FF, nullptr, (bf16_t*)((unsigned char*)W13 + (size_t)NEXP * 1024 * DM), DM, 128, 256, 0, 0, 0, 1, 1}; cvt_job(C, J, rot); }
    { CvtJob J{gptr(A->in[22]) + (size_t)l * EW, FF, DM, FF, nullptr, (bf16_t*)((unsigned char*)W13 + (size_t)NEXP * 1024 * DM), DM, 128, 256, 128, 0, 0, 1, 1}; cvt_job(C, J, rot); }
    { CvtJob J{gptr(A->in[23]) + (size_t)l * EW, DM, FF, DM, nullptr, (bf16_t*)((unsigned char*)W2 + (size_t)NEXP * DM * FF), FF, BIG, 0, 0, 0, 0, 1, 1}; cvt_job(C, J, rot); }
    if (l == 0) phase_convert_mixer(C, A, 1, rot);
}

__device__ __forceinline__ void rope8(u32x4& a, u32x4& b, const float* c, const float* s) {
    float x1[8] = {bflo(a.x), bfhi(a.x), bflo(a.y), bfhi(a.y), bflo(a.z), bfhi(a.z), bflo(a.w), bfhi(a.w)};
    float x2[8] = {bflo(b.x), bfhi(b.x), bflo(b.y), bfhi(b.y), bflo(b.z), bfhi(b.z), bflo(b.w), bfhi(b.w)};
    float y1[8], y2[8];
#pragma unroll
    for (int i = 0; i < 8; ++i) { y1[i] = x1[i] * c[i] - x2[i] * s[i]; y2[i] = x2[i] * c[i] + x1[i] * s[i]; }
    a.x = cvt_pk_bf16(y1[0], y1[1]); a.y = cvt_pk_bf16(y1[2], y1[3]); a.z = cvt_pk_bf16(y1[4], y1[5]); a.w = cvt_pk_bf16(y1[6], y1[7]);
    b.x = cvt_pk_bf16(y2[0], y2[1]); b.y = cvt_pk_bf16(y2[2], y2[3]); b.z = cvt_pk_bf16(y2[4], y2[5]); b.w = cvt_pk_bf16(y2[6], y2[7]);
}
__device__ __forceinline__ void ld8f(float (&d)[8], const float* p) { const f32x4 a = *(const f32x4*)p, b = *(const f32x4*)(p + 4); d[0] = a[0]; d[1] = a[1]; d[2] = a[2]; d[3] = a[3]; d[4] = b[0]; d[5] = b[1]; d[6] = b[2]; d[7] = b[3]; }
__device__ __forceinline__ void phase_krope(const Ctx& C) {
    unsigned char* ws = C.ws; bf16_t* P = (bf16_t*)(ws + WS_P); bf16_t* Kf = (bf16_t*)(ws + WS_KF);
    const float* cosT = (const float*)(ws + WS_COS); const float* sinT = (const float*)(ws + WS_SIN); float* kmean = (float*)(ws + WS_KMEAN);
    LAS float* red = (LAS float*)C.lds;
    for (int it = C.bid; it < 64 * 6; it += C.G) {
        const int rb = it / 6, kind = it - rb * 6, r0 = rb * 256;
        if (kind < 4) {
            const int h = kind, c8 = C.tid & 15, rr = C.tid >> 4;
            float cs[16];
#pragma unroll
            for (int j = 0; j < 16; ++j) cs[j] = 0.f;
            if (c8 < 2 || c8 >= 4) {
                for (int p = 0; p < 8; ++p) { const int row = r0 + p * 32 + rr; bf16_t* base = P + (size_t)row * PC + C_MK + h * 128;
                    if (c8 < 2) { u32x4 a = *(const u32x4*)(base + c8 * 8), b = *(const u32x4*)(base + 16 + c8 * 8);
                        float c[8], s[8]; ld8f(c, cosT + (size_t)row * NRT + 40 + c8 * 8); ld8f(s, sinT + (size_t)row * NRT + 40 + c8 * 8);
                        rope8(a, b, c, s); *(u32x4*)(base + c8 * 8) = a; *(u32x4*)(base + 16 + c8 * 8) = b;
                        cs[0] += bflo(a.x); cs[1] += bfhi(a.x); cs[2] += bflo(a.y); cs[3] += bfhi(a.y); cs[4] += bflo(a.z); cs[5] += bfhi(a.z); cs[6] += bflo(a.w); cs[7] += bfhi(a.w);
                        cs[8] += bflo(b.x); cs[9] += bfhi(b.x); cs[10] += bflo(b.y); cs[11] += bfhi(b.y); cs[12] += bflo(b.z); cs[13] += bfhi(b.z); cs[14] += bflo(b.w); cs[15] += bfhi(b.w);
                    } else { const u32x4 a = *(const u32x4*)(base + c8 * 8);
                        cs[0] += bflo(a.x); cs[1] += bfhi(a.x); cs[2] += bflo(a.y); cs[3] += bfhi(a.y); cs[4] += bflo(a.z); cs[5] += bfhi(a.z); cs[6] += bflo(a.w); cs[7] += bfhi(a.w); } }
            }
            if (c8 < 2) {
#pragma unroll
                for (int j = 0; j < 8; ++j) { red[rr * 128 + c8 * 8 + j] = cs[j]; red[rr * 128 + 16 + c8 * 8 + j] = cs[8 + j]; } }
            else if (c8 >= 4) {
#pragma unroll
                for (int j = 0; j < 8; ++j) red[rr * 128 + c8 * 8 + j] = cs[j]; }
            __syncthreads();
            if (C.tid < 128) { float s = 0.f; for (int q = 0; q < 32; ++q) s += red[q * 128 + C.tid];
                const int b = rb >> 3, nb = rb & 7; kmean[((size_t)(b * 4 + h) * 8 + nb) * 128 + C.tid] = s * (1.f / 256.f); }
            __syncthreads();
        } else if (kind == 4) {
            for (int q = 0; q < 4; ++q) { const int idx = C.tid + 512 * q, g = idx & 7, row = r0 + (idx >> 3); bf16_t* base = P + (size_t)row * PC + C_DK + g * 64;
                u32x4 a = *(const u32x4*)base, b = *(const u32x4*)(base + 8); float c[8], s[8]; ld8f(c, cosT + (size_t)row * NRT); ld8f(s, sinT + (size_t)row * NRT);
                rope8(a, b, c, s); *(u32x4*)base = a; *(u32x4*)(base + 8) = b; }
        } else {
            for (int q = 0; q < 2; ++q) { const int idx = C.tid + 512 * q, g = idx & 3, row = r0 + (idx >> 2); const bf16_t* base = P + (size_t)row * PC + C_KPE;
                u32x4 a = *(const u32x4*)(base + g * 8), b = *(const u32x4*)(base + 32 + g * 8); float c[8], s[8]; ld8f(c, cosT + (size_t)row * NRT + 8 + g * 8); ld8f(s, sinT + (size_t)row * NRT + 8 + g * 8);
                rope8(a, b, c, s);
#pragma unroll
                for (int h = 0; h < 8; ++h) { bf16_t* d = Kf + (size_t)row * 1536 + h * 192 + 128; *(u32x4*)(d + g * 8) = a; *(u32x4*)(d + 32 + g * 8) = b; } }
        }
    }
}

namespace at {
constexpr int LK = 0, LV = 24576, BUFSZ = 40960, LWS = 2 * BUFSZ, LKM = LWS + 2048;
__device__ __forceinline__ int v_st(int k, int c) { const int kk = (k & ~0xC) | ((k & 4) << 1) | ((k & 8) >> 1); return ((kk >> 3) * 4 + (c >> 5)) * 512 + ((kk & 7) * 32 + (c & 31)) * 2; }
__device__ __forceinline__ int v_rd_base(int lane) { return ((lane & 3) << 3) | (((lane >> 2) & 3) << 6) | (((lane >> 4) & 1) << 5) | (((lane >> 5) & 1) << 8); }
constexpr int v_rd_off(int d0, int ks, int half) { return d0 * 512 + ks * 4096 + half * 2048; }
__device__ __forceinline__ int crow(int r, int hi) { return (r & 3) + 8 * (r >> 2) + 4 * hi; }

__device__ __forceinline__ void rope_frag(bf16x8& a, bf16x8& b, const float* c, const float* s) {
    u32x4 ua = __builtin_bit_cast(u32x4, a), ub = __builtin_bit_cast(u32x4, b); rope8(ua, ub, c, s); a = __builtin_bit_cast(bf16x8, ua); b = __builtin_bit_cast(bf16x8, ub);
}

template <int KD, int MODE, int ROPE, int EPI>
__device__ __forceinline__ void attn_unit(LAS unsigned char* lds, const bf16_t* Qp, int qpitch, const bf16_t* Kp, int kpitch, const bf16_t* Vp, int vpitch,
                                          int trow0, int qb, const float* cosT, const float* sinT, float C2, const float* kmean_bh,
                                          float* O1, unsigned char* Oout, float lam, float outscale, const float* subg) {
    int tid_ = threadIdx.x; asm volatile("" : "+v"(tid_));
    const int tid = tid_, wid = __builtin_amdgcn_readfirstlane(tid >> 6), lane = tid & 63, r32 = lane & 31, hi = lane >> 5;
    const int q0 = qb * 256, qlo = q0 + wid * 32, qrow = qlo + r32;
    LAS unsigned char* K_lds = lds + LK; LAS unsigned char* V_lds = lds + LV;
    LAS float* wsf = (LAS float*)(lds + LWS) + wid * 64; LAS float* kml = (LAS float*)(lds + LKM);
    constexpr int ND = KD / 16;
    bf16x8 qr[ND];
    const bf16_t* qrowp = Qp + (size_t)qrow * qpitch;
#pragma unroll
    for (int d0 = 0; d0 < ND; ++d0) qr[d0] = *(const bf16x8*)(qrowp + d0 * 16 + hi * 8);
    const float* cr = cosT + (size_t)(trow0 + qrow) * NRT; const float* sr = sinT + (size_t)(trow0 + qrow) * NRT;
    if constexpr (ROPE == 0) {
        bf16x8 other = *(const bf16x8*)(qrowp + (1 - hi) * 8); float c[8], s[8]; ld8f(c, cr); ld8f(s, sr);
        bf16x8 a = hi ? other : qr[0], b = hi ? qr[0] : other; rope_frag(a, b, c, s); qr[0] = hi ? b : a;
    } else if constexpr (ROPE == 2) {
        float c[8], s[8]; ld8f(c, cr + 40 + hi * 8); ld8f(s, sr + 40 + hi * 8); rope_frag(qr[0], qr[1], c, s);
    } else {
        float c[8], s[8]; ld8f(c, cr + 8 + hi * 8); ld8f(s, sr + 8 + hi * 8); rope_frag(qr[8], qr[10], c, s);
        ld8f(c, cr + 8 + 16 + hi * 8); ld8f(s, sr + 8 + 16 + hi * 8); rope_frag(qr[9], qr[11], c, s);
    }
    unsigned selmask = 0xffu;
    if constexpr (MODE == 1) {
        __syncthreads();
        for (int i = tid; i < 1024; i += NTHR) kml[i] = kmean_bh[i];
        __syncthreads();
        float g[7];
#pragma unroll
        for (int n = 0; n < 7; ++n) { float s = 0.f;
            if (n < qb) {
#pragma unroll
                for (int d0 = 0; d0 < ND; ++d0) { const u32x4 w = __builtin_bit_cast(u32x4, qr[d0]); const LAS float* km = kml + n * 128 + d0 * 16 + hi * 8;
                    s += bflo(w.x) * km[0] + bfhi(w.x) * km[1] + bflo(w.y) * km[2] + bfhi(w.y) * km[3] + bflo(w.z) * km[4] + bfhi(w.z) * km[5] + bflo(w.w) * km[6] + bfhi(w.w) * km[7]; }
                s += __shfl_xor(s, 32);
            } else s = -__builtin_inff();
            g[n] = s; }
        if (qb <= 3) selmask = (1u << qb) - 1u;
        else { selmask = 0u;
#pragma unroll
            for (int n = 0; n < 7; ++n) { int rank = 0;
#pragma unroll
                for (int m = 0; m < 7; ++m) if (m != n) rank += (g[m] > g[n] || (g[m] == g[n] && m < n)) ? 1 : 0;
                if (rank < 3 && n < qb) selmask |= 1u << n; } }
    }
    constexpr int NKD = (64 * KD * 2) / 8192;
    int gko[NKD], gvo[2];
#pragma unroll
    for (int i = 0; i < NKD; ++i) { const int off = i * 8192 + tid * 16, row = off / (KD * 2), chs = (off - row * (KD * 2)) >> 4, ch = chs ^ (row & 7); gko[i] = row * kpitch + ch * 8; }
#pragma unroll
    for (int i = 0; i < 2; ++i) { const int off = i * 8192 + tid * 16, sub = off >> 9, within = off & 511, kk = (sub >> 2) * 8 + (within >> 6);
        const int k = (kk & ~0xC) | ((kk & 4) << 1) | ((kk & 8) >> 1), c = (sub & 3) * 32 + ((within & 63) >> 1); gvo[i] = k * vpitch + c; }
    const int vb00 = (int)(unsigned)(size_t)V_lds + v_rd_base(lane);
    int kbase4[4];
#pragma unroll
    for (int dd = 0; dd < 4; ++dd) kbase4[dd] = r32 * (KD * 2) + ((((dd * 2 + hi) ^ (r32 & 7))) << 4);
    const int NT = (q0 + 256) / 64;
#define AT_ISSUE(jt_, buf_) do { const size_t kb1_ = (size_t)(jt_) * 64; \
        _Pragma("unroll") for (int i = 0; i < NKD; ++i) __builtin_amdgcn_global_load_lds((const unsigned*)(Kp + kb1_ * kpitch + gko[i]), (LAS unsigned*)(lds + (buf_) * BUFSZ + LK + i * 8192 + wid * 1024), 16, 0, 0); \
        _Pragma("unroll") for (int i = 0; i < 2; ++i) __builtin_amdgcn_global_load_lds((const unsigned*)(Vp + kb1_ * vpitch + gvo[i]), (LAS unsigned*)(lds + (buf_) * BUFSZ + LV + i * 8192 + wid * 1024), 16, 0, 0); } while (0)
    AT_ISSUE(0, 0);
    float m_reg = -1e30f, l_reg = 0.f; f32x16 o[4];
#pragma unroll
    for (int d = 0; d < 4; ++d)
#pragma unroll
        for (int r = 0; r < 16; ++r) o[d][r] = 0.f;
    for (int jt = 0; jt < NT; ++jt) {
        asm volatile("s_waitcnt vmcnt(0)" ::: "memory");
        __syncthreads();
        if (jt + 1 < NT) AT_ISSUE(jt + 1, (jt + 1) & 1);
        const int bo = (jt & 1) * BUFSZ;
        const LAS unsigned char* Kb = K_lds + bo; const int vb0 = vb00 + bo;
        const int kb = jt * 64;
        bool act = kb <= qlo + 31;
        const int blk = jt >> 2;
        if (MODE == 1 && blk < qb) act = __any((int)((selmask >> blk) & 1u)) != 0;
        if (act) {
            f32x16 p0, p1;
#pragma unroll
            for (int r = 0; r < 16; ++r) { p0[r] = 0.f; p1[r] = 0.f; }
#pragma unroll
            for (int d0 = 0; d0 < ND; ++d0) { const LAS unsigned char* a = Kb + kbase4[d0 & 3] + (d0 >> 2) * 128;
                const bf16x8 b0 = *(const LAS bf16x8*)a, b1 = *(const LAS bf16x8*)(a + 32 * KD * 2);
                p0 = __builtin_amdgcn_mfma_f32_32x32x16_bf16(b0, qr[d0], p0, 0, 0, 0);
                p1 = __builtin_amdgcn_mfma_f32_32x32x16_bf16(b1, qr[d0], p1, 0, 0, 0); }
            const float NEG = -__builtin_inff();
            if (kb + 63 > qlo) {
                const int dq = qrow - 4 * hi - kb;
#pragma unroll
                for (int r = 0; r < 16; ++r) { const int c = (r & 3) + 8 * (r >> 2); if (dq - c < 0) p0[r] = NEG; if (dq - c - 32 < 0) p1[r] = NEG; }
            }
            if (MODE == 1 && blk < qb) { if (!((selmask >> blk) & 1u)) {
#pragma unroll
                for (int r = 0; r < 16; ++r) { p0[r] = NEG; p1[r] = NEG; } } }
            float pmax = p0[0];
#pragma unroll
            for (int r = 1; r < 16; ++r) pmax = fmaxf(pmax, p0[r]);
#pragma unroll
            for (int r = 0; r < 16; ++r) pmax = fmaxf(pmax, p1[r]);
            pmax = fmaxf(pmax, __shfl_xor(pmax, 32));
            const bool keep_max = __all((pmax - m_reg) * C2 <= 8.f) != 0;
            float mn = m_reg, alpha = 1.f;
            if (!keep_max) { mn = fmaxf(m_reg, pmax); alpha = __builtin_amdgcn_exp2f((m_reg - mn) * C2); m_reg = mn; }
            const float mnL = -mn * C2;
            float ps = 0.f;
#pragma unroll
            for (int r = 0; r < 16; ++r) { p0[r] = __builtin_amdgcn_exp2f(fmaf(p0[r], C2, mnL)); p1[r] = __builtin_amdgcn_exp2f(fmaf(p1[r], C2, mnL)); ps += p0[r] + p1[r]; }
            ps += __shfl_xor(ps, 32);
            l_reg = l_reg * alpha + ps;
            bf16x8 pa0, pa1, pa2, pa3;
#define PK4(P, B_, OUT) do { unsigned a0 = cvt_pk_bf16(P[B_+0], P[B_+1]), a1 = cvt_pk_bf16(P[B_+2], P[B_+3]); unsigned b0_ = cvt_pk_bf16(P[B_+4], P[B_+5]), b1_ = cvt_pk_bf16(P[B_+6], P[B_+7]); \
        auto r0 = __builtin_amdgcn_permlane32_swap(a0, b0_, false, false); auto r1 = __builtin_amdgcn_permlane32_swap(a1, b1_, false, false); \
        u32x4 w = {r0[0], r1[0], r0[1], r1[1]}; OUT = __builtin_bit_cast(bf16x8, w); } while (0)
            PK4(p0, 0, pa0); PK4(p0, 8, pa1); PK4(p1, 0, pa2); PK4(p1, 8, pa3);
#undef PK4
            if (!keep_max) { if (hi == 0) wsf[r32] = alpha; asm volatile("s_waitcnt lgkmcnt(0)" ::: "memory");
#pragma unroll
                for (int r = 0; r < 16; ++r) { const float a = wsf[crow(r, hi)];
#pragma unroll
                    for (int d = 0; d < 4; ++d) o[d][r] *= a; }
                asm volatile("s_waitcnt lgkmcnt(0)" ::: "memory"); }
#define TRRD(dst, off) asm volatile("ds_read_b64_tr_b16 %0, %1 offset:%2" : "=&v"(dst) : "v"(vb0), "i"(off) : "memory")
#define PV_D0(d0) do { s16x4 l0, l1, l2, l3, h0, h1, h2, h3; constexpr int b_ = v_rd_off(d0, 0, 0); \
        TRRD(l0, b_); TRRD(h0, b_ + 2048); TRRD(l1, b_ + 4096); TRRD(h1, b_ + 6144); TRRD(l2, b_ + 8192); TRRD(h2, b_ + 10240); TRRD(l3, b_ + 12288); TRRD(h3, b_ + 14336); \
        asm volatile("s_waitcnt lgkmcnt(0)" ::: "memory"); __builtin_amdgcn_sched_barrier(0); \
        o[d0] = __builtin_amdgcn_mfma_f32_32x32x16_bf16(pa0, (bf16x8){l0[0], l0[1], l0[2], l0[3], h0[0], h0[1], h0[2], h0[3]}, o[d0], 0, 0, 0); \
        o[d0] = __builtin_amdgcn_mfma_f32_32x32x16_bf16(pa1, (bf16x8){l1[0], l1[1], l1[2], l1[3], h1[0], h1[1], h1[2], h1[3]}, o[d0], 0, 0, 0); \
        o[d0] = __builtin_amdgcn_mfma_f32_32x32x16_bf16(pa2, (bf16x8){l2[0], l2[1], l2[2], l2[3], h2[0], h2[1], h2[2], h2[3]}, o[d0], 0, 0, 0); \
        o[d0] = __builtin_amdgcn_mfma_f32_32x32x16_bf16(pa3, (bf16x8){l3[0], l3[1], l3[2], l3[3], h3[0], h3[1], h3[2], h3[3]}, o[d0], 0, 0, 0); } while (0)
            PV_D0(0); PV_D0(1); PV_D0(2); PV_D0(3);
#undef PV_D0
#undef TRRD
        }
    }
#undef AT_ISSUE
    if (hi == 0) wsf[r32] = l_reg; asm volatile("s_waitcnt lgkmcnt(0)" ::: "memory");
    float rli[16];
#pragma unroll
    for (int r = 0; r < 16; ++r) rli[r] = __builtin_amdgcn_rcpf(wsf[crow(r, hi)]);
    asm volatile("s_waitcnt lgkmcnt(0)" ::: "memory");
    if constexpr (EPI == 0) {
#pragma unroll
        for (int r = 0; r < 16; ++r) { float* op = O1 + (size_t)(qlo + crow(r, hi)) * 512;
#pragma unroll
            for (int d = 0; d < 4; ++d) op[d * 32 + r32] = o[d][r] * rli[r]; }
    } else if constexpr (EPI == 1) {
        float gsub[4];
#pragma unroll
        for (int d = 0; d < 4; ++d) gsub[d] = subg[d * 32 + r32] * outscale;
#pragma unroll
        for (int r = 0; r < 16; ++r) { const int srow = qlo + crow(r, hi); const float* op = O1 + (size_t)srow * 512; float dv[4]; float ss = 0.f;
#pragma unroll
            for (int d = 0; d < 4; ++d) { dv[d] = op[d * 32 + r32] - lam * (o[d][r] * rli[r]); ss += dv[d] * dv[d]; }
#pragma unroll
            for (int off = 1; off < 32; off <<= 1) ss += __shfl_xor(ss, off);
            const float rs = rsqrtf(ss * (1.f / 128.f) + NORM_EPS);
#pragma unroll
            for (int d = 0; d < 4; ++d) { const float v = dv[d] * rs * gsub[d] * O8_SCALE; const float vn = __shfl_xor(v, 1);
                const unsigned h2 = (unsigned)__builtin_amdgcn_cvt_pk_fp8_f32(v, vn, 0, false) & 0xffffu; const unsigned hn = (unsigned)__shfl_xor((int)h2, 2);
                if ((r32 & 3) == 0) *(unsigned*)(Oout + (size_t)srow * 2048 + d * 32 + r32) = h2 | (hn << 16); } }
    } else {
#pragma unroll
        for (int r = 0; r < 16; ++r) { const int srow = qlo + crow(r, hi);
#pragma unroll
            for (int d = 0; d < 4; ++d) { const float v = o[d][r] * rli[r] * O8_SCALE; const float vn = __shfl_xor(v, 1);
                const unsigned h2 = (unsigned)__builtin_amdgcn_cvt_pk_fp8_f32(v, vn, 0, false) & 0xffffu; const unsigned hn = (unsigned)__shfl_xor((int)h2, 2);
                if ((r32 & 3) == 0) *(unsigned*)(Oout + (size_t)srow * 2048 + d * 32 + r32) = h2 | (hn << 16); } }
    }
    __syncthreads();
}
}

__device__ __forceinline__ void phase_attention(const Ctx& C, ArgsK* A, int l) {
    unsigned char* ws = C.ws; const bf16_t* P = (const bf16_t*)(ws + WS_P); const bf16_t* Qm = (const bf16_t*)(ws + WS_QM); const bf16_t* Kf = (const bf16_t*)(ws + WS_KF);
    const bf16_t* Vm = (const bf16_t*)(ws + WS_VM); unsigned char* O = (unsigned char*)(ws + WS_O); float* O1 = (float*)(ws + WS_O1);
    const float* cosT = (const float*)(ws + WS_COS); const float* sinT = (const float*)(ws + WS_SIN); const float* kmean = (const float*)(ws + WS_KMEAN);
    constexpr float LOG2E = 1.4426950408889634f;
    float d1 = 0.f, d2 = 0.f;
    for (int i = 0; i < 64; ++i) { d1 += gptr(A->in[3])[l * 64 + i] * gptr(A->in[4])[l * 64 + i]; d2 += gptr(A->in[5])[l * 64 + i] * gptr(A->in[6])[l * 64 + i]; }
    const float lam_init = 0.8f - 0.6f * expf(-0.3f * (float)l);
    const float lam = expf(d1) - expf(d2) + lam_init;
    {   const int NC = (C.G % 8 == 0 && C.G > CVT_NC) ? CVT_NC : C.G;
        if (C.bid < NC) { Ctx C2 = C; C2.G = NC; phase_convert_moe(C2, A, l); __syncthreads(); } }
    const int nq = (C.G % 8 == 0) ? 8 : 1, qx = C.bid % nq, bpq = 8 / nq, nun = 128 * bpq;
    unsigned* qc = (unsigned*)(ws + WS_CTL) + CW_AQ + l * 8 + qx;
    LAS int* slot = (LAS int*)(C.lds + 90112);
    if (C.tid == 0) *slot = (int)atomicAdd(qc, 1u);
    __syncthreads();
    int cur = __builtin_amdgcn_readfirstlane(*slot);
#pragma nounroll
    while (cur < nun) {
        int nxt = 0; if (C.tid == 0) nxt = (int)atomicAdd(qc, 1u);
        const int per = 16 * bpq, lvl = cur / per, r = cur - lvl * per, b = (r >> 4) * nq + qx, w = r & 15, qb = 7 - lvl, trow0 = b * SEQ;
        if (w < 8) { const int h = w;
            at::attn_unit<192, 0, 1, 2>(C.lds, Qm + (size_t)trow0 * 1536 + h * 192, 1536, Kf + (size_t)trow0 * 1536 + h * 192, 1536, Vm + (size_t)trow0 * 1024 + h * 128, 1024, trow0, qb, cosT, sinT,
                                        0.07216878364870322f * LOG2E, nullptr, nullptr, O + (size_t)trow0 * 2048 + 512 + h * 128, 0.f, 0.f, nullptr);
        } else if (w < 12) { const int h = w - 8;
            const bf16_t* Vp = P + (size_t)trow0 * PC + C_DV + h * 128;
            float* o1 = O1 + ((size_t)trow0 * 4 + h) * 128;
            at::attn_unit<64, 0, 0, 0>(C.lds, P + (size_t)trow0 * PC + C_DQ + h * 128, PC, P + (size_t)trow0 * PC + C_DK + h * 128, PC, Vp, PC, trow0, qb, cosT, sinT, 0.125f * LOG2E, nullptr,
                                       o1, nullptr, 0.f, 0.f, nullptr);
            at::attn_unit<64, 0, 0, 1>(C.lds, P + (size_t)trow0 * PC + C_DQ + h * 128 + 64, PC, P + (size_t)trow0 * PC + C_DK + h * 128 + 64, PC, Vp, PC, trow0, qb, cosT, sinT, 0.125f * LOG2E, nullptr,
                                       o1, O + (size_t)trow0 * 2048 + h * 128, lam, 1.f - lam_init, gptr(A->in[7]) + l * 128);
        } else { const int h = w - 12;
            at::attn_unit<128, 1, 2, 2>(C.lds, P + (size_t)trow0 * PC + C_MQ + h * 128, PC, P + (size_t)trow0 * PC + C_MK + h * 128, PC, P + (size_t)trow0 * PC + C_MV + h * 128, PC, trow0, qb, cosT, sinT,
                                        0.08838834764831845f * LOG2E, kmean + (size_t)(b * 4 + h) * 8 * 128, nullptr, O + (size_t)trow0 * 2048 + 1536 + h * 128, 0.f, 0.f, nullptr);
        }
        if (C.tid == 0) *slot = nxt;
        __syncthreads();
        cur = __builtin_amdgcn_readfirstlane(*slot);
    }
}

__device__ __forceinline__ void ln_row(f32x4 (&v)[4][2], const float* g, const float* bb, float* of, bf16_t* ob, unsigned char* oq, int lane) {
    float s = 0.f;
#pragma unroll
    for (int j = 0; j < 4; ++j)
#pragma unroll
        for (int h = 0; h < 2; ++h) s += (v[j][h][0] + v[j][h][1]) + (v[j][h][2] + v[j][h][3]);
    const float mean = wave_sum(s) * (1.f / DM); float s2 = 0.f;
#pragma unroll
    for (int j = 0; j < 4; ++j)
#pragma unroll
        for (int h = 0; h < 2; ++h) { const f32x4 d = v[j][h] - mean; s2 += (d[0] * d[0] + d[1] * d[1]) + (d[2] * d[2] + d[3] * d[3]); }
    const float rstd = rsqrtf(wave_sum(s2) * (1.f / DM) + NORM_EPS);
#pragma unroll
    for (int j = 0; j < 4; ++j) { const int c = (lane + 64 * j) * 8; f32x4 y[2];
#pragma unroll
        for (int h = 0; h < 2; ++h) { const f32x4 gg = *(const f32x4*)(g + c + 4 * h), b4 = *(const f32x4*)(bb + c + 4 * h); y[h] = (v[j][h] - mean) * rstd * gg + b4; }
        if (of) { *(f32x4*)(of + c) = y[0]; *(f32x4*)(of + c + 4) = y[1]; }
        if (ob) *(u32x4*)(ob + c) = pk8(y[0], y[1]);
        if (oq) { u32x2 q; q.x = pk4_fp8(y[0][0], y[0][1], y[0][2], y[0][3]); q.y = pk4_fp8(y[1][0], y[1][1], y[1][2], y[1][3]); *(u32x2*)(oq + c) = q; } }
}
__device__ __forceinline__ void ld_bf16x8(f32x4 (&d)[2], const bf16_t* p, float sc) { const u32x4 w = *(const u32x4*)p;
    d[0] = (f32x4){bflo(w.x), bfhi(w.x), bflo(w.y), bfhi(w.y)} * sc; d[1] = (f32x4){bflo(w.z), bfhi(w.z), bflo(w.w), bfhi(w.w)} * sc; }
__device__ __forceinline__ void phase_ln_mix(const Ctx& C, ArgsK* A, int l) {
    const bf16_t* Z = (const bf16_t*)(C.ws + WS_X1F); bf16_t* XB1 = (bf16_t*)(C.ws + WS_X1B);
    const float* g = gptr(A->in[14]) + l * DM; const float* bb = gptr(A->in[15]) + l * DM;
    for (int row0 = (C.bid * NWAVES + C.wave) * 4; row0 < T; row0 += C.G * NWAVES * 4) { f32x4 v[4][4][2];
#pragma unroll
        for (int u = 0; u < 4; ++u)
#pragma unroll
            for (int j = 0; j < 4; ++j) ld_bf16x8(v[u][j], Z + (size_t)(row0 + u) * DM + (C.lane + 64 * j) * 8, 1.f);
#pragma unroll
        for (int u = 0; u < 4; ++u) ln_row(v[u], g, bb, nullptr, XB1 + (size_t)(row0 + u) * DM, (unsigned char*)(C.ws + WS_X1Q) + (size_t)(row0 + u) * DM, C.lane); }
}

__device__ __forceinline__ void phase_route(const Ctx& C, ArgsK* A, int l) {
    unsigned char* ws = C.ws; const float* bias = gptr(A->in[17]) + l * NEXP;
    const float* logits = (const float*)(ws + WS_O1);
    int* ridx = (int*)(ws + WS_RIDX); float* rw = (float*)(ws + WS_RW); int* rpos = (int*)(ws + WS_RPOS); int* bbase = (int*)(ws + WS_BBASE);
    unsigned* ecnt = (unsigned*)(ws + WS_CTL) + CW_ECNT + l * 64;
    LAS int* hist = (LAS int*)C.lds;
    const int lane = C.lane;
    for (int chunk = C.bid; chunk < T / 64; chunk += C.G) {
        __syncthreads();
        if (C.tid < 64) hist[C.tid] = 0;
        __syncthreads();
        const float bs = bias[lane]; const float NEGI = -__builtin_inff();
        LAS float* cb = (LAS float*)(C.lds + 1024 + 16384) + C.wave * 128;
        const int gme = lane >> 3;
#pragma nounroll
        for (int q = 0; q < 8; ++q) { const int t = chunk * 64 + C.wave * 8 + q;
            const float* lp = logits + (size_t)t * 64 + lane; const float sv = sigmoidf_((lp[0] + lp[(size_t)T * 64]) + (lp[(size_t)2 * T * 64] + lp[(size_t)3 * T * 64])); const float c = sv + bs;
            cb[lane] = c; asm volatile("s_waitcnt lgkmcnt(0)" ::: "memory");
            const f32x4 ga = *(const LAS f32x4*)(cb + gme * 8), gb = *(const LAS f32x4*)(cb + gme * 8 + 4);
            float m1 = ga[0], m2 = NEGI;
#define TOP2(x) do { const float x_ = (x); const bool gt1 = x_ > m1; m2 = gt1 ? m1 : (x_ > m2 ? x_ : m2); m1 = gt1 ? x_ : m1; } while (0)
            TOP2(ga[1]); TOP2(ga[2]); TOP2(ga[3]); TOP2(gb[0]); TOP2(gb[1]); TOP2(gb[2]); TOP2(gb[3]);
#undef TOP2
            if ((lane & 7) == 0) cb[64 + gme] = m1 + m2;
            asm volatile("s_waitcnt lgkmcnt(0)" ::: "memory");
            const f32x4 s0 = *(const LAS f32x4*)(cb + 64), s1 = *(const LAS f32x4*)(cb + 68);
            const float gsv[8] = {s0[0], s0[1], s0[2], s0[3], s1[0], s1[1], s1[2], s1[3]};
            unsigned keepm = 0u;
#pragma unroll
            for (int g = 0; g < 8; ++g) { int r = 0;
#pragma unroll
                for (int h = 0; h < 8; ++h) if (h != g) r += (gsv[h] > gsv[g] || (gsv[h] == gsv[g] && h < g)) ? 1 : 0;
                if (r < 4) keepm |= 1u << g; }
            const bool keep = (keepm >> gme) & 1u;
            unsigned ub = __float_as_uint(c); ub = (ub & 0x80000000u) ? ~ub : (ub | 0x80000000u);
            const unsigned key = keep ? ((ub & ~63u) | (unsigned)(63 - lane)) : 0u;
            LAS unsigned* kb = (LAS unsigned*)cb;
            asm volatile("s_waitcnt lgkmcnt(0)" ::: "memory");
            kb[lane] = key; asm volatile("s_waitcnt lgkmcnt(0)" ::: "memory");
            int rk = 0;
#pragma unroll
            for (int e4 = 0; e4 < 16; ++e4) { const u32x4 v = *(const LAS u32x4*)(kb + e4 * 4);
                rk += (v[0] > key ? 1 : 0) + (v[1] > key ? 1 : 0) + (v[2] > key ? 1 : 0) + (v[3] > key ? 1 : 0); }
            const bool sel = keep && rk < 8;
            const float wsum = wave_sum(sel ? sv : 0.f);
            if (sel) { const int lr = __hip_atomic_fetch_add(hist + lane, 1, __ATOMIC_RELAXED, __HIP_MEMORY_SCOPE_WORKGROUP); ridx[t * 8 + rk] = lane; rw[t * 8 + rk] = sv / wsum * 2.5f; rpos[t * 8 + rk] = lr; }
            asm volatile("s_waitcnt lgkmcnt(0)" ::: "memory");
        }
        __syncthreads();
        if (C.tid < 64) bbase[chunk * 64 + C.tid] = (int)atomicAdd(ecnt + C.tid, (unsigned)hist[C.tid]);
    }
}
template <bool WANT_SEG> __device__ __forceinline__ void build_moe_tables(const Ctx& C, int l, LAS int* segb  ) {
    const unsigned* ecnt = (const unsigned*)(C.ws + WS_CTL) + CW_ECNT + l * 64;
    LAS unsigned char* tab = C.lds + TAB_OFF; LAS int* tile_e = (LAS int*)(tab + TAB_TILEE); LAS int* misc = (LAS int*)(tab + TAB_MISC);
    __syncthreads();
    if (C.wave == 0) { const int e = C.lane; const int cnt = (int)__hip_atomic_load(ecnt + e, __ATOMIC_RELAXED, __HIP_MEMORY_SCOPE_AGENT); const int nt = (cnt + 255) >> 8;
        int incl = nt;
#pragma unroll
        for (int o = 1; o < 64; o <<= 1) { const int v = __shfl_up(incl, o); if (e >= o) incl += v; }
        const int base = incl - nt; const int nrt = __shfl(incl, 63);
        for (int i = 0; i < nt; ++i) tile_e[base + i] = e;
        tile_e[nrt + e] = NEXP;
        if constexpr (WANT_SEG) segb[e] = base * 256;
        if (e == 0) { misc[0] = nrt; misc[1] = nrt + 64; } }
    __syncthreads();
}
__device__ __forceinline__ void phase_scatter(const Ctx& C, int l) {
    unsigned char* ws = C.ws; const int* ridx = (const int*)(ws + WS_RIDX); const float* rw = (const float*)(ws + WS_RW); int* rpos = (int*)(ws + WS_RPOS); const int* bbase = (const int*)(ws + WS_BBASE);
    int* stok = (int*)(ws + WS_STOK); float* sw = (float*)(ws + WS_SW);
    const unsigned* ecnt = (const unsigned*)(ws + WS_CTL) + CW_ECNT + l * 64;
    LAS int* segb = (LAS int*)C.lds;
    build_moe_tables<true>(C, l, segb);
    for (int chunk = C.bid; chunk < T / 64; chunk += C.G) {
        const int t = chunk * 64 + (C.tid >> 3), k = C.tid & 7; const int e = ridx[t * 8 + k];
        const int pos = segb[e] + bbase[chunk * 64 + e] + rpos[t * 8 + k];
        rpos[t * 8 + k] = pos; stok[pos] = t; sw[pos] = rw[t * 8 + k];
    }
    for (int e = C.bid; e < NEXP; e += C.G) { const int cnt = (int)__hip_atomic_load(ecnt + e, __ATOMIC_RELAXED, __HIP_MEMORY_SCOPE_AGENT); const int endp = segb[e] + ((cnt + 255) & ~255);
        for (int p = segb[e] + cnt + C.tid; p < endp; p += NTHR) { stok[p] = 0; sw[p] = 0.f; } }
    __syncthreads();
}

__device__ __forceinline__ void phase_combine(const Ctx& C, ArgsK* A, int l) {
    unsigned char* ws = C.ws; const bf16_t* X1 = (const bf16_t*)(ws + WS_X1B); const unsigned char* YS = (const unsigned char*)(ws + WS_YS); const int* rpos = (const int*)(ws + WS_RPOS);
    float* OF = (l == 1) ? gptr(A->out) : nullptr; bf16_t* OB = (l == 1) ? nullptr : (bf16_t*)(ws + WS_XB);
    const float* g = gptr(A->in[24]) + l * DM; const float* bb = gptr(A->in[25]) + l * DM;
    for (int row0 = (C.bid * NWAVES + C.wave) * 2; row0 < T; row0 += C.G * NWAVES * 2) {
        int sr[2][9];
#pragma unroll
        for (int u = 0; u < 2; ++u) {
#pragma unroll
            for (int k = 0; k < 8; ++k) sr[u][k] = rpos[(row0 + u) * 8 + k];
            sr[u][8] = RT_ROWS + row0 + u; }
        f32x4 v[2][4][2]; u32x2 yw[2][9][4];
#pragma unroll
        for (int u = 0; u < 2; ++u)
#pragma unroll
            for (int k = 0; k < 9; ++k) { const unsigned char* yr = YS + (size_t)sr[u][k] * DM;
#pragma unroll
                for (int j = 0; j < 4; ++j) yw[u][k][j] = *(const u32x2*)(yr + (C.lane + 64 * j) * 8); }
#pragma unroll
        for (int u = 0; u < 2; ++u)
#pragma unroll
            for (int j = 0; j < 4; ++j) ld_bf16x8(v[u][j], X1 + (size_t)(row0 + u) * DM + (C.lane + 64 * j) * 8, DN_ALPHA);
#pragma unroll
        for (int u = 0; u < 2; ++u) {
#pragma unroll
            for (int j = 0; j < 4; ++j) { f32x4 a0 = {0.f, 0.f, 0.f, 0.f}, a1 = a0;
#pragma unroll
                for (int k = 0; k < 9; ++k) { float lo[4], hi[4]; fp8x4_to_f32(yw[u][k][j].x, lo); fp8x4_to_f32(yw[u][k][j].y, hi);
                    a0 += (f32x4){lo[0], lo[1], lo[2], lo[3]}; a1 += (f32x4){hi[0], hi[1], hi[2], hi[3]}; }
                v[u][j][0] += a0 * (1.f / YS8_SCALE); v[u][j][1] += a1 * (1.f / YS8_SCALE); }
            const int row = row0 + u;
            ln_row(v[u], g, bb, OF ? OF + (size_t)row * DM : nullptr, OB ? OB + (size_t)row * DM : nullptr, OB ? (unsigned char*)(ws + WS_XQ) + (size_t)row * DM : nullptr, C.lane); }
    }
}

template <unsigned MASK> __global__ void __launch_bounds__(NTHR, 2) mk_fwd(Args args) {
    extern __shared__ __attribute__((aligned(16))) unsigned char lds_raw[];
    Ctx C;
    C.lds = (LAS unsigned char*)lds_raw; C.tid = threadIdx.x; C.lane = C.tid & 63; C.wave = __builtin_amdgcn_readfirstlane(C.tid >> 6); C.G = gridDim.x; C.bid = blockIdx.x;
    C.ws = args.ws; C.out = args.out;
    volatile LAS unsigned* MISC = (volatile LAS unsigned*)(C.lds + MISC_OFF);
    if (C.tid < 32) MISC[C.tid] = 0u;
    __syncthreads();
    unsigned char* ws = args.ws; ArgsK* ap;
    unsigned* ctl = (unsigned*)(ws + WS_CTL);
#if MK_ONE_LAUNCH
    XcdBarrier bar = xcd_barrier_post(ctl + CW_BAR, MISC + 8);
#define GRID_BAR() xcd_barrier(bar)
#else
#define GRID_BAR() do { } while (0)
#endif
    const int lo = args.ph_lo, hi = args.ph_hi;
#if MK_ONE_LAUNCH
#define IN(k) true
#else
#define IN(k) (((MASK >> ((k) % NPH)) & 1u) && lo <= (k) && (k) < hi)
#endif
#if MK_ONE_LAUNCH
#define BOTH(k) true
#else
#define BOTH(k) (IN(k) && IN((k) + 1))
#endif
#define OPAQUE_WS() do { ap = (ArgsK*)__builtin_amdgcn_kernarg_segment_ptr(); asm volatile("" : "+s"(ap)); ws = gptr(ap->ws); } while (0)
    for (int l = 0; l < 2; ++l) {
        OPAQUE_WS();
        const int pb = l * NPH;
        float* rsq_q = (float*)(ws + WS_RSQQ); float* rsq_kv = (float*)(ws + WS_RSQKV);
        for (int rep_ = 0; rep_ < REPN(0); ++rep_) if constexpr ((MASK >> 0) & 1u) if (l == 0 && IN(pb + 0)) { OPAQUE_WS(); C.ws = ws; { int t_ = threadIdx.x; asm volatile("" : "+v"(t_)); C.tid = t_; C.lane = t_ & 63; C.wave = __builtin_amdgcn_readfirstlane(t_ >> 6); int b_ = blockIdx.x, g_ = gridDim.x; asm volatile("" : "+s"(b_), "+s"(g_)); C.bid = b_; C.G = g_; }     phase_convert(C, ap, l); if (BOTH(pb + 0)) GRID_BAR(); }
        for (int rep_ = 0; rep_ < REPN(1); ++rep_) if constexpr ((MASK >> 1) & 1u) if (IN(pb + 1)) { OPAQUE_WS(); C.ws = ws; { int t_ = threadIdx.x; asm volatile("" : "+v"(t_)); C.tid = t_; C.lane = t_ & 63; C.wave = __builtin_amdgcn_readfirstlane(t_ >> 6); int b_ = blockIdx.x, g_ = gridDim.x; asm volatile("" : "+s"(b_), "+s"(g_)); C.bid = b_; C.G = g_; }
            { DenseSched S; S.so.init(T, PC, C.G, C.bid); S.A = (const char*)(ws + WS_XQ); S.B = (const char*)(ws + (l ? MIXOFS1 : 0) + WS_WIN); S.lda = DM; S.ldb = DM; S.nt = DM / 128;
              EpiInProj E{(bf16_t*)(ws + WS_P), rsq_q, rsq_kv};
              gm::gemm_phase<EpiInProj, DenseSched, false, false, true>(C.lds, DM, DM, S, E); }
            if (BOTH(pb + 1)) GRID_BAR(); }
        for (int rep_ = 0; rep_ < REPN(2); ++rep_) if constexpr ((MASK >> 2) & 1u) if (IN(pb + 2)) { OPAQUE_WS(); C.ws = ws; { int t_ = threadIdx.x; asm volatile("" : "+v"(t_)); C.tid = t_; C.lane = t_ & 63; C.wave = __builtin_amdgcn_readfirstlane(t_ >> 6); int b_ = blockIdx.x, g_ = gridDim.x; asm volatile("" : "+s"(b_), "+s"(g_)); C.bid = b_; C.G = g_; }
            if (rep_ == 0) phase_krope(C);
            __syncthreads();
            UpSched S{(const char*)(ws + WS_P), (const char*)(ws + (l ? MIXOFS1 : 0) + WS_WUQ), (const char*)(ws + (l ? MIXOFS1 : 0) + WS_WUKV), C.G, C.bid};
            EpiUp E{(bf16_t*)(ws + WS_QM), (bf16_t*)(ws + WS_KF), (bf16_t*)(ws + WS_VM), rsq_q, rsq_kv};
            gm::gemm_phase<EpiUp, UpSched, false, false>(C.lds, PC * 2, 1024, S, E);
            if (BOTH(pb + 2)) GRID_BAR(); }
        for (int rep_ = 0; rep_ < REPN(3); ++rep_) if constexpr ((MASK >> 3) & 1u) if (IN(pb + 3)) { OPAQUE_WS(); C.ws = ws; { int t_ = threadIdx.x; asm volatile("" : "+v"(t_)); C.tid = t_; C.lane = t_ & 63; C.wave = __builtin_amdgcn_readfirstlane(t_ >> 6); int b_ = blockIdx.x, g_ = gridDim.x; asm volatile("" : "+s"(b_), "+s"(g_)); C.bid = b_; C.G = g_; }     phase_attention(C, ap, l); if (BOTH(pb + 3)) GRID_BAR(); }
        for (int rep_ = 0; rep_ < REPN(4); ++rep_) if constexpr ((MASK >> 4) & 1u) if (IN(pb + 4)) { OPAQUE_WS(); C.ws = ws; { int t_ = threadIdx.x; asm volatile("" : "+v"(t_)); C.tid = t_; C.lane = t_ & 63; C.wave = __builtin_amdgcn_readfirstlane(t_ >> 6); int b_ = blockIdx.x, g_ = gridDim.x; asm volatile("" : "+s"(b_), "+s"(g_)); C.bid = b_; C.G = g_; }
            BranchSched S; S.so.init(T, DM, C.G, C.bid); S.A = (const char*)(ws + WS_O); S.B = (const char*)(ws + (l ? MIXOFS1 : 0) + WS_WBR);
            EpiBranch E{(bf16_t*)(ws + WS_YB), (unsigned char*)(ws + WS_O) + 32 * MiB, (const bf16_t*)(ws + WS_P)};
            gm::gemm_phase<EpiBranch, BranchSched, false, false, true>(C.lds, DM, DM, S, E);
            if (BOTH(pb + 4)) GRID_BAR(); }
        for (int rep_ = 0; rep_ < REPN(5); ++rep_) if constexpr ((MASK >> 5) & 1u) if (IN(pb + 5)) { OPAQUE_WS(); C.ws = ws; { int t_ = threadIdx.x; asm volatile("" : "+v"(t_)); C.tid = t_; C.lane = t_ & 63; C.wave = __builtin_amdgcn_readfirstlane(t_ >> 6); int b_ = blockIdx.x, g_ = gridDim.x; asm volatile("" : "+s"(b_), "+s"(g_)); C.bid = b_; C.G = g_; }
            DenseSched S; S.so.init(T, DM, C.G, C.bid); S.A = (const char*)(ws + WS_O) + 32 * MiB; S.B = (const char*)(ws + (l ? MIXOFS1 : 0) + WS_WOUT); S.lda = DM; S.ldb = DM; S.nt = DM / 128;
            EpiOut E{(bf16_t*)(ws + WS_X1F), (const bf16_t*)(ws + WS_XB)};
            gm::gemm_phase<EpiOut, DenseSched, false, true, true>(C.lds, DM, DM, S, E);
            if (BOTH(pb + 5)) GRID_BAR(); }
        for (int rep_ = 0; rep_ < REPN(6); ++rep_) if constexpr ((MASK >> 6) & 1u) if (IN(pb + 6)) { OPAQUE_WS(); C.ws = ws; { int t_ = threadIdx.x; asm volatile("" : "+v"(t_)); C.tid = t_; C.lane = t_ & 63; C.wave = __builtin_amdgcn_readfirstlane(t_ >> 6); int b_ = blockIdx.x, g_ = gridDim.x; asm volatile("" : "+s"(b_), "+s"(g_)); C.bid = b_; C.G = g_; }     phase_ln_mix(C, ap, l); if (BOTH(pb + 6)) GRID_BAR(); }
        for (int rep_ = 0; rep_ < REPN(7); ++rep_) if constexpr ((MASK >> 7) & 1u) if (IN(pb + 7)) { OPAQUE_WS(); C.ws = ws; { int t_ = threadIdx.x; asm volatile("" : "+v"(t_)); C.tid = t_; C.lane = t_ & 63; C.wave = __builtin_amdgcn_readfirstlane(t_ >> 6); int b_ = blockIdx.x, g_ = gridDim.x; asm volatile("" : "+s"(b_), "+s"(g_)); C.bid = b_; C.G = g_; }
            RouterSched S{(const char*)(ws + WS_X1B), (const char*)(ws + (l ? MIXOFS1 : 0) + WS_WR), C.G, C.bid};
            EpiLogit E{(float*)(ws + WS_O1)};
            gm::gemm_phase<EpiLogit, RouterSched, false, false>(C.lds, DM * 2, DM * 2, S, E);
            if (BOTH(pb + 7)) GRID_BAR(); }
        for (int rep_ = 0; rep_ < REPN(8); ++rep_) if constexpr ((MASK >> 8) & 1u) if (IN(pb + 8)) { OPAQUE_WS(); C.ws = ws; { int t_ = threadIdx.x; asm volatile("" : "+v"(t_)); C.tid = t_; C.lane = t_ & 63; C.wave = __builtin_amdgcn_readfirstlane(t_ >> 6); int b_ = blockIdx.x, g_ = gridDim.x; asm volatile("" : "+s"(b_), "+s"(g_)); C.bid = b_; C.G = g_; }     phase_route(C, ap, l); if (BOTH(pb + 8)) GRID_BAR(); }
        for (int rep_ = 0; rep_ < REPN(9); ++rep_) if constexpr ((MASK >> 9) & 1u) if (IN(pb + 9)) { OPAQUE_WS(); C.ws = ws; { int t_ = threadIdx.x; asm volatile("" : "+v"(t_)); C.tid = t_; C.lane = t_ & 63; C.wave = __builtin_amdgcn_readfirstlane(t_ >> 6); int b_ = blockIdx.x, g_ = gridDim.x; asm volatile("" : "+s"(b_), "+s"(g_)); C.bid = b_; C.G = g_; }     phase_scatter(C, l); if (BOTH(pb + 9)) GRID_BAR(); }
        for (int rep_ = 0; rep_ < REPN(10); ++rep_) if constexpr ((MASK >> 10) & 1u) if (IN(pb + 10)) { OPAQUE_WS(); C.ws = ws; { int t_ = threadIdx.x; asm volatile("" : "+v"(t_)); C.tid = t_; C.lane = t_ & 63; C.wave = __builtin_amdgcn_readfirstlane(t_ >> 6); int b_ = blockIdx.x, g_ = gridDim.x; asm volatile("" : "+s"(b_), "+s"(g_)); C.bid = b_; C.G = g_; }
            build_moe_tables<false>(C, l, (LAS int*)C.lds);
            LAS unsigned char* tab = C.lds + TAB_OFF;
            {
                const LAS int* misc = (const LAS int*)(tab + TAB_MISC); const int nrt = misc[0], ntl = misc[1]; const int* stok = (const int*)(ws + WS_STOK);
                LAS unsigned* idx = (LAS unsigned*)(tab + TAB_IDX);
#pragma nounroll
                for (int i = 0; i < 10; ++i) { const int L = xcd_chunk_unit(i, C.bid, C.G, ntl * 4); if (L < 0) break; const int tile = L >> 2;
                    if (C.tid < 256) { idx[i * 256 + C.tid] = tile < nrt ? (unsigned)stok[tile * 256 + C.tid] : (unsigned)((tile - nrt) * 256 + C.tid);
                        ((LAS float*)(tab + TAB_SW))[i * 256 + C.tid] = tile < nrt ? ((const float*)(ws + WS_SW))[tile * 256 + C.tid] : 1.f; } }
                __syncthreads();
            }
            Moe1Sched S1{tab, (const char*)(ws + WS_X1Q), (const char*)(ws + WS_W13), C.G, C.bid};
            EpiMoe1 E1{(unsigned char*)(ws + WS_HID), (const LAS float*)(tab + TAB_SW)};
            gm::gemm_phase<EpiMoe1, Moe1Sched, true, false, true>(C.lds, DM, DM, S1, E1);
#if MK_ONE_LAUNCH
            GRID_BAR();
#endif
        }
        if constexpr (((MASK >> 10) & 1u) && MK_ONE_LAUNCH) if (IN(pb + 10)) { OPAQUE_WS(); C.ws = ws; { int t_ = threadIdx.x; asm volatile("" : "+v"(t_)); C.tid = t_; C.lane = t_ & 63; C.wave = __builtin_amdgcn_readfirstlane(t_ >> 6); int b_ = blockIdx.x, g_ = gridDim.x; asm volatile("" : "+s"(b_), "+s"(g_)); C.bid = b_; C.G = g_; }
            LAS unsigned char* tab = C.lds + TAB_OFF;
            Moe2Sched S2{tab, (const char*)(ws + WS_HID), (const char*)(ws + WS_W2), C.G, C.bid};
            EpiMoe2 E2{(unsigned char*)(ws + WS_YS)};
            for (int rep_ = 0; rep_ < REPN(11); ++rep_) { gm::gemm_phase<EpiMoe2, Moe2Sched, false, false, true>(C.lds, FF, FF, S2, E2);
            GRID_BAR(); }
            for (int rep_ = 0; rep_ < REPN(12); ++rep_) { phase_combine(C, ap, l);
            if (l == 0 || rep_ + 1 < REPN(12)) GRID_BAR(); }
        }
    }
#undef IN
#undef BOTH
}

#if !MK_ONE_LAUNCH
__global__ void __launch_bounds__(NTHR, 2) mk_moe2(Args args, int l) {
    extern __shared__ __attribute__((aligned(16))) unsigned char lds_raw[];
    Ctx C; C.lds = (LAS unsigned char*)lds_raw; C.tid = threadIdx.x; C.lane = C.tid & 63; C.wave = __builtin_amdgcn_readfirstlane(C.tid >> 6); C.G = gridDim.x; C.bid = blockIdx.x; C.ws = args.ws; C.out = args.out;
    build_moe_tables<false>(C, l, (LAS int*)C.lds);
    LAS unsigned char* tab = C.lds + TAB_OFF; unsigned char* ws = args.ws;
    Moe2Sched S2{tab, (const char*)(ws + WS_HID), (const char*)(ws + WS_W2), C.G, C.bid};
    EpiMoe2 E2{(unsigned char*)(ws + WS_YS)};
    gm::gemm_phase<EpiMoe2, Moe2Sched, false, false, true>(C.lds, FF, FF, S2, E2);
}
__global__ void __launch_bounds__(NTHR, 2) mk_combine(Args args, int l) {
    extern __shared__ __attribute__((aligned(16))) unsigned char lds_raw[];
    Ctx C; C.lds = (LAS unsigned char*)lds_raw; C.tid = threadIdx.x; C.lane = C.tid & 63; C.wave = __builtin_amdgcn_readfirstlane(C.tid >> 6); C.G = gridDim.x; C.bid = blockIdx.x; C.ws = args.ws; C.out = args.out;
    phase_combine(C, (ArgsK*)__builtin_amdgcn_kernarg_segment_ptr(), l);
}
#endif


#ifdef DBG_STOP
__global__ void dbg_gather(const unsigned short* H, const unsigned short* YS, const int* rpos, float* out, int mode) {
    const size_t n = (size_t)T * DM;
    for (size_t i = (size_t)blockIdx.x * blockDim.x + threadIdx.x; i < n; i += (size_t)gridDim.x * blockDim.x) {
        if (mode == 9) { const size_t q = i % 131072; const int p = rpos[q]; const int* stok = (const int*)H; const float* sw = (const float*)YS; const bool oor = (p < 0 || p >= 147456);
#if DBG_SUB == 0
            out[i] = oor ? 1.f : 0.f;
#elif DBG_SUB == 1
            out[i] = oor ? 0.f : (stok[p] != (int)(q / 8) ? 1.f : 0.f);
#else
            out[i] = oor ? 0.f : sw[p];
#endif
            }
        else if (mode == 10) { const size_t t = i / 4096, k = (i / 512) % 8, c = i % 512; out[i] = __uint_as_float(((unsigned)H[(size_t)rpos[t * 8 + k] * 512 + c]) << 16); }
        else { const size_t t = i / 2048, c = i % 2048; float s = 0.f; for (int k = 0; k < 8; ++k) s += __uint_as_float(((unsigned)YS[(size_t)rpos[t * 8 + k] * 2048 + c]) << 16); out[i] = s; }
    }
}
__global__ void dbg_copy(const void* src, int is_f32, float* out, size_t n, size_t nsrc) {
    for (size_t i = (size_t)blockIdx.x * blockDim.x + threadIdx.x; i < n; i += (size_t)gridDim.x * blockDim.x) {
        const size_t j = i % nsrc; out[i] = is_f32 ? ((const float*)src)[j] : __uint_as_float(((unsigned)((const unsigned short*)src)[j]) << 16); }
}
#endif
#if MK_ONE_LAUNCH
static hipError_t set_attr_all() { return hipFuncSetAttribute((const void*)mk_fwd<0x7ffu>, hipFuncAttributeMaxDynamicSharedMemorySize, LDS_BYTES); }
#else
template <unsigned M> static hipError_t set_attr_one() { return hipFuncSetAttribute((const void*)mk_fwd<M>, hipFuncAttributeMaxDynamicSharedMemorySize, LDS_BYTES); }
static hipError_t set_attr_all() { hipError_t e = hipSuccess, r;
    r = set_attr_one<1u>(); if (r != hipSuccess) e = r; r = set_attr_one<2u>(); if (r != hipSuccess) e = r; r = set_attr_one<4u>(); if (r != hipSuccess) e = r; r = set_attr_one<8u>(); if (r != hipSuccess) e = r;
    r = set_attr_one<16u>(); if (r != hipSuccess) e = r; r = set_attr_one<32u>(); if (r != hipSuccess) e = r; r = set_attr_one<64u>(); if (r != hipSuccess) e = r; r = set_attr_one<128u>(); if (r != hipSuccess) e = r;
    r = set_attr_one<256u>(); if (r != hipSuccess) e = r; r = set_attr_one<512u>(); if (r != hipSuccess) e = r; r = set_attr_one<1024u>(); if (r != hipSuccess) e = r; return e; }
static void launch_phase(int k, int grid, hipStream_t stream, const Args& a) {
    switch (k) {
    case 0: hipLaunchKernelGGL(mk_fwd<1u>, dim3(grid), dim3(NTHR), LDS_BYTES, stream, a); break;
    case 1: hipLaunchKernelGGL(mk_fwd<2u>, dim3(grid), dim3(NTHR), LDS_BYTES, stream, a); break;
    case 2: hipLaunchKernelGGL(mk_fwd<4u>, dim3(grid), dim3(NTHR), LDS_BYTES, stream, a); break;
    case 3: hipLaunchKernelGGL(mk_fwd<8u>, dim3(grid), dim3(NTHR), LDS_BYTES, stream, a); break;
    case 4: hipLaunchKernelGGL(mk_fwd<16u>, dim3(grid), dim3(NTHR), LDS_BYTES, stream, a); break;
    case 5: hipLaunchKernelGGL(mk_fwd<32u>, dim3(grid), dim3(NTHR), LDS_BYTES, stream, a); break;
    case 6: hipLaunchKernelGGL(mk_fwd<64u>, dim3(grid), dim3(NTHR), LDS_BYTES, stream, a); break;
    case 7: hipLaunchKernelGGL(mk_fwd<128u>, dim3(grid), dim3(NTHR), LDS_BYTES, stream, a); break;
    case 8: hipLaunchKernelGGL(mk_fwd<256u>, dim3(grid), dim3(NTHR), LDS_BYTES, stream, a); break;
    case 9: hipLaunchKernelGGL(mk_fwd<512u>, dim3(grid), dim3(NTHR), LDS_BYTES, stream, a); break;
    default: hipLaunchKernelGGL(mk_fwd<1024u>, dim3(grid), dim3(NTHR), LDS_BYTES, stream, a); break;
    }
}
#endif

extern "C" void kernel_launch(void* const* d_in, const int* in_sizes, int n_in, void* d_out, int out_size, void* d_ws, size_t ws_size, hipStream_t stream) {
    static int grid = 0;
    if (grid == 0) {
        if (n_in != 26 || out_size != T * DM || ws_size < WS_END) { fprintf(stderr, "kernel_launch: unexpected shapes (n_in %d out %d ws %zu need %zu)\n", n_in, out_size, ws_size, (size_t)WS_END); grid = -1; return; }
        int dev = 0, cus = 0;
        if (hipGetDevice(&dev) != hipSuccess || hipDeviceGetAttribute(&cus, hipDeviceAttributeMultiprocessorCount, dev) != hipSuccess) { grid = -1; return; }
        if (set_attr_all() != hipSuccess) { fprintf(stderr, "kernel_launch: hipFuncSetAttribute failed\n"); grid = -1; return; }
#if !MK_ONE_LAUNCH
        (void)hipFuncSetAttribute((const void*)mk_moe2, hipFuncAttributeMaxDynamicSharedMemorySize, LDS_BYTES);
        (void)hipFuncSetAttribute((const void*)mk_combine, hipFuncAttributeMaxDynamicSharedMemorySize, LDS_BYTES);
#endif
        int per_cu = 0;
        if (hipOccupancyMaxActiveBlocksPerMultiprocessor(&per_cu, (const void*)mk_fwd<MK_ONE_LAUNCH ? 0x7ffu : 0x2u>, NTHR, LDS_BYTES) != hipSuccess || per_cu < 1) fprintf(stderr, "kernel_launch: occupancy query says %d\n", per_cu);
        (void)hipGetLastError();
        grid = cus > 256 ? 256 : cus;
    }
    if (grid < 0) return;
    (void)hipMemsetAsync((char*)d_ws + WS_CTL, 0, CTL_ZERO_BYTES, stream);
    Args a{};
    for (int i = 0; i < 26; ++i) a.in[i] = (const float*)d_in[i];
    a.out = (float*)d_out; a.ws = (unsigned char*)d_ws;
    for (int j = 0; j < 8; ++j) a.invf[j] = (float)pow(500000.0, -(double)(2 * j) / 16.0);
    for (int j = 0; j < 32; ++j) a.invf[8 + j] = (float)pow(500000.0, -(double)(2 * j) / 64.0);
    for (int j = 0; j < 16; ++j) a.invf[40 + j] = (float)pow(500000.0, -(double)(2 * j) / 32.0);
#if MK_ONE_LAUNCH
    a.ph_lo = 0; a.ph_hi = 2 * NPH;
    hipLaunchKernelGGL(mk_fwd<0x7ffu>, dim3(grid), dim3(NTHR), LDS_BYTES, stream, a);
#else
#ifdef DBG_STOP
    {
        const int l = 0;
        for (int k = 0; k < NPH && k <= DBG_STOP; ++k) { a.ph_lo = l * NPH + k; a.ph_hi = a.ph_lo + 1; launch_phase(k, grid, stream, a); }
        if (DBG_STOP >= 11) hipLaunchKernelGGL(mk_moe2, dim3(grid), dim3(NTHR), LDS_BYTES, stream, a, l);
        if (DBG_STOP >= 12) hipLaunchKernelGGL(mk_combine, dim3(grid), dim3(NTHR), LDS_BYTES, stream, a, l);
        const size_t n = (size_t)T * DM; unsigned char* w = (unsigned char*)d_ws;
        const void* src; int f32 = 0; size_t nsrc = n;
        switch (DBG_STOP) {
        case 0: src = w + WS_WIN; nsrc = (size_t)10240 * 2048; break;
        case 1: src = w + WS_P; break;
        case 2: src = w + WS_QM; nsrc = (size_t)T * (1536 + 1536 + 1024); break;
        case 3: src = w + WS_O; break;
        case 4: src = w + WS_YB; break;
        case 5: src = w + WS_X1F; f32 = 1; break;
        case 6: src = w + WS_X1B; break;
        case 7: src = w + WS_LOGIT; f32 = 1; nsrc = (size_t)T * 64; break;
        case 8: src = w + WS_RW; f32 = 1; nsrc = (size_t)T * 8; break;
        default: src = w + WS_X2F; f32 = 1; break;
        }
        if (DBG_STOP == 9) hipLaunchKernelGGL(dbg_gather, dim3(1024), dim3(256), 0, stream, (const unsigned short*)(w + WS_STOK), (const unsigned short*)(w + WS_SW), (const int*)(w + WS_RPOS), (float*)d_out, 9);
        else if (DBG_STOP == 10 || DBG_STOP == 11) hipLaunchKernelGGL(dbg_gather, dim3(1024), dim3(256), 0, stream, (const unsigned short*)(w + WS_HID), (const unsigned short*)(w + WS_YS), (const int*)(w + WS_RPOS), (float*)d_out, (int)DBG_STOP);
        else hipLaunchKernelGGL(dbg_copy, dim3(1024), dim3(256), 0, stream, src, f32, (float*)d_out, n, nsrc);
    }
#else
    for (int l = 0; l < 2; ++l) {
        for (int k = 0; k < NPH; ++k) { a.ph_lo = l * NPH + k; a.ph_hi = a.ph_lo + 1; launch_phase(k, grid, stream, a); }
        hipLaunchKernelGGL(mk_moe2, dim3(grid), dim3(NTHR), LDS_BYTES, stream, a, l);
        hipLaunchKernelGGL(mk_combine, dim3(grid), dim3(NTHR), LDS_BYTES, stream, a, l);
    }
#endif
#endif
}
```

```cpp
#include <hip/hip_runtime.h>
#include <cstdio>
#include <cstdint>
#include <cmath>

#ifndef REP_MASK
#define REP_MASK 0
#endif
#define REPN(k) (((REP_MASK >> (k)) & 1) ? 2 : 1)
#ifndef MK_ONE_LAUNCH
#define MK_ONE_LAUNCH 1
#endif

#define LAS __attribute__((address_space(3)))
#define GAS __attribute__((address_space(1)))
typedef unsigned short bf16_t;
typedef short bf16x8 __attribute__((ext_vector_type(8)));
typedef short s16x4 __attribute__((ext_vector_type(4)));
typedef float f32x4 __attribute__((ext_vector_type(4)));
typedef float f32x2 __attribute__((ext_vector_type(2)));
typedef float f32x16 __attribute__((ext_vector_type(16)));
typedef unsigned u32x4 __attribute__((ext_vector_type(4)));
typedef unsigned u32x2 __attribute__((ext_vector_type(2)));
typedef int v4i16_t __attribute__((ext_vector_type(2)));

constexpr int NB = 8, SEQ = 2048, T = NB * SEQ, DM = 2048;
constexpr int PC = 10240;
constexpr int C_DQ = 0, C_DK = 512, C_DV = 1024, C_CQ = 1536, C_CKV = 2048, C_MQ = 2304, C_MK = 2816, C_MV = 3328, C_G = 3840, C_KPE = 9984;
constexpr int IN_COLS = 10048;
constexpr int NEXP = 64, FF = 512;
constexpr int RT_ROWS = 147456;
constexpr int SR_ROWS = RT_ROWS + T;
constexpr int NRT = 56;
constexpr float NORM_EPS = 1e-5f;
constexpr float DN_ALPHA = 1.4142135623730951f;
constexpr int NPH = 11;

constexpr size_t MiB = 1u << 20;
constexpr size_t WS_CTL = 0, CTL_ZERO_BYTES = 1 * MiB;
constexpr int CW_BAR = 4096;
constexpr int CW_AQ = 8448;
#ifndef CVT_NC
#define CVT_NC 80
#endif
constexpr int CW_ECNT = 8192;
constexpr size_t WS_RSQQ = 52 * MiB, WS_RSQKV = 53 * MiB;
constexpr size_t WS_COS = 1 * MiB, WS_SIN = 5 * MiB;
constexpr size_t WS_KMEAN = 9 * MiB;
constexpr size_t WS_LOGIT = 10 * MiB;
constexpr size_t WS_RIDX = 14 * MiB, WS_RW = 14 * MiB + 512 * 1024, WS_RPOS = 15 * MiB, WS_BBASE = 15 * MiB + 512 * 1024;
constexpr size_t WS_STOK = 16 * MiB, WS_SW = 17 * MiB;
constexpr size_t WS_O1 = 18 * MiB;
constexpr size_t WS_WIN = 64 * MiB, WS_WUQ = 104 * MiB, WS_WUKV = 106 * MiB, WS_WR = 108 * MiB, WS_WBR = 109 * MiB, WS_WOUT = 117 * MiB;
constexpr size_t WS_W13 = 125 * MiB, WS_W2 = 385 * MiB;
constexpr size_t WS_XB = 515 * MiB, WS_X1F = 579 * MiB, WS_X1B = 707 * MiB, WS_X2F = 771 * MiB, WS_HID = 899 * MiB;
constexpr size_t WS_BIG = 1059 * MiB;
constexpr size_t WS_P = WS_BIG, WS_QM = WS_P + 320 * MiB, WS_KF = WS_QM + 48 * MiB, WS_VM = WS_KF + 48 * MiB, WS_O = WS_VM + 32 * MiB, WS_YB = WS_O + 64 * MiB;
constexpr size_t WS_X1Q = WS_HID + 80 * MiB;
constexpr size_t WS_XQ = WS_X1Q + 32 * MiB;
constexpr size_t WS_WINQ = WS_WIN + 20 * MiB;
static_assert(WS_XQ + 32 * MiB <= WS_BIG, "ws map");
constexpr size_t WS_YS = WS_BIG;
constexpr size_t WS_MIXALT = WS_BIG + 640 * MiB;
constexpr size_t MIXOFS1 = WS_MIXALT - WS_WIN;
constexpr size_t WS_END = WS_MIXALT + 61 * MiB;
static_assert(WS_YB + 64 * MiB <= WS_MIXALT && WS_HID + (size_t)SR_ROWS * FF * 2 <= WS_BIG, "ws map");

constexpr int RING_BYTES = 131072;
constexpr int TAB_OFF = RING_BYTES;
constexpr int TAB_BYTES = 24576;
constexpr int MISC_OFF = TAB_OFF + TAB_BYTES;
constexpr int LDS_BYTES = 157696;
static_assert(MISC_OFF + 128 <= LDS_BYTES, "lds map");
constexpr int NWAVES = 8, NTHR = 512;

__device__ __forceinline__ unsigned cvt_pk_bf16(float lo, float hi) { unsigned r; asm volatile("v_cvt_pk_bf16_f32 %0, %1, %2" : "=v"(r) : "v"(lo), "v"(hi)); return r; }
__device__ __forceinline__ float bf2f(unsigned short b) { return __uint_as_float(((unsigned)b) << 16); }
__device__ __forceinline__ float bflo(unsigned w) { return __uint_as_float(w << 16); }
__device__ __forceinline__ float bfhi(unsigned w) { return __uint_as_float(w & 0xffff0000u); }
__device__ __forceinline__ bf16x8 pack8(f32x4 a, f32x4 b) { u32x4 w = {cvt_pk_bf16(a[0], a[1]), cvt_pk_bf16(a[2], a[3]), cvt_pk_bf16(b[0], b[1]), cvt_pk_bf16(b[2], b[3])}; return __builtin_bit_cast(bf16x8, w); }
typedef int v8i32 __attribute__((ext_vector_type(8)));
__device__ __forceinline__ unsigned pk4_fp8(float a, float b, float c, float d) { unsigned w = 0; w = __builtin_amdgcn_cvt_pk_fp8_f32(a, b, w, false); w = __builtin_amdgcn_cvt_pk_fp8_f32(c, d, w, true); return w; }
__device__ __forceinline__ float clamp8(float v) { return __builtin_amdgcn_fmed3f(v, -440.f, 440.f); }
constexpr float W8_SCALE = 64.f, H8_SCALE = 8.f, O8_SCALE = 16.f, Y8_SCALE = 8.f, YS8_SCALE = 16.f;
__device__ __forceinline__ void fp8x4_to_f32(unsigned w, float (&o)[4]) { const f32x2 a = __builtin_amdgcn_cvt_pk_f32_fp8((int)w, false), b = __builtin_amdgcn_cvt_pk_f32_fp8((int)w, true); o[0] = a[0]; o[1] = a[1]; o[2] = b[0]; o[3] = b[1]; }
__device__ __forceinline__ float wave_sum(float v) {
#pragma unroll
    for (int o = 1; o < 64; o <<= 1) v += __shfl_xor(v, o);
    return v;
}
__device__ __forceinline__ float sigmoidf_(float x) { return __builtin_amdgcn_rcpf(1.f + __builtin_amdgcn_exp2f(x * -1.4426950408889634f)); }

#define XB_TMO      128
#define XB_XCNT(j)  (256  + 64 * (j))
#define XB_XSUB(j)  (1280 + 64 * (j))
#define XB_XGEN(j)  (2304 + 64 * (j))
#define XB_TOP      3328
#define XB_TOPGEN   3392
#define XCD_BAR_WORDS 3456
#define XB_SPIN_CAP (1u << 20)
__device__ __forceinline__ unsigned xb_ld(unsigned* p)              { return __hip_atomic_load(p, __ATOMIC_RELAXED, __HIP_MEMORY_SCOPE_AGENT); }
__device__ __forceinline__ unsigned xb_add(unsigned* p, unsigned v) { return __hip_atomic_fetch_add(p, v, __ATOMIC_RELAXED, __HIP_MEMORY_SCOPE_AGENT); }
__device__ __forceinline__ unsigned xb_xcc_id() { return (unsigned)__builtin_amdgcn_s_getreg((3 << 11) | 20) & 0xFu; }
#define XB_SPIN(cond, bar) do { unsigned _sp = 0; while (cond) { __builtin_amdgcn_s_sleep(1); \
    if ((++_sp & 255u) == 0u) { if (xb_ld(&(bar)[XB_TMO])) break; if (_sp > XB_SPIN_CAP) { atomicAdd(&(bar)[XB_TMO], 1u); break; } } } } while (0)
struct XcdBarrier { unsigned* bar; unsigned x; volatile LAS unsigned* st; };
__device__ __forceinline__ XcdBarrier xcd_barrier_post(unsigned* bar, volatile LAS unsigned* st) {
    XcdBarrier b; b.bar = bar; b.x = xb_xcc_id(); b.st = st;
    if (threadIdx.x == 0) (void)xb_add(&bar[XB_XCNT(b.x)], 1u);
    return b;
}
__device__ __forceinline__ void xcd_barrier_complete(unsigned* bar, unsigned x, unsigned& nloc, unsigned& nx) {
    asm volatile("" : "+v"(x));
    const unsigned G = gridDim.x * gridDim.y * gridDim.z;
    unsigned sum, cnt, mine, sp = 0u;
    for (;;) {
        sum = 0u; cnt = 0u; mine = 0u;
#pragma unroll
        for (unsigned j = 0; j < 16; ++j) { const unsigned c = xb_ld(&bar[XB_XCNT(j)]); sum += c; cnt += (c > 0u) ? 1u : 0u; mine = (j == x) ? c : mine; }
        if (sum == G) break;
        __builtin_amdgcn_s_sleep(1);
        if ((++sp & 255u) == 0u) { if (xb_ld(&bar[XB_TMO])) break; if (sp > XB_SPIN_CAP) { atomicAdd(&bar[XB_TMO], 1u); break; } }
    }
    nloc = mine > 0u ? mine : 1u; nx = cnt > 0u ? cnt : 1u;
}
__device__ __forceinline__ void xcd_barrier(const XcdBarrier& b) {
    asm volatile("s_waitcnt vmcnt(0)" ::: "memory");
    __syncthreads();
    if (threadIdx.x == 0) {
        GAS unsigned* barg_ = (GAS unsigned*)b.bar; asm volatile("" : "+v"(barg_)); unsigned* bar = (unsigned*)barg_;
        __builtin_amdgcn_s_waitcnt(0);
        unsigned nloc = b.st[0], nx = b.st[1];
        if (nloc == 0u) { xcd_barrier_complete(bar, b.x, nloc, nx); b.st[0] = nloc; b.st[1] = nx; }
        const unsigned old = xb_add(&bar[XB_XSUB(b.x)], 1u);
        const unsigned gen = old / nloc;
        if (old + 1u == (gen + 1u) * nloc) {
            __builtin_amdgcn_fence(__ATOMIC_RELEASE, "agent");
            asm volatile("s_waitcnt vmcnt(0)" ::: "memory");
            const unsigned og = xb_add(&bar[XB_TOP], 1u);
            const unsigned tg = og / nx;
            if (og + 1u == (tg + 1u) * nx) xb_add(&bar[XB_TOPGEN], 1u);
            else XB_SPIN(xb_ld(&bar[XB_TOPGEN]) == tg, bar);
            __builtin_amdgcn_fence(__ATOMIC_ACQUIRE, "agent");
            xb_add(&bar[XB_XGEN(b.x)], 1u);
            asm volatile("s_waitcnt vmcnt(0)" ::: "memory");
        } else {
            XB_SPIN(xb_ld(&bar[XB_XGEN(b.x)]) == gen, bar);
            __builtin_amdgcn_fence(__ATOMIC_ACQUIRE, "agent");
            asm volatile("s_waitcnt vmcnt(0)" ::: "memory");
        }
    }
    __syncthreads();
}

namespace gm {
constexpr int BM = 256, BK = 64, HALF = 128, HTB = HALF * BK * 2, STAGE_BYTES = 8 * HTB, NXCD = 8, WGM = 8;
__device__ __forceinline__ int lds_byte(int r, int c) { const int st = (r >> 4) * 2 + (c >> 5), rr = r & 15, cc = c & 31, ob = rr * 64 + cc * 2; return st * 1024 + (ob ^ (((ob >> 9) & 1) << 5)); }
__device__ __forceinline__ void stage_rc(int b, int& R, int& C) { const int st = b / 1024, sb = b % 1024, swz = sb ^ (((sb >> 9) & 1) << 5); R = (st >> 1) * 16 + swz / 64; C = (st & 1) * 32 + (swz % 64) / 2; }
__device__ __forceinline__ int perm32(int rho) { const int n = rho >> 4, i = rho & 15; return 8 * (i >> 2) + 4 * n + (i & 3); }
struct Unit { int pm, pn; };
struct StaticOrder {
    int nM, nN, nwg, G, c;
    __device__ void init(int M, int N, int G_, int c_) { nM = M / BM; nN = N / BM; nwg = nM * nN; G = G_; c = c_; }
    __device__ bool next(int i, Unit& u) const {
        const long L = (long)i * G + c; if (L >= nwg) return false;
        int wgid = (int)L; { const int q = nwg / NXCD, r = nwg % NXCD, xcd = wgid % NXCD, off = wgid / NXCD; wgid = (xcd < r ? xcd * (q + 1) : r * (q + 1) + (xcd - r) * q) + off; }
        const int nig = WGM * nN, gid = wgid / nig, fm = gid * WGM, gsz = (nM - fm) < WGM ? (nM - fm) : WGM;
        u.pm = fm + ((wgid % nig) % gsz); u.pn = (wgid % nig) / gsz; return true;
    }
};
struct GUnit { const char* A; const char* B; int nt; int pm; int pn; int aux; int idx; };

template <class Epi, class Sched, bool GATHER, bool ALIGN_EPI, bool F8 = false>
__device__ __forceinline__ void gemm_phase(LAS unsigned char* lds, const unsigned lda, const unsigned ldb, const Sched& S, const Epi& E) {
    int tid_ = threadIdx.x; asm volatile("" : "+v"(tid_));
    const int tid = tid_, wid = __builtin_amdgcn_readfirstlane(tid >> 6), lane = tid & 63, wr = wid >> 2, wc = wid & 3, fr = lane & 15, fq = lane >> 4;
    unsigned voffA[2], voffB[2], colA[2]; int RA[2];
#pragma unroll
    for (int i = 0; i < 2; ++i) { int R, C; stage_rc(tid * 16 + i * 8192, R, C); const int Rb = (R & ~31) + perm32(R & 31);
        RA[i] = R; colA[i] = (unsigned)C * 2u; voffA[i] = (unsigned)R * lda + (unsigned)C * 2u; voffB[i] = (unsigned)(Epi::COL16 ? (16 * (Rb >> 3) + (Rb & 7)) : Rb) * ldb + (unsigned)C * 2u; }
    const size_t kstep = (size_t)(BK * 2);
    const size_t hA = GATHER ? 0 : (size_t)HALF * lda, hB = (size_t)(Epi::COL16 ? 8 : HALF) * ldb;
    const unsigned ldsw = (unsigned)wid * 1024u;
    const int aoff = lds_byte(wr * 64 + fr, fq * 8), boff = lds_byte(wc * 32 + fr, fq * 8);
    unsigned gcur[2][2];
#define GM_SA(b, h) (((b) * 2 + (h)) * HTB)
#define GM_SB(b, h) ((4 + (b) * 2 + (h)) * HTB)
#define GM_STAGE_B(bufoff, gbase) do { _Pragma("unroll") for (int _i = 0; _i < 2; ++_i) \
        __builtin_amdgcn_global_load_lds((const unsigned*)((const char*)(gbase) + voffB[_i]), (LAS unsigned*)(lds + (bufoff) + ldsw + _i * 8192), 16, 0, 0); } while (0)
#define GM_STAGE_A(bufoff, gbase, h, nx) do { _Pragma("unroll") for (int _i = 0; _i < 2; ++_i) { \
        unsigned _vo = GATHER ? gcur[h][_i] : voffA[_i]; if (GATHER && (nx) && has_next) _vo = S.rowoff(ui + 1, (h) * HALF + RA[_i]) * lda + colA[_i]; \
        __builtin_amdgcn_global_load_lds((const unsigned*)((const char*)(gbase) + (size_t)(h) * hA + _vo), (LAS unsigned*)(lds + (bufoff) + ldsw + _i * 8192), 16, 0, 0); } } while (0)
#define GM_LD8(p_) ({ const u32x4 lo_ = *(const LAS u32x4*)(p_), hi_ = *(const LAS u32x4*)((p_) + 1024); (v8i32){(int)lo_.x, (int)lo_.y, (int)lo_.z, (int)lo_.w, (int)hi_.x, (int)hi_.y, (int)hi_.z, (int)hi_.w}; })
#define GM_LDA(dst, b, h) do { if constexpr (F8) { _Pragma("unroll") for (int m = 0; m < 4; ++m) dst##8[m] = GM_LD8(lds + GM_SA(b, h) + aoff + m * 2048); } \
        else { _Pragma("unroll") for (int m = 0; m < 4; ++m) _Pragma("unroll") for (int k = 0; k < 2; ++k) dst[m][k] = *(const LAS bf16x8*)(lds + GM_SA(b, h) + aoff + m * 2048 + k * 1024); } } while (0)
#define GM_LDB(dst, b, h) do { if constexpr (F8) { _Pragma("unroll") for (int n = 0; n < 2; ++n) dst##8[n] = GM_LD8(lds + GM_SB(b, h) + boff + n * 2048); } \
        else { _Pragma("unroll") for (int n = 0; n < 2; ++n) _Pragma("unroll") for (int k = 0; k < 2; ++k) dst[n][k] = *(const LAS bf16x8*)(lds + GM_SB(b, h) + boff + n * 2048 + k * 1024); } } while (0)
#define GM_MMA(ai, bj, At, Bt) do { __builtin_amdgcn_s_setprio(1); _Pragma("unroll") for (int m = 0; m < 4; ++m) _Pragma("unroll") for (int n = 0; n < 2; ++n) { \
        if constexpr (F8) { asm volatile("v_mfma_scale_f32_16x16x128_f8f6f4 %0, %1, %2, %0, %3, %4 op_sel_hi:[0,0,0]" : "+v"(acc[ai][bj][m][n]) : "v"(Bt##8[n]), "v"(At##8[m]), "v"(sc_w), "v"(sc_one)); }   \
        else { _Pragma("unroll") for (int k = 0; k < 2; ++k) acc[ai][bj][m][n] = __builtin_amdgcn_mfma_f32_16x16x32_bf16(Bt[n][k], At[m][k], acc[ai][bj][m][n], 0, 0, 0); } } \
        __builtin_amdgcn_s_setprio(0); } while (0)
#define GM_WAIT_V(n) asm volatile("s_waitcnt vmcnt(" #n ")" ::: "memory")
#define GM_WAIT_L(n) asm volatile("s_waitcnt lgkmcnt(" #n ")" ::: "memory")
#define GM_BAR __builtin_amdgcn_s_barrier()
#define GM_SCHED __builtin_amdgcn_sched_barrier(0)
    GUnit cur, nxt; int ui = 0;
    if (!S.next(0, cur)) return;
    if constexpr (GATHER) {
#pragma unroll
        for (int h = 0; h < 2; ++h)
#pragma unroll
            for (int i = 0; i < 2; ++i) gcur[h][i] = S.rowoff(0, h * HALF + RA[i]) * lda + colA[i];
    }
    f32x4 acc[2][2][4][2];
#pragma unroll
    for (int a = 0; a < 2; ++a)
#pragma unroll
        for (int b = 0; b < 2; ++b)
#pragma unroll
            for (int m = 0; m < 4; ++m)
#pragma unroll
                for (int n = 0; n < 2; ++n) acc[a][b][m][n] = (f32x4){0.f, 0.f, 0.f, 0.f};
    int sc_one = 0x7f7f7f7f, sc_w = 0x01010101 * (127 - Epi::BSH); if constexpr (F8) { asm volatile("" : "+v"(sc_one)); asm volatile("" : "+v"(sc_w)); }
    bf16x8 At[4][2], B0[2][2], B1[2][2]; v8i32 At8[4], B08[2], B18[2];
    const char* cA = cur.A; const char* cB = cur.B;
    {
    const bool has_next = false;
    GM_STAGE_B(GM_SB(0, 0), cB); GM_STAGE_B(GM_SB(0, 1), cB + hB); GM_STAGE_A(GM_SA(0, 0), cA, 0, false); GM_STAGE_A(GM_SA(0, 1), cA, 1, false);
    if (wr == 1) GM_BAR;
    GM_WAIT_V(2); GM_BAR;
    GM_STAGE_B(GM_SB(1, 0), cB + kstep); GM_STAGE_A(GM_SA(1, 0), cA + kstep, 0, false); GM_STAGE_B(GM_SB(1, 1), cB + hB + kstep);
    GM_WAIT_V(6); GM_BAR;
    }
    for (;;) {
        const bool has_next = S.next(ui + 1, nxt);
        const char* nA = has_next ? nxt.A : cA; const char* nB = has_next ? nxt.B : cB;
        const int nt = cur.nt;
#pragma nounroll
        for (int t = 0; t < nt; t += 2) {
            const bool last = (t == nt - 2);
            const char* a1 = cA + (size_t)(t + 1) * kstep;
            const char* a2 = last ? nA : cA + (size_t)(t + 2) * kstep; const char* b2 = last ? nB : cB + (size_t)(t + 2) * kstep;
            const char* a3 = a2 + kstep; const char* b3 = b2 + kstep;
            GM_LDB(B0, 0, 0); GM_LDB(B1, 0, 1); GM_SCHED; GM_LDA(At, 0, 0); GM_STAGE_A(GM_SA(1, 1), a1, 1, false);
            GM_WAIT_V(8); GM_WAIT_L(0); GM_BAR; GM_MMA(0, 0, At, B0); GM_MMA(0, 1, At, B1); GM_BAR; GM_SCHED;
            GM_LDA(At, 0, 1); GM_STAGE_B(GM_SB(0, 0), b2); GM_STAGE_B(GM_SB(0, 1), b2 + hB); GM_STAGE_A(GM_SA(0, 0), a2, 0, last);
            GM_WAIT_V(8); GM_WAIT_L(0); GM_BAR; GM_MMA(1, 0, At, B0); GM_MMA(1, 1, At, B1); GM_BAR; GM_SCHED;
            GM_LDB(B0, 1, 0); GM_LDB(B1, 1, 1); GM_SCHED; GM_LDA(At, 1, 0); GM_STAGE_A(GM_SA(0, 1), a2, 1, last);
            GM_WAIT_V(8); GM_WAIT_L(0); GM_BAR; GM_MMA(0, 0, At, B0); GM_MMA(0, 1, At, B1); GM_BAR; GM_SCHED;
            GM_LDA(At, 1, 1); GM_STAGE_B(GM_SB(1, 0), b3); GM_STAGE_B(GM_SB(1, 1), b3 + hB); GM_STAGE_A(GM_SA(1, 0), a3, 0, last);
            GM_WAIT_V(8); GM_WAIT_L(0); GM_BAR; GM_MMA(1, 0, At, B0); GM_MMA(1, 1, At, B1); GM_BAR; GM_SCHED;
        }
        if constexpr (ALIGN_EPI) { if (wr == 0) GM_BAR; }
        if constexpr (F8) asm volatile("s_nop 15\n\ts_nop 15" ::: "memory");
        E(acc, cur, wr, wc, fr, fq);
        if (!has_next) break;
#pragma unroll
        for (int a = 0; a < 2; ++a)
#pragma unroll
            for (int b = 0; b < 2; ++b)
#pragma unroll
                for (int m = 0; m < 4; ++m)
#pragma unroll
                    for (int n = 0; n < 2; ++n) acc[a][b][m][n] = (f32x4){0.f, 0.f, 0.f, 0.f};
        cur = nxt; cA = nA; cB = nB; ++ui;
        if constexpr (GATHER) {
#pragma unroll
            for (int h = 0; h < 2; ++h)
#pragma unroll
                for (int i = 0; i < 2; ++i) gcur[h][i] = S.rowoff(ui, h * HALF + RA[i]) * lda + colA[i];
        }
        if constexpr (ALIGN_EPI) { if (wr == 1) GM_BAR; }
    }
    GM_WAIT_V(0);
    if constexpr (!ALIGN_EPI) { if (wr == 0) GM_BAR; }
    GM_BAR;
#undef GM_SA
#undef GM_SB
#undef GM_STAGE_A
#undef GM_STAGE_B
#undef GM_LDA
#undef GM_LDB
#undef GM_MMA
#undef GM_LD8
#undef GM_WAIT_V
#undef GM_WAIT_L
#undef GM_BAR
#undef GM_SCHED
}
}
using gm::GUnit;
typedef f32x4 AccT[2][2][4][2];

struct Args { const float* in[26]; float* out; unsigned char* ws; float invf[NRT]; int ph_lo, ph_hi; };
typedef const __attribute__((address_space(4))) Args ArgsK;
template <class Tp> __device__ __forceinline__ Tp* gptr(Tp* p) { return (Tp*)(GAS Tp*)p; }
struct Ctx {
    LAS unsigned char* lds; int tid, lane, wave, G, bid;
    unsigned char* ws;
    float* out;
};

struct DenseSched {
    gm::StaticOrder so; const char* A; const char* B; unsigned lda, ldb; int nt;
    __device__ __forceinline__ bool next(int i, GUnit& u) const { gm::Unit t; if (!so.next(i, t)) return false; u.pm = t.pm; u.pn = t.pn; u.aux = 0;
        u.A = A + (size_t)t.pm * 256 * lda; u.B = B + (size_t)t.pn * 256 * ldb; u.nt = nt; return true; }
    __device__ __forceinline__ unsigned rowoff(int, int) const { return 0; }
};
struct BranchSched {
    gm::StaticOrder so; const char* A; const char* B;
    __device__ __forceinline__ bool next(int j, GUnit& u) const { const int jt = j / 3, br = j - 3 * jt; gm::Unit t; if (!so.next(jt, t)) return false;
        const int koff = br == 0 ? 0 : (br == 1 ? 512 : 1536); u.pm = t.pm; u.pn = t.pn; u.aux = br; u.nt = br == 1 ? 8 : 4;
        u.A = A + (size_t)t.pm * 256 * 2048 + koff; u.B = B + (size_t)t.pn * 256 * 2048 + koff; return true; }
    __device__ __forceinline__ unsigned rowoff(int, int) const { return 0; }
};
struct UpSched {
    const char* P; const char* Wq; const char* Wkv; int G, c;
    __device__ __forceinline__ bool next(int i, GUnit& u) const {
        int L;
        if (G == 256) { if (c < 128) { if (i > 2) return false; L = i == 0 ? c : (i == 1 ? 128 + c : 384 + c); }
                        else { if (i > 3) return false; const int d = c - 128; L = i == 0 ? 256 + d : 384 + 128 * i + d; } }
        else { L = i * G + c; if (L >= 896) return false; }
        if (L < 384) { u.pm = L / 6; u.pn = L % 6; u.aux = 0; u.nt = 8; u.A = P + (size_t)u.pm * 256 * (PC * 2) + C_CQ * 2; u.B = Wq + (size_t)u.pn * 256 * 1024; }
        else { const int v = L - 384; u.pm = v / 8; u.pn = v % 8; u.aux = 1; u.nt = 4; u.A = P + (size_t)u.pm * 256 * (PC * 2) + C_CKV * 2; u.B = Wkv + (size_t)u.pn * 256 * 1024; }
        return true; }
    __device__ __forceinline__ unsigned rowoff(int, int) const { return 0; }
};
struct RouterSched {
    const char* X; const char* W; int G, c;
    __device__ __forceinline__ bool next(int i, GUnit& u) const { const int L = i * G + c; if (L >= 256) return false;
        u.pm = L >> 2; u.pn = 0; u.aux = L & 3; u.nt = 8; u.A = X + (size_t)u.pm * 256 * 4096 + (size_t)u.aux * 1024; u.B = W + (size_t)u.aux * 1024; return true; }
    __device__ __forceinline__ unsigned rowoff(int, int) const { return 0; }
};
__device__ __forceinline__ int xcd_chunk_unit(int i, int c, int G, int U) {
    if (G % 8 != 0) { const int L = i * G + c; return L < U ? L : -1; }
    const int per = G / 8, x = c % 8, j = c / 8, q = (U + 7) / 8, lo = x * q, hi = (lo + q < U) ? lo + q : U;
    const int L = lo + i * per + j; return L < hi ? L : -1;
}
constexpr int TAB_TILEE = 0, TAB_MISC = 704 * 4, TAB_IDX = 704 * 4 + 64, TAB_SW = TAB_IDX + 10 * 256 * 4;
struct Moe1Sched {
    LAS unsigned char* tab; const char* X; const char* W13; int G, c;
    __device__ __forceinline__ bool next(int i, GUnit& u) const { const LAS int* misc = (const LAS int*)(tab + TAB_MISC); const int nrt = misc[0], ntl = misc[1];
        const int L = xcd_chunk_unit(i, c, G, ntl * 4); if (L < 0 || i >= 10) return false; const int tile = L >> 2, pn = L & 3; const int e = ((const LAS int*)(tab + TAB_TILEE))[tile];
        u.pm = tile < nrt ? tile * 256 : RT_ROWS + (tile - nrt) * 256; u.pn = pn; u.aux = e; u.idx = i; u.nt = 16; u.A = X; u.B = W13 + (size_t)e * (2 * MiB) + (size_t)pn * 256 * 2048; return true; }
    __device__ __forceinline__ unsigned rowoff(int ui, int r) const { return ((const LAS unsigned*)(tab + TAB_IDX))[ui * 256 + r]; }
};
struct Moe2Sched {
    LAS unsigned char* tab; const char* H; const char* W2; int G, c;
    __device__ __forceinline__ bool next(int i, GUnit& u) const { const LAS int* misc = (const LAS int*)(tab + TAB_MISC); const int nrt = misc[0], ntl = misc[1];
        const int L = xcd_chunk_unit(i, c, G, ntl * 8); if (L < 0) return false; const int tile = L >> 3, pn = L & 7; const int e = ((const LAS int*)(tab + TAB_TILEE))[tile];
        u.pm = tile < nrt ? tile * 256 : RT_ROWS + (tile - nrt) * 256; u.pn = pn; u.aux = e; u.nt = 8; u.nt = 4; u.A = H + (size_t)u.pm * 512; u.B = W2 + (size_t)e * (1 * MiB) + (size_t)pn * 256 * 512; return true; }
    __device__ __forceinline__ unsigned rowoff(int, int) const { return 0; }
};

__device__ __forceinline__ u32x4 pk8(f32x4 v0, f32x4 v1) { u32x4 w; w.x = cvt_pk_bf16(v0[0], v0[1]); w.y = cvt_pk_bf16(v0[2], v0[3]); w.z = cvt_pk_bf16(v1[0], v1[1]); w.w = cvt_pk_bf16(v1[2], v1[3]); return w; }
struct EpiInProj {
    static constexpr bool COL16 = true;
    static constexpr int BSH = 6;
    bf16_t* P; float* rsq_q; float* rsq_kv;
    __device__ __forceinline__ void operator()(const AccT& acc, const GUnit& u, int wr, int wc, int fr, int fq) const {
        const int row0 = u.pm * 256 + wr * 64 + fr, col0 = u.pn * 256 + wc * 64 + 16 * fq;
        const bool sig = (u.pn >= 15 && u.pn < 39); const int sq = (u.pn == 6 || u.pn == 7) ? 1 : (u.pn == 8 ? 2 : 0);
        bf16_t* rowp0 = P + (size_t)row0 * PC + col0;
        if (sig) {
            unsigned char* gb0 = (unsigned char*)(P + (size_t)row0 * PC) + C_G * 2 + (col0 - C_G);
#define G256(x_) fminf(__builtin_amdgcn_rcpf(__builtin_fmaf(__builtin_amdgcn_exp2f((x_) * -1.4426950408889634f), 0.00390625f, 0.00390625f)), 255.f)
#pragma unroll
            for (int ai = 0; ai < 2; ++ai)
#pragma unroll
                for (int m = 0; m < 4; ++m) { u32x4 w; unsigned t[4];
#pragma unroll
                    for (int bj = 0; bj < 2; ++bj)
#pragma unroll
                        for (int n = 0; n < 2; ++n) { const f32x4 v = acc[ai][bj][m][n]; unsigned p = 0u;
                            p = __builtin_amdgcn_cvt_pk_u8_f32(G256(v[0]), 0u, p); p = __builtin_amdgcn_cvt_pk_u8_f32(G256(v[1]), 1u, p); p = __builtin_amdgcn_cvt_pk_u8_f32(G256(v[2]), 2u, p); p = __builtin_amdgcn_cvt_pk_u8_f32(G256(v[3]), 3u, p);
                            t[bj * 2 + n] = p; }
                    w.x = t[0]; w.y = t[1]; w.z = t[2]; w.w = t[3];
                    __builtin_nontemporal_store(w, (u32x4*)(gb0 + (size_t)(ai * 128 + m * 16) * (PC * 2))); }
#undef G256
        } else {
#pragma unroll
            for (int ai = 0; ai < 2; ++ai)
#pragma unroll
                for (int m = 0; m < 4; ++m) { const int row = row0 + ai * 128 + m * 16; bf16_t* rowp = rowp0 + (size_t)(ai * 128 + m * 16) * PC;
#pragma unroll
                    for (int bj = 0; bj < 2; ++bj) *(u32x4*)(rowp + bj * 8) = pk8(acc[ai][bj][m][0], acc[ai][bj][m][1]);
                    if (sq) { float ss = 0.f;
#pragma unroll
                        for (int bj = 0; bj < 2; ++bj) { const f32x4 v0 = acc[ai][bj][m][0], v1 = acc[ai][bj][m][1];
                            ss += (v0[0] * v0[0] + v0[1] * v0[1]) + (v0[2] * v0[2] + v0[3] * v0[3]) + (v1[0] * v1[0] + v1[1] * v1[1]) + (v1[2] * v1[2] + v1[3] * v1[3]); }
                        ss += __shfl_xor(ss, 16); ss += __shfl_xor(ss, 32); if (fq == 0) { if (sq == 1) rsq_q[row * 8 + (u.pn - 6) * 4 + wc] = ss; else rsq_kv[row * 4 + wc] = ss; } } }
        }
    }
};
struct EpiUp {
    static constexpr bool COL16 = false;
    static constexpr int BSH = 0;
    bf16_t* Qm; bf16_t* Kf; bf16_t* Vm; const float* rsq_q; const float* rsq_kv;
    __device__ __forceinline__ void operator()(const AccT& acc, const GUnit& u, int wr, int wc, int fr, int fq) const {
        const int row0 = u.pm * 256 + wr * 64 + fr, cw = wc * 32 + 8 * fq; const bool kv = u.aux != 0;
        float rs8[2][4];
#pragma unroll
        for (int ai = 0; ai < 2; ++ai)
#pragma unroll
            for (int m = 0; m < 4; ++m) { const int row = row0 + ai * 128 + m * 16;
                if (kv) { const f32x4 p = *(const f32x4*)(rsq_kv + row * 4); rs8[ai][m] = rsqrtf(((p[0] + p[1]) + (p[2] + p[3])) * (1.f / 256.f) + NORM_EPS); }
                else { const f32x4 p = *(const f32x4*)(rsq_q + row * 8), q = *(const f32x4*)(rsq_q + row * 8 + 4); rs8[ai][m] = rsqrtf((((p[0] + p[1]) + (p[2] + p[3])) + ((q[0] + q[1]) + (q[2] + q[3]))) * (1.f / 512.f) + NORM_EPS); } }
#pragma unroll
        for (int ai = 0; ai < 2; ++ai)
#pragma unroll
            for (int m = 0; m < 4; ++m) { const int row = row0 + ai * 128 + m * 16; const float rs = rs8[ai][m];
#pragma unroll
                for (int bj = 0; bj < 2; ++bj) { const f32x4 v0 = acc[ai][bj][m][0] * rs, v1 = acc[ai][bj][m][1] * rs;
                    bf16_t* dst = kv ? (bj == 0 ? Kf + (size_t)row * 1536 + u.pn * 192 + cw : Vm + (size_t)row * 1024 + u.pn * 128 + cw) : Qm + (size_t)row * 1536 + u.pn * 256 + bj * 128 + cw;
                    *(u32x4*)dst = pk8(v0, v1); } }
    }
};
typedef _Float16 h16x8 __attribute__((ext_vector_type(8)));
struct EpiBranch {
    static constexpr bool COL16 = true;
    static constexpr int BSH = 18;
    bf16_t* YB; unsigned char* YQ; const bf16_t* P;
    __device__ __forceinline__ void operator()(const AccT& acc, const GUnit& u, int wr, int wc, int fr, int fq) const {
        const int row0 = u.pm * 256 + wr * 64 + fr, col0 = u.pn * 256 + wc * 64 + 16 * fq; const int br = u.aux;
        const unsigned char* gp = (const unsigned char*)(P + (size_t)row0 * PC) + C_G * 2 + br * 2048 + col0; bf16_t* yp = YB + (size_t)row0 * 2048 + col0; unsigned char* qp = YQ + (size_t)row0 * 2048 + col0;
        u32x4 gw[2][4];
#pragma unroll
        for (int ai = 0; ai < 2; ++ai)
#pragma unroll
            for (int m = 0; m < 4; ++m) gw[ai][m] = *(const u32x4*)(gp + (size_t)(ai * 128 + m * 16) * (PC * 2));
#pragma unroll
        for (int ai = 0; ai < 2; ++ai) { h16x8 yy[4][2];
#pragma unroll
            for (int m = 0; m < 4; ++m)
#pragma unroll
                for (int bj = 0; bj < 2; ++bj) yy[m][bj] = br != 0 ? *(const h16x8*)(yp + (size_t)(ai * 128 + m * 16) * 2048 + bj * 8) : (h16x8){0, 0, 0, 0, 0, 0, 0, 0};
#pragma unroll
            for (int m = 0; m < 4; ++m)
#pragma unroll
                for (int bj = 0; bj < 2; ++bj) { const int ro = ai * 128 + m * 16; const h16x8 y = yy[m][bj]; float v[8];
                    const unsigned w0 = bj ? gw[ai][m].z : gw[ai][m].x, w1 = bj ? gw[ai][m].w : gw[ai][m].y;
                    const float g[8] = {(float)(w0 & 0xffu), (float)((w0 >> 8) & 0xffu), (float)((w0 >> 16) & 0xffu), (float)(w0 >> 24), (float)(w1 & 0xffu), (float)((w1 >> 8) & 0xffu), (float)((w1 >> 16) & 0xffu), (float)(w1 >> 24)};
#pragma unroll
                    for (int j = 0; j < 8; ++j) v[j] = acc[ai][bj][m][j >> 2][j & 3] * g[j] + (float)y[j];
                    if (br == 2) { u32x2 q; q.x = pk4_fp8(clamp8(v[0] * Y8_SCALE), clamp8(v[1] * Y8_SCALE), clamp8(v[2] * Y8_SCALE), clamp8(v[3] * Y8_SCALE));
                        q.y = pk4_fp8(clamp8(v[4] * Y8_SCALE), clamp8(v[5] * Y8_SCALE), clamp8(v[6] * Y8_SCALE), clamp8(v[7] * Y8_SCALE)); *(u32x2*)(qp + (size_t)ro * 2048 + bj * 8) = q; }
                    else { u32x4 w; w.x = __builtin_bit_cast(unsigned, __builtin_amdgcn_cvt_pkrtz(v[0], v[1])); w.y = __builtin_bit_cast(unsigned, __builtin_amdgcn_cvt_pkrtz(v[2], v[3]));
                        w.z = __builtin_bit_cast(unsigned, __builtin_amdgcn_cvt_pkrtz(v[4], v[5])); w.w = __builtin_bit_cast(unsigned, __builtin_amdgcn_cvt_pkrtz(v[6], v[7])); *(u32x4*)(yp + (size_t)ro * 2048 + bj * 8) = w; } } }
    }
};
struct EpiOut {
    static constexpr bool COL16 = true;
    static constexpr int BSH = 9;
    bf16_t* Z; const bf16_t* xres;
    __device__ __forceinline__ void operator()(const AccT& acc, const GUnit& u, int wr, int wc, int fr, int fq) const {
        const int row0 = u.pm * 256 + wr * 64 + fr, col0 = u.pn * 256 + wc * 64 + 16 * fq;
        u32x4 xr[2][4][2];
#pragma unroll
        for (int ai = 0; ai < 2; ++ai)
#pragma unroll
            for (int m = 0; m < 4; ++m)
#pragma unroll
                for (int bj = 0; bj < 2; ++bj) xr[ai][m][bj] = *(const u32x4*)(xres + (size_t)(row0 + ai * 128 + m * 16) * 2048 + col0 + bj * 8);
#pragma unroll
        for (int ai = 0; ai < 2; ++ai) {
#pragma unroll
            for (int m = 0; m < 4; ++m) { const size_t ro = (size_t)(row0 + ai * 128 + m * 16) * 2048 + col0;
#pragma unroll
                for (int bj = 0; bj < 2; ++bj) { const u32x4 x = xr[ai][m][bj]; f32x4 v0 = acc[ai][bj][m][0], v1 = acc[ai][bj][m][1];
                    v0[0] += DN_ALPHA * bflo(x.x); v0[1] += DN_ALPHA * bfhi(x.x); v0[2] += DN_ALPHA * bflo(x.y); v0[3] += DN_ALPHA * bfhi(x.y);
                    v1[0] += DN_ALPHA * bflo(x.z); v1[1] += DN_ALPHA * bfhi(x.z); v1[2] += DN_ALPHA * bflo(x.w); v1[3] += DN_ALPHA * bfhi(x.w);
                    *(u32x4*)(Z + ro + bj * 8) = pk8(v0, v1); } } }
    }
};
struct EpiLogit {
    static constexpr bool COL16 = false;
    static constexpr int BSH = 0;
    float* L;
    __device__ __forceinline__ void operator()(const AccT& acc, const GUnit& u, int wr, int wc, int fr, int fq) const {
        if (wc >= 2) return; const int row0 = u.pm * 256 + wr * 64 + fr, col0 = wc * 32 + 8 * fq;
#pragma unroll
        for (int ai = 0; ai < 2; ++ai)
#pragma unroll
            for (int m = 0; m < 4; ++m) { float* d = L + (size_t)u.aux * T * 64 + (size_t)(row0 + ai * 128 + m * 16) * 64 + col0; *(f32x4*)d = acc[ai][0][m][0]; *(f32x4*)(d + 4) = acc[ai][0][m][1]; }
    }
};
struct EpiMoe1 {
    static constexpr bool COL16 = false;
    static constexpr int BSH = 6;
    unsigned char* H; const LAS float* sw;
    __device__ __forceinline__ void operator()(const AccT& acc, const GUnit& u, int wr, int wc, int fr, int fq) const {
        const int row0 = u.pm + wr * 64 + fr, col0 = u.pn * 128 + wc * 32 + 8 * fq; const LAS float* swu = sw + u.idx * 256 + wr * 64 + fr;
        float w8[2][4];
#pragma unroll
        for (int ai = 0; ai < 2; ++ai)
#pragma unroll
            for (int m = 0; m < 4; ++m) w8[ai][m] = swu[ai * 128 + m * 16];
#pragma unroll
        for (int ai = 0; ai < 2; ++ai)
#pragma unroll
            for (int m = 0; m < 4; ++m) { const int srow = row0 + ai * 128 + m * 16; const float w = w8[ai][m] * H8_SCALE;
                float h0[4], h1[4];
#pragma unroll
                for (int j = 0; j < 4; ++j) { const float g0 = acc[ai][0][m][0][j], g1 = acc[ai][0][m][1][j];
                    h0[j] = clamp8(g0 * sigmoidf_(g0) * acc[ai][1][m][0][j] * w); h1[j] = clamp8(g1 * sigmoidf_(g1) * acc[ai][1][m][1][j] * w); }
                u32x2 o; o.x = pk4_fp8(h0[0], h0[1], h0[2], h0[3]); o.y = pk4_fp8(h1[0], h1[1], h1[2], h1[3]);
                *(u32x2*)(H + (size_t)srow * FF + col0) = o; }
    }
};
struct EpiMoe2 {
    static constexpr bool COL16 = true;
    static constexpr int BSH = 5;
    unsigned char* Y;
    __device__ __forceinline__ void operator()(const AccT& acc, const GUnit& u, int wr, int wc, int fr, int fq) const {
        const int row0 = u.pm + wr * 64 + fr, col0 = u.pn * 256 + wc * 64 + 16 * fq;
#pragma unroll
        for (int ai = 0; ai < 2; ++ai)
#pragma unroll
            for (int m = 0; m < 4; ++m) { u32x4 q;
                q.x = pk4_fp8(acc[ai][0][m][0][0], acc[ai][0][m][0][1], acc[ai][0][m][0][2], acc[ai][0][m][0][3]); q.y = pk4_fp8(acc[ai][0][m][1][0], acc[ai][0][m][1][1], acc[ai][0][m][1][2], acc[ai][0][m][1][3]);
                q.z = pk4_fp8(acc[ai][1][m][0][0], acc[ai][1][m][0][1], acc[ai][1][m][0][2], acc[ai][1][m][0][3]); q.w = pk4_fp8(acc[ai][1][m][1][0], acc[ai][1][m][1][1], acc[ai][1][m][1][2], acc[ai][1][m][1][3]);
                *(u32x4*)(Y + (size_t)(row0 + ai * 128 + m * 16) * 2048 + col0) = q; }
    }
};

struct CvtJob { const float* src; int pitch; int K; int N; const float* kscale; bf16_t* dst; int dpitch; int grp; int gstride; int rbase; size_t sbs; size_t dbs; int nbatch; int f8; };
template <int NT, int NP> __device__ __forceinline__ void cvt_load(const Ctx& C, const CvtJob& J, f32x4 (&dst)[NP], int it, int per, int nnb) {
    constexpr int TPR = NT / 4, RPP = 512 / TPR;
    const int rr = C.tid / TPR, c4 = (C.tid % TPR) * 4;
    const int e_ = it / per, r_ = it - e_ * per, kb_ = r_ / nnb, nb_ = r_ - kb_ * nnb;
    const float* s_ = J.src + (size_t)e_ * J.sbs + (size_t)(kb_ * 128) * J.pitch + nb_ * NT;
#pragma unroll
    for (int p = 0; p < NP; ++p) { const int k = p * RPP + rr; dst[p] = __builtin_nontemporal_load((const f32x4*)(s_ + (size_t)k * J.pitch + c4)); }
}
template <int NT, int NP> __device__ __forceinline__ void cvt_step(const Ctx& C, const CvtJob& J, f32x4 (&v)[NP], int it, int total, int per, int nnb) {
    LAS float* scr = (LAS float*)C.lds;
    constexpr int TPR = NT / 4, RPP = 512 / TPR, PT = NT + 1, NQ = NT * 16 / 512;
    const int rr = C.tid / TPR, c4 = (C.tid % TPR) * 4;
    const int e = it / per, r = it - e * per, kb = r / nnb, nb = r - kb * nnb;
#pragma unroll
    for (int p = 0; p < NP; ++p) { const int k = p * RPP + rr; f32x4 x = v[p]; if (J.kscale) x = x * J.kscale[kb * 128 + k];
        scr[k * PT + c4 + 0] = x[0]; scr[k * PT + c4 + 1] = x[1]; scr[k * PT + c4 + 2] = x[2]; scr[k * PT + c4 + 3] = x[3]; }
    __syncthreads();
    if (it + 3 * C.G < total) cvt_load<NT, NP>(C, J, v, it + 3 * C.G, per, nnb);
    const int j0 = nb * NT; const int drow0 = (j0 / J.grp) * J.gstride + (j0 % J.grp) + J.rbase;
    if (J.f8) { unsigned char* d8 = (unsigned char*)J.dst + (size_t)e * J.dbs + (size_t)drow0 * J.dpitch + kb * 128;
#pragma unroll
        for (int q = 0; q < NQ; ++q) { const int ch = (C.tid & 7) | ((q & 1) << 3), n = (C.tid >> 3) + 64 * (q >> 1); const LAS float* sp = scr + (8 * ch) * PT + n;
            u32x2 o; o.x = pk4_fp8(sp[0] * W8_SCALE, sp[PT] * W8_SCALE, sp[2 * PT] * W8_SCALE, sp[3 * PT] * W8_SCALE); o.y = pk4_fp8(sp[4 * PT] * W8_SCALE, sp[5 * PT] * W8_SCALE, sp[6 * PT] * W8_SCALE, sp[7 * PT] * W8_SCALE);
            *(u32x2*)(d8 + (size_t)n * J.dpitch + 8 * ch) = o; }
    } else {
        bf16_t* d = J.dst + (size_t)e * J.dbs + (size_t)drow0 * J.dpitch + kb * 128;
#pragma unroll
        for (int q = 0; q < NQ; ++q) { const int ch = (C.tid & 7) | ((q & 1) << 3), n = (C.tid >> 3) + 64 * (q >> 1); const LAS float* sp = scr + (8 * ch) * PT + n;
            u32x4 o; o.x = cvt_pk_bf16(sp[0], sp[PT]); o.y = cvt_pk_bf16(sp[2 * PT], sp[3 * PT]); o.z = cvt_pk_bf16(sp[4 * PT], sp[5 * PT]); o.w = cvt_pk_bf16(sp[6 * PT], sp[7 * PT]);
            *(u32x4*)(d + (size_t)n * J.dpitch + 8 * ch) = o; }
    }
    __syncthreads();
}
template <int NT> __device__ __forceinline__ void cvt_job_t(const Ctx& C, const CvtJob& J, int& rot) {
    constexpr int TPR = NT / 4, RPP = 512 / TPR, NP = 128 / RPP;
    const int nkb = J.K / 128, nnb = J.N / NT, per = nkb * nnb, total = per * J.nbatch;
    int start = C.bid - rot; if (start < 0) start += C.G;
    f32x4 va[NP], vb[NP], vc[NP];
    if (start < total) cvt_load<NT, NP>(C, J, va, start, per, nnb);
    if (start + C.G < total) cvt_load<NT, NP>(C, J, vb, start + C.G, per, nnb);
    if (start + 2 * C.G < total) cvt_load<NT, NP>(C, J, vc, start + 2 * C.G, per, nnb);
#pragma nounroll
    for (int it = start; it < total; it += 3 * C.G) {
        cvt_step<NT, NP>(C, J, va, it, total, per, nnb);
        if (it + C.G < total) cvt_step<NT, NP>(C, J, vb, it + C.G, total, per, nnb);
        if (it + 2 * C.G < total) cvt_step<NT, NP>(C, J, vc, it + 2 * C.G, total, per, nnb);
    }
    rot = (rot + total) % C.G;
}
__device__ __forceinline__ void ld_nt_async(f32x4& v, const float* p) { asm volatile("global_load_dwordx4 %0, %1, off nt" : "=v"(v) : "v"(p)); }
#define CVT_W8(v) "+v"(v[0]), "+v"(v[1]), "+v"(v[2]), "+v"(v[3]), "+v"(v[4]), "+v"(v[5]), "+v"(v[6]), "+v"(v[7])
__device__ __forceinline__ void cvt_loada(const Ctx& C, const CvtJob& J, f32x4 (&dst)[8], int it, int total, int per, int nnb) {
    const int rr = C.tid >> 5, c4 = (C.tid & 31) * 4;
    const bool ok = it < total; const int itc = ok ? it : 0;
    const int e_ = itc / per, r_ = itc - e_ * per, kb_ = r_ / nnb, nb_ = r_ - kb_ * nnb;
    const float* s_ = J.src + (size_t)e_ * J.sbs + (size_t)(kb_ * 128) * J.pitch + nb_ * 128;
#pragma unroll
    for (int p = 0; p < 8; ++p) { const int k = p * 16 + rr; const float* a = ok ? s_ + (size_t)k * J.pitch + c4 : J.src; ld_nt_async(dst[p], a); }
}
__device__ __forceinline__ void cvt_dummy4(const Ctx& C) {
    unsigned char* dp = C.ws + WS_X2F + ((size_t)C.bid * NTHR + C.tid) * 16; u32x2 z = (u32x2){0u, 0u};
#pragma unroll
    for (int q = 0; q < 4; ++q) asm volatile("global_store_dwordx2 %0, %1, off" :: "v"(dp), "v"(z) : "memory");
}
__device__ __forceinline__ void cvt_stepa(const Ctx& C, const CvtJob& J, f32x4 (&v)[8], int it, int total, int per, int nnb, int& par) {
    LAS float* scr = (LAS float*)(C.lds + par * 65536); par ^= 1;
    const int rr = C.tid >> 5, cg = C.tid & 31;
    const int e = it / per, r = it - e * per, kb = r / nnb, nb = r - kb * nnb;
    asm volatile("s_waitcnt vmcnt(28)" : CVT_W8(v));
#pragma unroll
    for (int p = 0; p < 8; ++p) { const int k = p * 16 + rr; f32x4 x = v[p]; if (J.kscale) x = x * J.kscale[kb * 128 + k];
        *(LAS f32x4*)(scr + k * 128 + ((cg ^ ((k >> 3) & 15)) << 2)) = x; }
    __syncthreads();
    cvt_loada(C, J, v, it + 3 * C.G, total, per, nnb);
    const int j0 = nb * 128; const int drow0 = (j0 / J.grp) * J.gstride + (j0 % J.grp) + J.rbase;
    const int k8 = C.tid & 15, g = C.tid >> 4;
    f32x4 x[8];
#pragma unroll
    for (int j = 0; j < 8; ++j) x[j] = *(const LAS f32x4*)(scr + (k8 * 8 + j) * 128 + ((g ^ k8) << 2));
    if (J.f8) { unsigned char* d8 = (unsigned char*)J.dst + (size_t)e * J.dbs + (size_t)drow0 * J.dpitch + kb * 128 + k8 * 8;
#pragma unroll
        for (int q = 0; q < 4; ++q) {
            u32x2 o; o.x = pk4_fp8(x[0][q] * W8_SCALE, x[1][q] * W8_SCALE, x[2][q] * W8_SCALE, x[3][q] * W8_SCALE); o.y = pk4_fp8(x[4][q] * W8_SCALE, x[5][q] * W8_SCALE, x[6][q] * W8_SCALE, x[7][q] * W8_SCALE);
            __builtin_nontemporal_store(o, (u32x2*)(d8 + (size_t)(4 * g + q) * J.dpitch)); }
    } else {
        bf16_t* d = J.dst + (size_t)e * J.dbs + (size_t)drow0 * J.dpitch + kb * 128 + k8 * 8;
#pragma unroll
        for (int q = 0; q < 4; ++q) {
            u32x4 o; o.x = cvt_pk_bf16(x[0][q], x[1][q]); o.y = cvt_pk_bf16(x[2][q], x[3][q]); o.z = cvt_pk_bf16(x[4][q], x[5][q]); o.w = cvt_pk_bf16(x[6][q], x[7][q]);
            __builtin_nontemporal_store(o, (u32x4*)(d + (size_t)(4 * g + q) * J.dpitch)); }
    }
}
__device__ __forceinline__ void cvt_job_a(const Ctx& C, const CvtJob& J, int& rot) {
    const int nkb = J.K / 128, nnb = J.N / 128, per = nkb * nnb, total = per * J.nbatch;
    int start = C.bid - rot; if (start < 0) start += C.G;
    f32x4 va[8], vb[8], vc[8]; int par = 0;
    cvt_loada(C, J, va, start, total, per, nnb); cvt_dummy4(C);
    cvt_loada(C, J, vb, start + C.G, total, per, nnb); cvt_dummy4(C);
    cvt_loada(C, J, vc, start + 2 * C.G, total, per, nnb); cvt_dummy4(C);
#pragma nounroll
    for (int it = start; it < total; it += 3 * C.G) {
        cvt_stepa(C, J, va, it, total, per, nnb, par);
        if (it + C.G < total) cvt_stepa(C, J, vb, it + C.G, total, per, nnb, par);
        if (it + 2 * C.G < total) cvt_stepa(C, J, vc, it + 2 * C.G, total, per, nnb, par);
    }
    asm volatile("s_waitcnt vmcnt(0)" : CVT_W8(va), CVT_W8(vb), CVT_W8(vc));
    __syncthreads();
    rot = (rot + total) % C.G;
}
__device__ __forceinline__ void cvt_issued(const Ctx& C, const CvtJob& J, int u, int j, int nun, int nkb, int ncc, int CB, int buf) {
    const bool ok = u < nun; const int uu = ok ? u : 0;
    const int e_ = uu / (nkb * ncc), r_ = uu - e_ * (nkb * ncc), kb_ = r_ / ncc, nb_ = (r_ - kb_ * ncc) * CB + j;
    const float* s_ = J.src + (size_t)e_ * J.sbs + (size_t)(kb_ * 128) * J.pitch + nb_ * 64;
    const int r = C.lane >> 4, slot = C.lane & 15;
#pragma unroll
    for (int i = 0; i < 4; ++i) { const int rg = i * 8 + C.wave;
        const float* a = ok ? s_ + (size_t)(rg * 4 + r) * J.pitch + ((slot ^ (rg & 15)) << 2) : J.src;
        __builtin_amdgcn_global_load_lds((const unsigned*)a, (LAS unsigned*)(C.lds + buf * 32768 + rg * 1024), 16, 0, 2); }
}
__device__ __forceinline__ void cvt_stepd(const Ctx& C, const CvtJob& J, int u, int j, int nkb, int ncc, int CB, int buf) {
    const int e = u / (nkb * ncc), r = u - e * (nkb * ncc), kb = r / ncc, nb = (r - kb * ncc) * CB + j;
    const int k4 = C.tid & 31, g = C.tid >> 5;
    const LAS float* sp = (const LAS float*)(C.lds + buf * 32768) + (k4 * 4) * 64 + ((g ^ (k4 & 15)) << 2);
    f32x4 x[4];
#pragma unroll
    for (int jj = 0; jj < 4; ++jj) x[jj] = *(const LAS f32x4*)(sp + jj * 64);
    const int j0 = nb * 64; const int drow0 = (j0 / J.grp) * J.gstride + (j0 % J.grp) + J.rbase;
    unsigned char* d8 = (unsigned char*)J.dst + (size_t)e * J.dbs + (size_t)drow0 * J.dpitch + kb * 128 + k4 * 4;
#pragma unroll
    for (int q = 0; q < 4; ++q) { const unsigned o = pk4_fp8(x[0][q] * W8_SCALE, x[1][q] * W8_SCALE, x[2][q] * W8_SCALE, x[3][q] * W8_SCALE);
        __builtin_nontemporal_store(o, (unsigned*)(d8 + (size_t)(4 * g + q) * J.dpitch)); }
}
__device__ __forceinline__ void cvt_job_d(const Ctx& C, const CvtJob& J, int& rot) {
    const int nkb = J.K / 128, nnb = J.N / 64, CB = (nnb % 8 == 0) ? 8 : (nnb % 6 == 0) ? 6 : (nnb % 4 == 0) ? 4 : 1, ncc = nnb / CB, nun = nkb * ncc * J.nbatch;
    int start = C.bid - rot; if (start < 0) start += C.G;
    int ui = start, ji = 0;
#define CVT_ADV(u_, j_) do { if (++j_ == CB) { j_ = 0; u_ += C.G; } } while (0)
    cvt_issued(C, J, ui, ji, nun, nkb, ncc, CB, 0); cvt_dummy4(C); CVT_ADV(ui, ji);
    cvt_issued(C, J, ui, ji, nun, nkb, ncc, CB, 1); cvt_dummy4(C); CVT_ADV(ui, ji);
    cvt_issued(C, J, ui, ji, nun, nkb, ncc, CB, 2); cvt_dummy4(C); CVT_ADV(ui, ji);
    int buf = 0, uc = start, jc = 0;
#pragma nounroll
    while (uc < nun) {
        asm volatile("s_waitcnt vmcnt(20)" ::: "memory");
        __builtin_amdgcn_s_barrier();
        cvt_issued(C, J, ui, ji, nun, nkb, ncc, CB, (buf + 3) & 3); CVT_ADV(ui, ji);
        cvt_stepd(C, J, uc, jc, nkb, ncc, CB, buf); CVT_ADV(uc, jc);
        buf = (buf + 1) & 3;
    }
#undef CVT_ADV
    asm volatile("s_waitcnt vmcnt(0)" ::: "memory");
    __syncthreads();
    rot = (rot + nun) % C.G;
}
__device__ __forceinline__ void cvt_job(const Ctx& C, const CvtJob& J, int& rot) {
    if (J.f8 && !J.kscale && J.N % 64 == 0) cvt_job_d(C, J, rot); else if (J.N % 128 == 0) cvt_job_a(C, J, rot); else cvt_job_t<64>(C, J, rot); }
__device__ __forceinline__ void zero_fill16(const Ctx& C, void* p, size_t bytes) {
    u32x4* q = (u32x4*)p; const size_t n = bytes / 16;
    unsigned z_; asm volatile("v_mov_b32 %0, 0" : "=v"(z_));
    for (size_t i = (size_t)C.bid * NTHR + C.tid; i < n; i += (size_t)C.G * NTHR) q[i] = (u32x4){z_, z_, z_, z_};
}
__device__ __forceinline__ void phase_convert_mixer(const Ctx& C, ArgsK* A, int l, int& rot) {
    unsigned char* ws = C.ws + (l ? MIXOFS1 : 0);
    const float* w_in = gptr(A->in[2]) + (size_t)l * DM * IN_COLS;
    bf16_t* WinT = (bf16_t*)(ws + WS_WIN);
    const int BIG = 1 << 30;
    { CvtJob J{w_in, IN_COLS, DM, 2304, nullptr, WinT, DM, BIG, 0, 0, 0, 0, 1, 1}; cvt_job(C, J, rot); }
    { CvtJob J{w_in + 2368, IN_COLS, DM, 7680, nullptr, WinT, DM, BIG, 0, 2304, 0, 0, 1, 1}; cvt_job(C, J, rot); }
    { CvtJob J{w_in + 2304, IN_COLS, DM, 64, nullptr, WinT, DM, BIG, 0, 9984, 0, 0, 1, 1}; cvt_job(C, J, rot); }
    zero_fill16(C, (unsigned char*)WinT + (size_t)10048 * DM, (size_t)192 * DM);
    { CvtJob J{gptr(A->in[9]) + (size_t)l * 512 * 1536, 1536, 512, 1536, gptr(A->in[8]) + l * 512, (bf16_t*)(ws + WS_WUQ), 512, BIG, 0, 0, 0, 0, 1, 0}; cvt_job(C, J, rot); }
    { CvtJob J{gptr(A->in[11]) + (size_t)l * 256 * 2048, 2048, 256, 2048, gptr(A->in[10]) + l * 256, (bf16_t*)(ws + WS_WUKV), 512, BIG, 0, 0, 0, 0, 1, 0}; cvt_job(C, J, rot); }
    { CvtJob J{gptr(A->in[16]) + (size_t)l * DM * 64, 64, DM, 64, nullptr, (bf16_t*)(ws + WS_WR), DM, BIG, 0, 0, 0, 0, 1, 0}; cvt_job(C, J, rot); }
    zero_fill16(C, (bf16_t*)(ws + WS_WR) + (size_t)64 * DM, (size_t)192 * DM * 2);
    { CvtJob J{gptr(A->in[12]) + (size_t)l * DM * DM, DM, DM, DM, nullptr, (bf16_t*)(ws + WS_WBR), DM, BIG, 0, 0, 0, 0, 1, 1}; cvt_job(C, J, rot); }
    { CvtJob J{gptr(A->in[13]) + (size_t)l * DM * DM, DM, DM, DM, nullptr, (bf16_t*)(ws + WS_WOUT), DM, BIG, 0, 0, 0, 0, 1, 1}; cvt_job(C, J, rot); }
}
__device__ __forceinline__ void phase_convert(const Ctx& C, ArgsK* A, int l) {
    const __attribute__((address_space(4))) float* invf = A->invf;
    unsigned char* ws = C.ws; int rot = 0;
    if (C.bid == 0 && C.tid < 128) ((unsigned*)(ws + WS_CTL))[CW_ECNT + C.tid] = 0u;
    phase_convert_mixer(C, A, 0, rot);
    if (l == 0) {
        const float* x = gptr(A->in[0]); bf16_t* XB = (bf16_t*)(ws + WS_XB);
        {
            const size_t stride = (size_t)C.G * NTHR * 8, n = (size_t)T * DM;
            for (size_t i = ((size_t)C.bid * NTHR + C.tid) * 8; i < n; i += 4 * stride) {
                f32x4 a[4], b[4];
#pragma unroll
                for (int u = 0; u < 4; ++u) { const size_t j = i + u * stride; const size_t jj = j < n ? j : i; a[u] = __builtin_nontemporal_load((const f32x4*)(x + jj)); b[u] = __builtin_nontemporal_load((const f32x4*)(x + jj + 4)); }
#pragma unroll
                for (int u = 0; u < 4; ++u) { const size_t j = i + u * stride; if (j < n) { *(u32x4*)(XB + j) = pk8(a[u], b[u]);
                    u32x2 q; q.x = pk4_fp8(a[u][0], a[u][1], a[u][2], a[u][3]); q.y = pk4_fp8(b[u][0], b[u][1], b[u][2], b[u][3]); *(u32x2*)((unsigned char*)(ws + WS_XQ) + j) = q; } }
            }
        }
        const int* pos = (const int*)gptr(A->in[1]); float* cosT = (float*)(ws + WS_COS); float* sinT = (float*)(ws + WS_SIN);
        for (int i0 = C.bid * NTHR + C.tid; i0 < T * NRT; i0 += 8 * C.G * NTHR) {
            int pv[8]; float iv[8];
#pragma unroll
            for (int u = 0; u < 8; ++u) { const int i = i0 + u * C.G * NTHR, ic = i < T * NRT ? i : i0, t = ic / NRT; pv[u] = pos[t]; iv[u] = invf[ic - t * NRT]; }
#pragma unroll
            for (int u = 0; u < 8; ++u) { const int i = i0 + u * C.G * NTHR; if (i < T * NRT) {
                const float ang = (float)pv[u] * iv[u];
                const double rev = (double)ang * 0.15915494309189535; const float fr = (float)(rev - floor(rev));
                cosT[i] = __builtin_amdgcn_cosf(fr); sinT[i] = __builtin_amdgcn_sinf(fr); } }
        }
    }
}
__device__ __forceinline__ void phase_convert_moe(const Ctx& C, ArgsK* A, int l) {
    unsigned char* ws = C.ws; int rot = 0;
    const int BIG = 1 << 30;
    bf16_t* W13 = (bf16_t*)(ws + WS_W13); bf16_t* W2 = (bf16_t*)(ws + WS_W2);
    const size_t EW = (size_t)DM * FF;
    { CvtJob J{gptr(A->in[18]) + (size_t)l * NEXP * EW, FF, DM, FF, nullptr, W13, DM, 128, 256, 0, EW, (size_t)1024 * DM, NEXP, 1}; cvt_job(C, J, rot); }
    { CvtJob J{gptr(A->in[19]) + (size_t)l * NEXP * EW, FF, DM, FF, nullptr, W13, DM, 128, 256, 128, EW, (size_t)1024 * DM, NEXP, 1}; cvt_job(C, J, rot); }
    { CvtJob J{gptr(A->in[20]) + (size_t)l * NEXP * EW, DM, FF, DM, nullptr, W2, FF, BIG, 0, 0, EW, (size_t)DM * FF, NEXP, 1}; cvt_job(C, J, rot); }
    { CvtJob J{gptr(A->in[21]) + (size_t)l * EW, FF, DM, FF, nullptr, (bf16_t*)((unsigned char*)W13 + (size_t)NEXP * 1024 * DM), DM, 128, 256, 0, 0, 0, 1, 1}; cvt_job(C, J, rot); }
    { CvtJob J{gptr(A->in[22]) + (size_t)l * EW, FF, DM, FF, nullptr, (bf16_t*)((unsigned char*)W13 + (size_t)NEXP * 1024 * DM), DM, 128, 256, 128, 0, 0, 1, 1}; cvt_job(C, J, rot); }
    { CvtJob J{gptr(A->in[23]) + (size_t)l * EW, DM, FF, DM, nullptr, (bf16_t*)((unsigned char*)W2 + (size_t)NEXP * DM * FF), FF, BIG, 0, 0, 0, 0, 1, 1}; cvt_job(C, J, rot); }
    if (l == 0) phase_convert_mixer(C, A, 1, rot);
}

__device__ __forceinline__ void rope8(u32x4& a, u32x4& b, const float* c, const float* s) {
    float x1[8] = {bflo(a.x), bfhi(a.x), bflo(a.y), bfhi(a.y), bflo(a.z), bfhi(a.z), bflo(a.w), bfhi(a.w)};
    float x2[8] = {bflo(b.x), bfhi(b.x), bflo(b.y), bfhi(b.y), bflo(b.z), bfhi(b.z), bflo(b.w), bfhi(b.w)};
    float y1[8], y2[8];
#pragma unroll
    for (int i = 0; i < 8; ++i) { y1[i] = x1[i] * c[i] - x2[i] * s[i]; y2[i] = x2[i] * c[i] + x1[i] * s[i]; }
    a.x = cvt_pk_bf16(y1[0], y1[1]); a.y = cvt_pk_bf16(y1[2], y1[3]); a.z = cvt_pk_bf16(y1[4], y1[5]); a.w = cvt_pk_bf16(y1[6], y1[7]);
    b.x = cvt_pk_bf16(y2[0], y2[1]); b.y = cvt_pk_bf16(y2[2], y2[3]); b.z = cvt_pk_bf16(y2[4], y2[5]); b.w = cvt_pk_bf16(y2[6], y2[7]);
}
__device__ __forceinline__ void ld8f(float (&d)[8], const float* p) { const f32x4 a = *(const f32x4*)p, b = *(const f32x4*)(p + 4); d[0] = a[0]; d[1] = a[1]; d[2] = a[2]; d[3] = a[3]; d[4] = b[0]; d[5] = b[1]; d[6] = b[2]; d[7] = b[3]; }
__device__ __forceinline__ void phase_krope(const Ctx& C) {
    unsigned char* ws = C.ws; bf16_t* P = (bf16_t*)(ws + WS_P); bf16_t* Kf = (bf16_t*)(ws + WS_KF);
    const float* cosT = (const float*)(ws + WS_COS); const float* sinT = (const float*)(ws + WS_SIN); float* kmean = (float*)(ws + WS_KMEAN);
    LAS float* red = (LAS float*)C.lds;
    for (int it = C.bid; it < 64 * 6; it += C.G) {
        const int rb = it / 6, kind = it - rb * 6, r0 = rb * 256;
        if (kind < 4) {
            const int h = kind, c8 = C.tid & 15, rr = C.tid >> 4;
            float cs[16];
#pragma unroll
            for (int j = 0; j < 16; ++j) cs[j] = 0.f;
            if (c8 < 2 || c8 >= 4) {
                for (int p = 0; p < 8; ++p) { const int row = r0 + p * 32 + rr; bf16_t* base = P + (size_t)row * PC + C_MK + h * 128;
                    if (c8 < 2) { u32x4 a = *(const u32x4*)(base + c8 * 8), b = *(const u32x4*)(base + 16 + c8 * 8);
                        float c[8], s[8]; ld8f(c, cosT + (size_t)row * NRT + 40 + c8 * 8); ld8f(s, sinT + (size_t)row * NRT + 40 + c8 * 8);
                        rope8(a, b, c, s); *(u32x4*)(base + c8 * 8) = a; *(u32x4*)(base + 16 + c8 * 8) = b;
                        cs[0] += bflo(a.x); cs[1] += bfhi(a.x); cs[2] += bflo(a.y); cs[3] += bfhi(a.y); cs[4] += bflo(a.z); cs[5] += bfhi(a.z); cs[6] += bflo(a.w); cs[7] += bfhi(a.w);
                        cs[8] += bflo(b.x); cs[9] += bfhi(b.x); cs[10] += bflo(b.y); cs[11] += bfhi(b.y); cs[12] += bflo(b.z); cs[13] += bfhi(b.z); cs[14] += bflo(b.w); cs[15] += bfhi(b.w);
                    } else { const u32x4 a = *(const u32x4*)(base + c8 * 8);
                        cs[0] += bflo(a.x); cs[1] += bfhi(a.x); cs[2] += bflo(a.y); cs[3] += bfhi(a.y); cs[4] += bflo(a.z); cs[5] += bfhi(a.z); cs[6] += bflo(a.w); cs[7] += bfhi(a.w); } }
            }
            if (c8 < 2) {
#pragma unroll
                for (int j = 0; j < 8; ++j) { red[rr * 128 + c8 * 8 + j] = cs[j]; red[rr * 128 + 16 + c8 * 8 + j] = cs[8 + j]; } }
            else if (c8 >= 4) {
#pragma unroll
                for (int j = 0; j < 8; ++j) red[rr * 128 + c8 * 8 + j] = cs[j]; }
            __syncthreads();
            if (C.tid < 128) { float s = 0.f; for (int q = 0; q < 32; ++q) s += red[q * 128 + C.tid];
                const int b = rb >> 3, nb = rb & 7; kmean[((size_t)(b * 4 + h) * 8 + nb) * 128 + C.tid] = s * (1.f / 256.f); }
            __syncthreads();
        } else if (kind == 4) {
            for (int q = 0; q < 4; ++q) { const int idx = C.tid + 512 * q, g = idx & 7, row = r0 + (idx >> 3); bf16_t* base = P + (size_t)row * PC + C_DK + g * 64;
                u32x4 a = *(const u32x4*)base, b = *(const u32x4*)(base + 8); float c[8], s[8]; ld8f(c, cosT + (size_t)row * NRT); ld8f(s, sinT + (size_t)row * NRT);
                rope8(a, b, c, s); *(u32x4*)base = a; *(u32x4*)(base + 8) = b; }
        } else {
            for (int q = 0; q < 2; ++q) { const int idx = C.tid + 512 * q, g = idx & 3, row = r0 + (idx >> 2); const bf16_t* base = P + (size_t)row * PC + C_KPE;
                u32x4 a = *(const u32x4*)(base + g * 8), b = *(const u32x4*)(base + 32 + g * 8); float c[8], s[8]; ld8f(c, cosT + (size_t)row * NRT + 8 + g * 8); ld8f(s, sinT + (size_t)row * NRT + 8 + g * 8);
                rope8(a, b, c, s);
#pragma unroll
                for (int h = 0; h < 8; ++h) { bf16_t* d = Kf + (size_t)row * 1536 + h * 192 + 128; *(u32x4*)(d + g * 8) = a; *(u32x4*)(d + 32 + g * 8) = b; } }
        }
    }
}

namespace at {
constexpr int LK = 0, LV = 24576, BUFSZ = 40960, LWS = 2 * BUFSZ, LKM = LWS + 2048;
__device__ __forceinline__ int v_st(int k, int c) { const int kk = (k & ~0xC) | ((k & 4) << 1) | ((k & 8) >> 1); return ((kk >> 3) * 4 + (c >> 5)) * 512 + ((kk & 7) * 32 + (c & 31)) * 2; }
__device__ __forceinline__ int v_rd_base(int lane) { return ((lane & 3) << 3) | (((lane >> 2) & 3) << 6) | (((lane >> 4) & 1) << 5) | (((lane >> 5) & 1) << 8); }
constexpr int v_rd_off(int d0, int ks, int half) { return d0 * 512 + ks * 4096 + half * 2048; }
__device__ __forceinline__ int crow(int r, int hi) { return (r & 3) + 8 * (r >> 2) + 4 * hi; }

__device__ __forceinline__ void rope_frag(bf16x8& a, bf16x8& b, const float* c, const float* s) {
    u32x4 ua = __builtin_bit_cast(u32x4, a), ub = __builtin_bit_cast(u32x4, b); rope8(ua, ub, c, s); a = __builtin_bit_cast(bf16x8, ua); b = __builtin_bit_cast(bf16x8, ub);
}

template <int KD, int MODE, int ROPE, int EPI>
__device__ __forceinline__ void attn_unit(LAS unsigned char* lds, const bf16_t* Qp, int qpitch, const bf16_t* Kp, int kpitch, const bf16_t* Vp, int vpitch,
                                          int trow0, int qb, const float* cosT, const float* sinT, float C2, const float* kmean_bh,
                                          float* O1, unsigned char* Oout, float lam, float outscale, const float* subg) {
    int tid_ = threadIdx.x; asm volatile("" : "+v"(tid_));
    const int tid = tid_, wid = __builtin_amdgcn_readfirstlane(tid >> 6), lane = tid & 63, r32 = lane & 31, hi = lane >> 5;
    const int q0 = qb * 256, qlo = q0 + wid * 32, qrow = qlo + r32;
    LAS unsigned char* K_lds = lds + LK; LAS unsigned char* V_lds = lds + LV;
    LAS float* wsf = (LAS float*)(lds + LWS) + wid * 64; LAS float* kml = (LAS float*)(lds + LKM);
    constexpr int ND = KD / 16;
    bf16x8 qr[ND];
    const bf16_t* qrowp = Qp + (size_t)qrow * qpitch;
#pragma unroll
    for (int d0 = 0; d0 < ND; ++d0) qr[d0] = *(const bf16x8*)(qrowp + d0 * 16 + hi * 8);
    const float* cr = cosT + (size_t)(trow0 + qrow) * NRT; const float* sr = sinT + (size_t)(trow0 + qrow) * NRT;
    if constexpr (ROPE == 0) {
        bf16x8 other = *(const bf16x8*)(qrowp + (1 - hi) * 8); float c[8], s[8]; ld8f(c, cr); ld8f(s, sr);
        bf16x8 a = hi ? other : qr[0], b = hi ? qr[0] : other; rope_frag(a, b, c, s); qr[0] = hi ? b : a;
    } else if constexpr (ROPE == 2) {
        float c[8], s[8]; ld8f(c, cr + 40 + hi * 8); ld8f(s, sr + 40 + hi * 8); rope_frag(qr[0], qr[1], c, s);
    } else {
        float c[8], s[8]; ld8f(c, cr + 8 + hi * 8); ld8f(s, sr + 8 + hi * 8); rope_frag(qr[8], qr[10], c, s);
        ld8f(c, cr + 8 + 16 + hi * 8); ld8f(s, sr + 8 + 16 + hi * 8); rope_frag(qr[9], qr[11], c, s);
    }
    unsigned selmask = 0xffu;
    if constexpr (MODE == 1) {
        __syncthreads();
        for (int i = tid; i < 1024; i += NTHR) kml[i] = kmean_bh[i];
        __syncthreads();
        float g[7];
#pragma unroll
        for (int n = 0; n < 7; ++n) { float s = 0.f;
            if (n < qb) {
#pragma unroll
                for (int d0 = 0; d0 < ND; ++d0) { const u32x4 w = __builtin_bit_cast(u32x4, qr[d0]); const LAS float* km = kml + n * 128 + d0 * 16 + hi * 8;
                    s += bflo(w.x) * km[0] + bfhi(w.x) * km[1] + bflo(w.y) * km[2] + bfhi(w.y) * km[3] + bflo(w.z) * km[4] + bfhi(w.z) * km[5] + bflo(w.w) * km[6] + bfhi(w.w) * km[7]; }
                s += __shfl_xor(s, 32);
            } else s = -__builtin_inff();
            g[n] = s; }
        if (qb <= 3) selmask = (1u << qb) - 1u;
        else { selmask = 0u;
#pragma unroll
            for (int n = 0; n < 7; ++n) { int rank = 0;
#pragma unroll
                for (int m = 0; m < 7; ++m) if (m != n) rank += (g[m] > g[n] || (g[m] == g[n] && m < n)) ? 1 : 0;
                if (rank < 3 && n < qb) selmask |= 1u << n; } }
    }
    constexpr int NKD = (64 * KD * 2) / 8192;
    int gko[NKD], gvo[2];
#pragma unroll
    for (int i = 0; i < NKD; ++i) { const int off = i * 8192 + tid * 16, row = off / (KD * 2), chs = (off - row * (KD * 2)) >> 4, ch = chs ^ (row & 7); gko[i] = row * kpitch + ch * 8; }
#pragma unroll
    for (int i = 0; i < 2; ++i) { const int off = i * 8192 + tid * 16, sub = off >> 9, within = off & 511, kk = (sub >> 2) * 8 + (within >> 6);
        const int k = (kk & ~0xC) | ((kk & 4) << 1) | ((kk & 8) >> 1), c = (sub & 3) * 32 + ((within & 63) >> 1); gvo[i] = k * vpitch + c; }
    const int vb00 = (int)(unsigned)(size_t)V_lds + v_rd_base(lane);
    int kbase4[4];
#pragma unroll
    for (int dd = 0; dd < 4; ++dd) kbase4[dd] = r32 * (KD * 2) + ((((dd * 2 + hi) ^ (r32 & 7))) << 4);
    const int NT = (q0 + 256) / 64;
#define AT_ISSUE(jt_, buf_) do { const size_t kb1_ = (size_t)(jt_) * 64; \
        _Pragma("unroll") for (int i = 0; i < NKD; ++i) __builtin_amdgcn_global_load_lds((const unsigned*)(Kp + kb1_ * kpitch + gko[i]), (LAS unsigned*)(lds + (buf_) * BUFSZ + LK + i * 8192 + wid * 1024), 16, 0, 0); \
        _Pragma("unroll") for (int i = 0; i < 2; ++i) __builtin_amdgcn_global_load_lds((const unsigned*)(Vp + kb1_ * vpitch + gvo[i]), (LAS unsigned*)(lds + (buf_) * BUFSZ + LV + i * 8192 + wid * 1024), 16, 0, 0); } while (0)
    AT_ISSUE(0, 0);
    float m_reg = -1e30f, l_reg = 0.f; f32x16 o[4];
#pragma unroll
    for (int d = 0; d < 4; ++d)
#pragma unroll
        for (int r = 0; r < 16; ++r) o[d][r] = 0.f;
    for (int jt = 0; jt < NT; ++jt) {
        asm volatile("s_waitcnt vmcnt(0)" ::: "memory");
        __syncthreads();
        if (jt + 1 < NT) AT_ISSUE(jt + 1, (jt + 1) & 1);
        const int bo = (jt & 1) * BUFSZ;
        const LAS unsigned char* Kb = K_lds + bo; const int vb0 = vb00 + bo;
        const int kb = jt * 64;
        bool act = kb <= qlo + 31;
        const int blk = jt >> 2;
        if (MODE == 1 && blk < qb) act = __any((int)((selmask >> blk) & 1u)) != 0;
        if (act) {
            f32x16 p0, p1;
#pragma unroll
            for (int r = 0; r < 16; ++r) { p0[r] = 0.f; p1[r] = 0.f; }
#pragma unroll
            for (int d0 = 0; d0 < ND; ++d0) { const LAS unsigned char* a = Kb + kbase4[d0 & 3] + (d0 >> 2) * 128;
                const bf16x8 b0 = *(const LAS bf16x8*)a, b1 = *(const LAS bf16x8*)(a + 32 * KD * 2);
                p0 = __builtin_amdgcn_mfma_f32_32x32x16_bf16(b0, qr[d0], p0, 0, 0, 0);
                p1 = __builtin_amdgcn_mfma_f32_32x32x16_bf16(b1, qr[d0], p1, 0, 0, 0); }
            const float NEG = -__builtin_inff();
            if (kb + 63 > qlo) {
                const int dq = qrow - 4 * hi - kb;
#pragma unroll
                for (int r = 0; r < 16; ++r) { const int c = (r & 3) + 8 * (r >> 2); if (dq - c < 0) p0[r] = NEG; if (dq - c - 32 < 0) p1[r] = NEG; }
            }
            if (MODE == 1 && blk < qb) { if (!((selmask >> blk) & 1u)) {
#pragma unroll
                for (int r = 0; r < 16; ++r) { p0[r] = NEG; p1[r] = NEG; } } }
            float pmax = p0[0];
#pragma unroll
            for (int r = 1; r < 16; ++r) pmax = fmaxf(pmax, p0[r]);
#pragma unroll
            for (int r = 0; r < 16; ++r) pmax = fmaxf(pmax, p1[r]);
            pmax = fmaxf(pmax, __shfl_xor(pmax, 32));
            const bool keep_max = __all((pmax - m_reg) * C2 <= 8.f) != 0;
            float mn = m_reg, alpha = 1.f;
            if (!keep_max) { mn = fmaxf(m_reg, pmax); alpha = __builtin_amdgcn_exp2f((m_reg - mn) * C2); m_reg = mn; }
            const float mnL = -mn * C2;
            float ps = 0.f;
#pragma unroll
            for (int r = 0; r < 16; ++r) { p0[r] = __builtin_amdgcn_exp2f(fmaf(p0[r], C2, mnL)); p1[r] = __builtin_amdgcn_exp2f(fmaf(p1[r], C2, mnL)); ps += p0[r] + p1[r]; }
            ps += __shfl_xor(ps, 32);
            l_reg = l_reg * alpha + ps;
            bf16x8 pa0, pa1, pa2, pa3;
#define PK4(P, B_, OUT) do { unsigned a0 = cvt_pk_bf16(P[B_+0], P[B_+1]), a1 = cvt_pk_bf16(P[B_+2], P[B_+3]); unsigned b0_ = cvt_pk_bf16(P[B_+4], P[B_+5]), b1_ = cvt_pk_bf16(P[B_+6], P[B_+7]); \
        auto r0 = __builtin_amdgcn_permlane32_swap(a0, b0_, false, false); auto r1 = __builtin_amdgcn_permlane32_swap(a1, b1_, false, false); \
        u32x4 w = {r0[0], r1[0], r0[1], r1[1]}; OUT = __builtin_bit_cast(bf16x8, w); } while (0)
            PK4(p0, 0, pa0); PK4(p0, 8, pa1); PK4(p1, 0, pa2); PK4(p1, 8, pa3);
#undef PK4
            if (!keep_max) { if (hi == 0) wsf[r32] = alpha; asm volatile("s_waitcnt lgkmcnt(0)" ::: "memory");
#pragma unroll
                for (int r = 0; r < 16; ++r) { const float a = wsf[crow(r, hi)];
#pragma unroll
                    for (int d = 0; d < 4; ++d) o[d][r] *= a; }
                asm volatile("s_waitcnt lgkmcnt(0)" ::: "memory"); }
#define TRRD(dst, off) asm volatile("ds_read_b64_tr_b16 %0, %1 offset:%2" : "=&v"(dst) : "v"(vb0), "i"(off) : "memory")
#define PV_D0(d0) do { s16x4 l0, l1, l2, l3, h0, h1, h2, h3; constexpr int b_ = v_rd_off(d0, 0, 0); \
        TRRD(l0, b_); TRRD(h0, b_ + 2048); TRRD(l1, b_ + 4096); TRRD(h1, b_ + 6144); TRRD(l2, b_ + 8192); TRRD(h2, b_ + 10240); TRRD(l3, b_ + 12288); TRRD(h3, b_ + 14336); \
        asm volatile("s_waitcnt lgkmcnt(0)" ::: "memory"); __builtin_amdgcn_sched_barrier(0); \
        o[d0] = __builtin_amdgcn_mfma_f32_32x32x16_bf16(pa0, (bf16x8){l0[0], l0[1], l0[2], l0[3], h0[0], h0[1], h0[2], h0[3]}, o[d0], 0, 0, 0); \
        o[d0] = __builtin_amdgcn_mfma_f32_32x32x16_bf16(pa1, (bf16x8){l1[0], l1[1], l1[2], l1[3], h1[0], h1[1], h1[2], h1[3]}, o[d0], 0, 0, 0); \
        o[d0] = __builtin_amdgcn_mfma_f32_32x32x16_bf16(pa2, (bf16x8){l2[0], l2[1], l2[2], l2[3], h2[0], h2[1], h2[2], h2[3]}, o[d0], 0, 0, 0); \
        o[d0] = __builtin_amdgcn_mfma_f32_32x32x16_bf16(pa3, (bf16x8){l3[0], l3[1], l3[2], l3[3], h3[0], h3[1], h3[2], h3[3]}, o[d0], 0, 0, 0); } while (0)
            PV_D0(0); PV_D0(1); PV_D0(2); PV_D0(3);
#undef PV_D0
#undef TRRD
        }
    }
#undef AT_ISSUE
    if (hi == 0) wsf[r32] = l_reg; asm volatile("s_waitcnt lgkmcnt(0)" ::: "memory");
    float rli[16];
#pragma unroll
    for (int r = 0; r < 16; ++r) rli[r] = __builtin_amdgcn_rcpf(wsf[crow(r, hi)]);
    asm volatile("s_waitcnt lgkmcnt(0)" ::: "memory");
    if constexpr (EPI == 0) {
#pragma unroll
        for (int r = 0; r < 16; ++r) { float* op = O1 + (size_t)(qlo + crow(r, hi)) * 512;
#pragma unroll
            for (int d = 0; d < 4; ++d) op[d * 32 + r32] = o[d][r] * rli[r]; }
    } else if constexpr (EPI == 1) {
        float gsub[4];
#pragma unroll
        for (int d = 0; d < 4; ++d) gsub[d] = subg[d * 32 + r32] * outscale;
        float o1v[16][4];
#pragma unroll
        for (int r = 0; r < 16; ++r) { const float* op = O1 + (size_t)(qlo + crow(r, hi)) * 512;
#pragma unroll
            for (int d = 0; d < 4; ++d) o1v[r][d] = op[d * 32 + r32]; }
#pragma unroll
        for (int r = 0; r < 16; ++r) { const int srow = qlo + crow(r, hi); float dv[4]; float ss = 0.f;
#pragma unroll
            for (int d = 0; d < 4; ++d) { dv[d] = o1v[r][d] - lam * (o[d][r] * rli[r]); ss += dv[d] * dv[d]; }
#pragma unroll
            for (int off = 1; off < 32; off <<= 1) ss += __shfl_xor(ss, off);
            const float rs = rsqrtf(ss * (1.f / 128.f) + NORM_EPS);
#pragma unroll
            for (int d = 0; d < 4; ++d) { const float v = dv[d] * rs * gsub[d] * O8_SCALE; const float vn = __shfl_xor(v, 1);
                const unsigned h2 = (unsigned)__builtin_amdgcn_cvt_pk_fp8_f32(v, vn, 0, false) & 0xffffu; const unsigned hn = (unsigned)__shfl_xor((int)h2, 2);
                if ((r32 & 3) == 0) *(unsigned*)(Oout + (size_t)srow * 2048 + d * 32 + r32) = h2 | (hn << 16); } }
    } else {
#pragma unroll
        for (int r = 0; r < 16; ++r) { const int srow = qlo + crow(r, hi);
#pragma unroll
            for (int d = 0; d < 4; ++d) { const float v = o[d][r] * rli[r] * O8_SCALE; const float vn = __shfl_xor(v, 1);
                const unsigned h2 = (unsigned)__builtin_amdgcn_cvt_pk_fp8_f32(v, vn, 0, false) & 0xffffu; const unsigned hn = (unsigned)__shfl_xor((int)h2, 2);
                if ((r32 & 3) == 0) *(unsigned*)(Oout + (size_t)srow * 2048 + d * 32 + r32) = h2 | (hn << 16); } }
    }
    __syncthreads();
}
}

__device__ __forceinline__ void phase_attention(const Ctx& C, ArgsK* A, int l) {
    {   const int NC = (C.G % 8 == 0 && C.G > CVT_NC) ? CVT_NC : C.G;
        if (C.bid < NC) { Ctx C2 = C; C2.G = NC; phase_convert_moe(C2, A, l); __syncthreads(); } }
    asm volatile("" : "+s"(A));
    unsigned char* ws = gptr(A->ws); const bf16_t* P = (const bf16_t*)(ws + WS_P); const bf16_t* Qm = (const bf16_t*)(ws + WS_QM); const bf16_t* Kf = (const bf16_t*)(ws + WS_KF);
    const bf16_t* Vm = (const bf16_t*)(ws + WS_VM); unsigned char* O = (unsigned char*)(ws + WS_O); float* O1 = (float*)(ws + WS_O1);
    const float* cosT = (const float*)(ws + WS_COS); const float* sinT = (const float*)(ws + WS_SIN); const float* kmean = (const float*)(ws + WS_KMEAN);
    constexpr float LOG2E = 1.4426950408889634f;
    float d1 = 0.f, d2 = 0.f;
    for (int i = 0; i < 64; ++i) { d1 += gptr(A->in[3])[l * 64 + i] * gptr(A->in[4])[l * 64 + i]; d2 += gptr(A->in[5])[l * 64 + i] * gptr(A->in[6])[l * 64 + i]; }
    const float lam_init = 0.8f - 0.6f * expf(-0.3f * (float)l);
    const float lam = expf(d1) - expf(d2) + lam_init;
    const int nq = 1, qx = C.bid % nq, bpq = 8 / nq, nun = 128 * bpq;
    unsigned* qc = (unsigned*)(ws + WS_CTL) + CW_AQ + l * 8 + qx;
    LAS int* slot = (LAS int*)(C.lds + 90112);
    if (C.tid == 0) *slot = (int)atomicAdd(qc, 1u);
    __syncthreads();
    int cur = __builtin_amdgcn_readfirstlane(*slot);
#pragma nounroll
    while (cur < nun) {
        int nxt = 0; if (C.tid == 0) nxt = (int)atomicAdd(qc, 1u);
        const int per = 16 * bpq, lvl = cur / per, r = cur - lvl * per, b = (r >> 4) * nq + qx, w = r & 15, qb = 7 - lvl, trow0 = b * SEQ;
        if (w < 8) { const int h = w;
            at::attn_unit<192, 0, 1, 2>(C.lds, Qm + (size_t)trow0 * 1536 + h * 192, 1536, Kf + (size_t)trow0 * 1536 + h * 192, 1536, Vm + (size_t)trow0 * 1024 + h * 128, 1024, trow0, qb, cosT, sinT,
                                        0.07216878364870322f * LOG2E, nullptr, nullptr, O + (size_t)trow0 * 2048 + 512 + h * 128, 0.f, 0.f, nullptr);
        } else if (w < 12) { const int h = w - 8;
            const bf16_t* Vp = P + (size_t)trow0 * PC + C_DV + h * 128;
            float* o1 = O1 + ((size_t)trow0 * 4 + h) * 128;
            at::attn_unit<64, 0, 0, 0>(C.lds, P + (size_t)trow0 * PC + C_DQ + h * 128, PC, P + (size_t)trow0 * PC + C_DK + h * 128, PC, Vp, PC, trow0, qb, cosT, sinT, 0.125f * LOG2E, nullptr,
                                       o1, nullptr, 0.f, 0.f, nullptr);
            at::attn_unit<64, 0, 0, 1>(C.lds, P + (size_t)trow0 * PC + C_DQ + h * 128 + 64, PC, P + (size_t)trow0 * PC + C_DK + h * 128 + 64, PC, Vp, PC, trow0, qb, cosT, sinT, 0.125f * LOG2E, nullptr,
                                       o1, O + (size_t)trow0 * 2048 + h * 128, lam, 1.f - lam_init, gptr(A->in[7]) + l * 128);
        } else { const int h = w - 12;
            at::attn_unit<128, 1, 2, 2>(C.lds, P + (size_t)trow0 * PC + C_MQ + h * 128, PC, P + (size_t)trow0 * PC + C_MK + h * 128, PC, P + (size_t)trow0 * PC + C_MV + h * 128, PC, trow0, qb, cosT, sinT,
                                        0.08838834764831845f * LOG2E, kmean + (size_t)(b * 4 + h) * 8 * 128, nullptr, O + (size_t)trow0 * 2048 + 1536 + h * 128, 0.f, 0.f, nullptr);
        }
        if (C.tid == 0) *slot = nxt;
        __syncthreads();
        cur = __builtin_amdgcn_readfirstlane(*slot);
    }
}

__device__ __forceinline__ void ld_gb(f32x4 (&gm)[4][2], f32x4 (&bt)[4][2], const float* g, const float* bb, int lane) {
#pragma unroll
    for (int j = 0; j < 4; ++j)
#pragma unroll
        for (int h = 0; h < 2; ++h) { const int c = (lane + 64 * j) * 8 + 4 * h; gm[j][h] = *(const f32x4*)(g + c); bt[j][h] = *(const f32x4*)(bb + c); }
}
__device__ __forceinline__ void ln_row(f32x4 (&v)[4][2], const f32x4 (&gm)[4][2], const f32x4 (&bt)[4][2], float* of, bf16_t* ob, unsigned char* oq, int lane) {
    float s = 0.f;
#pragma unroll
    for (int j = 0; j < 4; ++j)
#pragma unroll
        for (int h = 0; h < 2; ++h) s += (v[j][h][0] + v[j][h][1]) + (v[j][h][2] + v[j][h][3]);
    const float mean = wave_sum(s) * (1.f / DM); float s2 = 0.f;
#pragma unroll
    for (int j = 0; j < 4; ++j)
#pragma unroll
        for (int h = 0; h < 2; ++h) { const f32x4 d = v[j][h] - mean; s2 += (d[0] * d[0] + d[1] * d[1]) + (d[2] * d[2] + d[3] * d[3]); }
    const float rstd = rsqrtf(wave_sum(s2) * (1.f / DM) + NORM_EPS);
#pragma unroll
    for (int j = 0; j < 4; ++j) { const int c = (lane + 64 * j) * 8; f32x4 y[2];
#pragma unroll
        for (int h = 0; h < 2; ++h) y[h] = (v[j][h] - mean) * rstd * gm[j][h] + bt[j][h];
        if (of) { *(f32x4*)(of + c) = y[0]; *(f32x4*)(of + c + 4) = y[1]; }
        if (ob) *(u32x4*)(ob + c) = pk8(y[0], y[1]);
        if (oq) { u32x2 q; q.x = pk4_fp8(y[0][0], y[0][1], y[0][2], y[0][3]); q.y = pk4_fp8(y[1][0], y[1][1], y[1][2], y[1][3]); *(u32x2*)(oq + c) = q; } }
}
__device__ __forceinline__ void ld_bf16x8(f32x4 (&d)[2], const bf16_t* p, float sc) { const u32x4 w = *(const u32x4*)p;
    d[0] = (f32x4){bflo(w.x), bfhi(w.x), bflo(w.y), bfhi(w.y)} * sc; d[1] = (f32x4){bflo(w.z), bfhi(w.z), bflo(w.w), bfhi(w.w)} * sc; }
__device__ __forceinline__ void phase_ln_mix(const Ctx& C, ArgsK* A, int l) {
    const bf16_t* Z = (const bf16_t*)(C.ws + WS_X1F); bf16_t* XB1 = (bf16_t*)(C.ws + WS_X1B);
    const float* g = gptr(A->in[14]) + l * DM; const float* bb = gptr(A->in[15]) + l * DM;
    f32x4 gm[4][2], bt[4][2]; ld_gb(gm, bt, g, bb, C.lane);
    for (int row0 = (C.bid * NWAVES + C.wave) * 4; row0 < T; row0 += C.G * NWAVES * 4) { f32x4 v[4][4][2];
#pragma unroll
        for (int u = 0; u < 4; ++u)
#pragma unroll
            for (int j = 0; j < 4; ++j) ld_bf16x8(v[u][j], Z + (size_t)(row0 + u) * DM + (C.lane + 64 * j) * 8, 1.f);
#pragma unroll
        for (int u = 0; u < 4; ++u) ln_row(v[u], gm, bt, nullptr, XB1 + (size_t)(row0 + u) * DM, (unsigned char*)(C.ws + WS_X1Q) + (size_t)(row0 + u) * DM, C.lane); }
}

__device__ __forceinline__ void phase_route(const Ctx& C, ArgsK* A, int l) {
    unsigned char* ws = C.ws; const float* bias = gptr(A->in[17]) + l * NEXP;
    const float* logits = (const float*)(ws + WS_O1);
    int* ridx = (int*)(ws + WS_RIDX); float* rw = (float*)(ws + WS_RW); int* rpos = (int*)(ws + WS_RPOS); int* bbase = (int*)(ws + WS_BBASE);
    unsigned* ecnt = (unsigned*)(ws + WS_CTL) + CW_ECNT + l * 64;
    LAS int* hist = (LAS int*)C.lds;
    const int lane = C.lane;
    for (int chunk = C.bid; chunk < T / 64; chunk += C.G) {
        __syncthreads();
        if (C.tid < 64) hist[C.tid] = 0;
        __syncthreads();
        const float bs = bias[lane]; const float NEGI = -__builtin_inff();
        LAS float* cb = (LAS float*)(C.lds + 1024 + 16384) + C.wave * 128;
        const int gme = lane >> 3;
        float lsum[8];
#pragma unroll
        for (int q = 0; q < 8; ++q) { const float* lp = logits + (size_t)(chunk * 64 + C.wave * 8 + q) * 64 + lane; lsum[q] = (lp[0] + lp[(size_t)T * 64]) + (lp[(size_t)2 * T * 64] + lp[(size_t)3 * T * 64]); }
#pragma unroll
        for (int q = 0; q < 8; ++q) { const int t = chunk * 64 + C.wave * 8 + q;
            const float sv = sigmoidf_(lsum[q]); const float c = sv + bs;
            cb[lane] = c; asm volatile("s_waitcnt lgkmcnt(0)" ::: "memory");
            const f32x4 ga = *(const LAS f32x4*)(cb + gme * 8), gb = *(const LAS f32x4*)(cb + gme * 8 + 4);
            float m1 = ga[0], m2 = NEGI;
#define TOP2(x) do { const float x_ = (x); const bool gt1 = x_ > m1; m2 = gt1 ? m1 : (x_ > m2 ? x_ : m2); m1 = gt1 ? x_ : m1; } while (0)
            TOP2(ga[1]); TOP2(ga[2]); TOP2(ga[3]); TOP2(gb[0]); TOP2(gb[1]); TOP2(gb[2]); TOP2(gb[3]);
#undef TOP2
            if ((lane & 7) == 0) cb[64 + gme] = m1 + m2;
            asm volatile("s_waitcnt lgkmcnt(0)" ::: "memory");
            const f32x4 s0 = *(const LAS f32x4*)(cb + 64), s1 = *(const LAS f32x4*)(cb + 68);
            const float gsv[8] = {s0[0], s0[1], s0[2], s0[3], s1[0], s1[1], s1[2], s1[3]};
            unsigned keepm = 0u;
#pragma unroll
            for (int g = 0; g < 8; ++g) { int r = 0;
#pragma unroll
                for (int h = 0; h < 8; ++h) if (h != g) r += (gsv[h] > gsv[g] || (gsv[h] == gsv[g] && h < g)) ? 1 : 0;
                if (r < 4) keepm |= 1u << g; }
            const bool keep = (keepm >> gme) & 1u;
            unsigned ub = __float_as_uint(c); ub = (ub & 0x80000000u) ? ~ub : (ub | 0x80000000u);
            const unsigned key = keep ? ((ub & ~63u) | (unsigned)(63 - lane)) : 0u;
            LAS unsigned* kb = (LAS unsigned*)cb;
            asm volatile("s_waitcnt lgkmcnt(0)" ::: "memory");
            kb[lane] = key; asm volatile("s_waitcnt lgkmcnt(0)" ::: "memory");
            int rk = 0;
#pragma unroll
            for (int e4 = 0; e4 < 16; ++e4) { const u32x4 v = *(const LAS u32x4*)(kb + e4 * 4);
                rk += (v[0] > key ? 1 : 0) + (v[1] > key ? 1 : 0) + (v[2] > key ? 1 : 0) + (v[3] > key ? 1 : 0); }
            const bool sel = keep && rk < 8;
            const float wsum = wave_sum(sel ? sv : 0.f);
            if (sel) { const int lr = __hip_atomic_fetch_add(hist + lane, 1, __ATOMIC_RELAXED, __HIP_MEMORY_SCOPE_WORKGROUP); ridx[t * 8 + rk] = lane; rw[t * 8 + rk] = sv / wsum * 2.5f; rpos[t * 8 + rk] = lr; }
            asm volatile("s_waitcnt lgkmcnt(0)" ::: "memory");
        }
        __syncthreads();
        if (C.tid < 64) bbase[chunk * 64 + C.tid] = (int)atomicAdd(ecnt + C.tid, (unsigned)hist[C.tid]);
    }
}
template <bool WANT_SEG> __device__ __forceinline__ void build_moe_tables(const Ctx& C, int l, LAS int* segb  ) {
    const unsigned* ecnt = (const unsigned*)(C.ws + WS_CTL) + CW_ECNT + l * 64;
    LAS unsigned char* tab = C.lds + TAB_OFF; LAS int* tile_e = (LAS int*)(tab + TAB_TILEE); LAS int* misc = (LAS int*)(tab + TAB_MISC);
    __syncthreads();
    if (C.wave == 0) { const int e = C.lane; const int cnt = (int)__hip_atomic_load(ecnt + e, __ATOMIC_RELAXED, __HIP_MEMORY_SCOPE_AGENT); const int nt = (cnt + 255) >> 8;
        int incl = nt;
#pragma unroll
        for (int o = 1; o < 64; o <<= 1) { const int v = __shfl_up(incl, o); if (e >= o) incl += v; }
        const int base = incl - nt; const int nrt = __shfl(incl, 63);
        for (int i = 0; i < nt; ++i) tile_e[base + i] = e;
        tile_e[nrt + e] = NEXP;
        if constexpr (WANT_SEG) segb[e] = base * 256;
        if (e == 0) { misc[0] = nrt; misc[1] = nrt + 64; } }
    __syncthreads();
}
__device__ __forceinline__ void phase_scatter(const Ctx& C, int l) {
    unsigned char* ws = C.ws; const int* ridx = (const int*)(ws + WS_RIDX); const float* rw = (const float*)(ws + WS_RW); int* rpos = (int*)(ws + WS_RPOS); const int* bbase = (const int*)(ws + WS_BBASE);
    int* stok = (int*)(ws + WS_STOK); float* sw = (float*)(ws + WS_SW);
    const unsigned* ecnt = (const unsigned*)(ws + WS_CTL) + CW_ECNT + l * 64;
    LAS int* segb = (LAS int*)C.lds;
    build_moe_tables<true>(C, l, segb);
    for (int chunk = C.bid; chunk < T / 64; chunk += C.G) {
        const int t = chunk * 64 + (C.tid >> 3), k = C.tid & 7; const int e = ridx[t * 8 + k];
        const int pos = segb[e] + bbase[chunk * 64 + e] + rpos[t * 8 + k];
        rpos[t * 8 + k] = pos; stok[pos] = t; sw[pos] = rw[t * 8 + k];
    }
    for (int e = C.bid; e < NEXP; e += C.G) { const int cnt = (int)__hip_atomic_load(ecnt + e, __ATOMIC_RELAXED, __HIP_MEMORY_SCOPE_AGENT); const int endp = segb[e] + ((cnt + 255) & ~255);
        for (int p = segb[e] + cnt + C.tid; p < endp; p += NTHR) { stok[p] = 0; sw[p] = 0.f; } }
    __syncthreads();
}

__device__ __forceinline__ void phase_combine(const Ctx& C, ArgsK* A, int l) {
    unsigned char* ws = C.ws; const bf16_t* X1 = (const bf16_t*)(ws + WS_X1B); const unsigned char* YS = (const unsigned char*)(ws + WS_YS); const int* rpos = (const int*)(ws + WS_RPOS);
    float* OF = (l == 1) ? gptr(A->out) : nullptr; bf16_t* OB = (l == 1) ? nullptr : (bf16_t*)(ws + WS_XB);
    const float* g = gptr(A->in[24]) + l * DM; const float* bb = gptr(A->in[25]) + l * DM;
    int srn[2][8];
    { const int r_ = (C.bid * NWAVES + C.wave) * 2;
#pragma unroll
      for (int u = 0; u < 2; ++u)
#pragma unroll
        for (int k = 0; k < 8; ++k) srn[u][k] = rpos[(r_ + u) * 8 + k]; }
    for (int row0 = (C.bid * NWAVES + C.wave) * 2; row0 < T; row0 += C.G * NWAVES * 2) {
        int sr[2][9];
#pragma unroll
        for (int u = 0; u < 2; ++u) {
#pragma unroll
            for (int k = 0; k < 8; ++k) sr[u][k] = srn[u][k];
            sr[u][8] = RT_ROWS + row0 + u; }
        f32x4 v[2][4][2]; u32x2 yw[2][9][4];
#pragma unroll
        for (int u = 0; u < 2; ++u)
#pragma unroll
            for (int k = 0; k < 9; ++k) { const unsigned char* yr = YS + (size_t)sr[u][k] * DM;
#pragma unroll
                for (int j = 0; j < 4; ++j) yw[u][k][j] = *(const u32x2*)(yr + (C.lane + 64 * j) * 8); }
#pragma unroll
        for (int u = 0; u < 2; ++u)
#pragma unroll
            for (int j = 0; j < 4; ++j) ld_bf16x8(v[u][j], X1 + (size_t)(row0 + u) * DM + (C.lane + 64 * j) * 8, DN_ALPHA);
        { const int rn = row0 + C.G * NWAVES * 2, rc = rn < T ? rn : row0;
#pragma unroll
          for (int u = 0; u < 2; ++u)
#pragma unroll
            for (int k = 0; k < 8; ++k) srn[u][k] = rpos[(rc + u) * 8 + k]; }
        f32x4 gm[4][2], bt[4][2]; ld_gb(gm, bt, g, bb, C.lane);
#pragma unroll
        for (int u = 0; u < 2; ++u) {
#pragma unroll
            for (int j = 0; j < 4; ++j) { f32x4 a0 = {0.f, 0.f, 0.f, 0.f}, a1 = a0;
#pragma unroll
                for (int k = 0; k < 9; ++k) { float lo[4], hi[4]; fp8x4_to_f32(yw[u][k][j].x, lo); fp8x4_to_f32(yw[u][k][j].y, hi);
                    a0 += (f32x4){lo[0], lo[1], lo[2], lo[3]}; a1 += (f32x4){hi[0], hi[1], hi[2], hi[3]}; }
                v[u][j][0] += a0 * (1.f / YS8_SCALE); v[u][j][1] += a1 * (1.f / YS8_SCALE); }
            const int row = row0 + u;
            ln_row(v[u], gm, bt, OF ? OF + (size_t)row * DM : nullptr, OB ? OB + (size_t)row * DM : nullptr, OB ? (unsigned char*)(ws + WS_XQ) + (size_t)row * DM : nullptr, C.lane); }
    }
}

template <unsigned MASK> __global__ void __launch_bounds__(NTHR, 2) mk_fwd(Args args) {
    extern __shared__ __attribute__((aligned(16))) unsigned char lds_raw[];
    Ctx C;
    C.lds = (LAS unsigned char*)lds_raw; C.tid = threadIdx.x; C.lane = C.tid & 63; C.wave = __builtin_amdgcn_readfirstlane(C.tid >> 6); C.G = gridDim.x; C.bid = blockIdx.x;
    C.ws = args.ws; C.out = args.out;
    volatile LAS unsigned* MISC = (volatile LAS unsigned*)(C.lds + MISC_OFF);
    if (C.tid < 32) MISC[C.tid] = 0u;
    __syncthreads();
    unsigned char* ws = args.ws; ArgsK* ap;
    unsigned* ctl = (unsigned*)(ws + WS_CTL);
#if MK_ONE_LAUNCH
    XcdBarrier bar = xcd_barrier_post(ctl + CW_BAR, MISC + 8);
#define GRID_BAR() xcd_barrier(bar)
#else
#define GRID_BAR() do { } while (0)
#endif
    const int lo = args.ph_lo, hi = args.ph_hi;
#if MK_ONE_LAUNCH
#define IN(k) true
#else
#define IN(k) (((MASK >> ((k) % NPH)) & 1u) && lo <= (k) && (k) < hi)
#endif
#if MK_ONE_LAUNCH
#define BOTH(k) true
#else
#define BOTH(k) (IN(k) && IN((k) + 1))
#endif
#define OPAQUE_WS() do { ap = (ArgsK*)__builtin_amdgcn_kernarg_segment_ptr(); asm volatile("" : "+s"(ap)); ws = gptr(ap->ws); } while (0)
    for (int l = 0; l < 2; ++l) {
        OPAQUE_WS();
        const int pb = l * NPH;
        float* rsq_q = (float*)(ws + WS_RSQQ); float* rsq_kv = (float*)(ws + WS_RSQKV);
        for (int rep_ = 0; rep_ < REPN(0); ++rep_) if constexpr ((MASK >> 0) & 1u) if (l == 0 && IN(pb + 0)) { OPAQUE_WS(); C.ws = ws; { int t_ = threadIdx.x; asm volatile("" : "+v"(t_)); C.tid = t_; C.lane = t_ & 63; C.wave = __builtin_amdgcn_readfirstlane(t_ >> 6); int b_ = blockIdx.x, g_ = gridDim.x; asm volatile("" : "+s"(b_), "+s"(g_)); C.bid = b_; C.G = g_; }     phase_convert(C, ap, l); if (BOTH(pb + 0)) GRID_BAR(); }
        for (int rep_ = 0; rep_ < REPN(1); ++rep_) if constexpr ((MASK >> 1) & 1u) if (IN(pb + 1)) { OPAQUE_WS(); C.ws = ws; { int t_ = threadIdx.x; asm volatile("" : "+v"(t_)); C.tid = t_; C.lane = t_ & 63; C.wave = __builtin_amdgcn_readfirstlane(t_ >> 6); int b_ = blockIdx.x, g_ = gridDim.x; asm volatile("" : "+s"(b_), "+s"(g_)); C.bid = b_; C.G = g_; }
            { DenseSched S; S.so.init(T, PC, C.G, C.bid); S.A = (const char*)(ws + WS_XQ); S.B = (const char*)(ws + (l ? MIXOFS1 : 0) + WS_WIN); S.lda = DM; S.ldb = DM; S.nt = DM / 128;
              EpiInProj E{(bf16_t*)(ws + WS_P), rsq_q, rsq_kv};
              gm::gemm_phase<EpiInProj, DenseSched, false, false, true>(C.lds, DM, DM, S, E); }
            if (BOTH(pb + 1)) GRID_BAR(); }
        for (int rep_ = 0; rep_ < REPN(2); ++rep_) if constexpr ((MASK >> 2) & 1u) if (IN(pb + 2)) { OPAQUE_WS(); C.ws = ws; { int t_ = threadIdx.x; asm volatile("" : "+v"(t_)); C.tid = t_; C.lane = t_ & 63; C.wave = __builtin_amdgcn_readfirstlane(t_ >> 6); int b_ = blockIdx.x, g_ = gridDim.x; asm volatile("" : "+s"(b_), "+s"(g_)); C.bid = b_; C.G = g_; }
            if (rep_ == 0) phase_krope(C);
            __syncthreads();
            UpSched S{(const char*)(ws + WS_P), (const char*)(ws + (l ? MIXOFS1 : 0) + WS_WUQ), (const char*)(ws + (l ? MIXOFS1 : 0) + WS_WUKV), C.G, C.bid};
            EpiUp E{(bf16_t*)(ws + WS_QM), (bf16_t*)(ws + WS_KF), (bf16_t*)(ws + WS_VM), rsq_q, rsq_kv};
            gm::gemm_phase<EpiUp, UpSched, false, false>(C.lds, PC * 2, 1024, S, E);
            if (BOTH(pb + 2)) GRID_BAR(); }
        for (int rep_ = 0; rep_ < REPN(3); ++rep_) if constexpr ((MASK >> 3) & 1u) if (IN(pb + 3)) { OPAQUE_WS(); C.ws = ws; { int t_ = threadIdx.x; asm volatile("" : "+v"(t_)); C.tid = t_; C.lane = t_ & 63; C.wave = __builtin_amdgcn_readfirstlane(t_ >> 6); int b_ = blockIdx.x, g_ = gridDim.x; asm volatile("" : "+s"(b_), "+s"(g_)); C.bid = b_; C.G = g_; }     phase_attention(C, ap, l); if (BOTH(pb + 3)) GRID_BAR(); }
        for (int rep_ = 0; rep_ < REPN(4); ++rep_) if constexpr ((MASK >> 4) & 1u) if (IN(pb + 4)) { OPAQUE_WS(); C.ws = ws; { int t_ = threadIdx.x; asm volatile("" : "+v"(t_)); C.tid = t_; C.lane = t_ & 63; C.wave = __builtin_amdgcn_readfirstlane(t_ >> 6); int b_ = blockIdx.x, g_ = gridDim.x; asm volatile("" : "+s"(b_), "+s"(g_)); C.bid = b_; C.G = g_; }
            BranchSched S; S.so.init(T, DM, C.G, C.bid); S.A = (const char*)(ws + WS_O); S.B = (const char*)(ws + (l ? MIXOFS1 : 0) + WS_WBR);
            EpiBranch E{(bf16_t*)(ws + WS_YB), (unsigned char*)(ws + WS_O) + 32 * MiB, (const bf16_t*)(ws + WS_P)};
            gm::gemm_phase<EpiBranch, BranchSched, false, false, true>(C.lds, DM, DM, S, E);
            if (BOTH(pb + 4)) GRID_BAR(); }
        for (int rep_ = 0; rep_ < REPN(5); ++rep_) if constexpr ((MASK >> 5) & 1u) if (IN(pb + 5)) { OPAQUE_WS(); C.ws = ws; { int t_ = threadIdx.x; asm volatile("" : "+v"(t_)); C.tid = t_; C.lane = t_ & 63; C.wave = __builtin_amdgcn_readfirstlane(t_ >> 6); int b_ = blockIdx.x, g_ = gridDim.x; asm volatile("" : "+s"(b_), "+s"(g_)); C.bid = b_; C.G = g_; }
            DenseSched S; S.so.init(T, DM, C.G, C.bid); S.A = (const char*)(ws + WS_O) + 32 * MiB; S.B = (const char*)(ws + (l ? MIXOFS1 : 0) + WS_WOUT); S.lda = DM; S.ldb = DM; S.nt = DM / 128;
            EpiOut E{(bf16_t*)(ws + WS_X1F), (const bf16_t*)(ws + WS_XB)};
            gm::gemm_phase<EpiOut, DenseSched, false, true, true>(C.lds, DM, DM, S, E);
            if (BOTH(pb + 5)) GRID_BAR(); }
        for (int rep_ = 0; rep_ < REPN(6); ++rep_) if constexpr ((MASK >> 6) & 1u) if (IN(pb + 6)) { OPAQUE_WS(); C.ws = ws; { int t_ = threadIdx.x; asm volatile("" : "+v"(t_)); C.tid = t_; C.lane = t_ & 63; C.wave = __builtin_amdgcn_readfirstlane(t_ >> 6); int b_ = blockIdx.x, g_ = gridDim.x; asm volatile("" : "+s"(b_), "+s"(g_)); C.bid = b_; C.G = g_; }     phase_ln_mix(C, ap, l); if (BOTH(pb + 6)) GRID_BAR(); }
        for (int rep_ = 0; rep_ < REPN(7); ++rep_) if constexpr ((MASK >> 7) & 1u) if (IN(pb + 7)) { OPAQUE_WS(); C.ws = ws; { int t_ = threadIdx.x; asm volatile("" : "+v"(t_)); C.tid = t_; C.lane = t_ & 63; C.wave = __builtin_amdgcn_readfirstlane(t_ >> 6); int b_ = blockIdx.x, g_ = gridDim.x; asm volatile("" : "+s"(b_), "+s"(g_)); C.bid = b_; C.G = g_; }
            RouterSched S{(const char*)(ws + WS_X1B), (const char*)(ws + (l ? MIXOFS1 : 0) + WS_WR), C.G, C.bid};
            EpiLogit E{(float*)(ws + WS_O1)};
            gm::gemm_phase<EpiLogit, RouterSched, false, false>(C.lds, DM * 2, DM * 2, S, E);
            if (BOTH(pb + 7)) GRID_BAR(); }
        for (int rep_ = 0; rep_ < REPN(8); ++rep_) if constexpr ((MASK >> 8) & 1u) if (IN(pb + 8)) { OPAQUE_WS(); C.ws = ws; { int t_ = threadIdx.x; asm volatile("" : "+v"(t_)); C.tid = t_; C.lane = t_ & 63; C.wave = __builtin_amdgcn_readfirstlane(t_ >> 6); int b_ = blockIdx.x, g_ = gridDim.x; asm volatile("" : "+s"(b_), "+s"(g_)); C.bid = b_; C.G = g_; }     phase_route(C, ap, l); if (BOTH(pb + 8)) GRID_BAR(); }
        for (int rep_ = 0; rep_ < REPN(9); ++rep_) if constexpr ((MASK >> 9) & 1u) if (IN(pb + 9)) { OPAQUE_WS(); C.ws = ws; { int t_ = threadIdx.x; asm volatile("" : "+v"(t_)); C.tid = t_; C.lane = t_ & 63; C.wave = __builtin_amdgcn_readfirstlane(t_ >> 6); int b_ = blockIdx.x, g_ = gridDim.x; asm volatile("" : "+s"(b_), "+s"(g_)); C.bid = b_; C.G = g_; }     phase_scatter(C, l); if (BOTH(pb + 9)) GRID_BAR(); }
        for (int rep_ = 0; rep_ < REPN(10); ++rep_) if constexpr ((MASK >> 10) & 1u) if (IN(pb + 10)) { OPAQUE_WS(); C.ws = ws; { int t_ = threadIdx.x; asm volatile("" : "+v"(t_)); C.tid = t_; C.lane = t_ & 63; C.wave = __builtin_amdgcn_readfirstlane(t_ >> 6); int b_ = blockIdx.x, g_ = gridDim.x; asm volatile("" : "+s"(b_), "+s"(g_)); C.bid = b_; C.G = g_; }
            build_moe_tables<false>(C, l, (LAS int*)C.lds);
            LAS unsigned char* tab = C.lds + TAB_OFF;
            {
                const LAS int* misc = (const LAS int*)(tab + TAB_MISC); const int nrt = misc[0], ntl = misc[1]; const int* stok = (const int*)(ws + WS_STOK);
                LAS unsigned* idx = (LAS unsigned*)(tab + TAB_IDX);
#pragma nounroll
                for (int i = 0; i < 10; ++i) { const int L = xcd_chunk_unit(i, C.bid, C.G, ntl * 4); if (L < 0) break; const int tile = L >> 2;
                    if (C.tid < 256) { idx[i * 256 + C.tid] = tile < nrt ? (unsigned)stok[tile * 256 + C.tid] : (unsigned)((tile - nrt) * 256 + C.tid);
                        ((LAS float*)(tab + TAB_SW))[i * 256 + C.tid] = tile < nrt ? ((const float*)(ws + WS_SW))[tile * 256 + C.tid] : 1.f; } }
                __syncthreads();
            }
            Moe1Sched S1{tab, (const char*)(ws + WS_X1Q), (const char*)(ws + WS_W13), C.G, C.bid};
            EpiMoe1 E1{(unsigned char*)(ws + WS_HID), (const LAS float*)(tab + TAB_SW)};
            gm::gemm_phase<EpiMoe1, Moe1Sched, true, false, true>(C.lds, DM, DM, S1, E1);
#if MK_ONE_LAUNCH
            GRID_BAR();
#endif
        }
        if constexpr (((MASK >> 10) & 1u) && MK_ONE_LAUNCH) if (IN(pb + 10)) { OPAQUE_WS(); C.ws = ws; { int t_ = threadIdx.x; asm volatile("" : "+v"(t_)); C.tid = t_; C.lane = t_ & 63; C.wave = __builtin_amdgcn_readfirstlane(t_ >> 6); int b_ = blockIdx.x, g_ = gridDim.x; asm volatile("" : "+s"(b_), "+s"(g_)); C.bid = b_; C.G = g_; }
            LAS unsigned char* tab = C.lds + TAB_OFF;
            Moe2Sched S2{tab, (const char*)(ws + WS_HID), (const char*)(ws + WS_W2), C.G, C.bid};
            EpiMoe2 E2{(unsigned char*)(ws + WS_YS)};
            for (int rep_ = 0; rep_ < REPN(11); ++rep_) { gm::gemm_phase<EpiMoe2, Moe2Sched, false, false, true>(C.lds, FF, FF, S2, E2);
            GRID_BAR(); }
            for (int rep_ = 0; rep_ < REPN(12); ++rep_) { phase_combine(C, ap, l);
            if (l == 0 || rep_ + 1 < REPN(12)) GRID_BAR(); }
        }
    }
#undef IN
#undef BOTH
}

#if !MK_ONE_LAUNCH
__global__ void __launch_bounds__(NTHR, 2) mk_moe2(Args args, int l) {
    extern __shared__ __attribute__((aligned(16))) unsigned char lds_raw[];
    Ctx C; C.lds = (LAS unsigned char*)lds_raw; C.tid = threadIdx.x; C.lane = C.tid & 63; C.wave = __builtin_amdgcn_readfirstlane(C.tid >> 6); C.G = gridDim.x; C.bid = blockIdx.x; C.ws = args.ws; C.out = args.out;
    build_moe_tables<false>(C, l, (LAS int*)C.lds);
    LAS unsigned char* tab = C.lds + TAB_OFF; unsigned char* ws = args.ws;
    Moe2Sched S2{tab, (const char*)(ws + WS_HID), (const char*)(ws + WS_W2), C.G, C.bid};
    EpiMoe2 E2{(unsigned char*)(ws + WS_YS)};
    gm::gemm_phase<EpiMoe2, Moe2Sched, false, false, true>(C.lds, FF, FF, S2, E2);
}
__global__ void __launch_bounds__(NTHR, 2) mk_combine(Args args, int l) {
    extern __shared__ __attribute__((aligned(16))) unsigned char lds_raw[];
    Ctx C; C.lds = (LAS unsigned char*)lds_raw; C.tid = threadIdx.x; C.lane = C.tid & 63; C.wave = __builtin_amdgcn_readfirstlane(C.tid >> 6); C.G = gridDim.x; C.bid = blockIdx.x; C.ws = args.ws; C.out = args.out;
    phase_combine(C, (ArgsK*)__builtin_amdgcn_kernarg_segment_ptr(), l);
}
#endif


#ifdef DBG_STOP
__global__ void dbg_gather(const unsigned short* H, const unsigned short* YS, const int* rpos, float* out, int mode) {
    const size_t n = (size_t)T * DM;
    for (size_t i = (size_t)blockIdx.x * blockDim.x + threadIdx.x; i < n; i += (size_t)gridDim.x * blockDim.x) {
        if (mode == 9) { const size_t q = i % 131072; const int p = rpos[q]; const int* stok = (const int*)H; const float* sw = (const float*)YS; const bool oor = (p < 0 || p >= 147456);
#if DBG_SUB == 0
            out[i] = oor ? 1.f : 0.f;
#elif DBG_SUB == 1
            out[i] = oor ? 0.f : (stok[p] != (int)(q / 8) ? 1.f : 0.f);
#else
            out[i] = oor ? 0.f : sw[p];
#endif
            }
        else if (mode == 10) { const size_t t = i / 4096, k = (i / 512) % 8, c = i % 512; out[i] = __uint_as_float(((unsigned)H[(size_t)rpos[t * 8 + k] * 512 + c]) << 16); }
        else { const size_t t = i / 2048, c = i % 2048; float s = 0.f; for (int k = 0; k < 8; ++k) s += __uint_as_float(((unsigned)YS[(size_t)rpos[t * 8 + k] * 2048 + c]) << 16); out[i] = s; }
    }
}
__global__ void dbg_copy(const void* src, int is_f32, float* out, size_t n, size_t nsrc) {
    for (size_t i = (size_t)blockIdx.x * blockDim.x + threadIdx.x; i < n; i += (size_t)gridDim.x * blockDim.x) {
        const size_t j = i % nsrc; out[i] = is_f32 ? ((const float*)src)[j] : __uint_as_float(((unsigned)((const unsigned short*)src)[j]) << 16); }
}
#endif
#if MK_ONE_LAUNCH
static hipError_t set_attr_all() { return hipFuncSetAttribute((const void*)mk_fwd<0x7ffu>, hipFuncAttributeMaxDynamicSharedMemorySize, LDS_BYTES); }
#else
template <unsigned M> static hipError_t set_attr_one() { return hipFuncSetAttribute((const void*)mk_fwd<M>, hipFuncAttributeMaxDynamicSharedMemorySize, LDS_BYTES); }
static hipError_t set_attr_all() { hipError_t e = hipSuccess, r;
    r = set_attr_one<1u>(); if (r != hipSuccess) e = r; r = set_attr_one<2u>(); if (r != hipSuccess) e = r; r = set_attr_one<4u>(); if (r != hipSuccess) e = r; r = set_attr_one<8u>(); if (r != hipSuccess) e = r;
    r = set_attr_one<16u>(); if (r != hipSuccess) e = r; r = set_attr_one<32u>(); if (r != hipSuccess) e = r; r = set_attr_one<64u>(); if (r != hipSuccess) e = r; r = set_attr_one<128u>(); if (r != hipSuccess) e = r;
    r = set_attr_one<256u>(); if (r != hipSuccess) e = r; r = set_attr_one<512u>(); if (r != hipSuccess) e = r; r = set_attr_one<1024u>(); if (r != hipSuccess) e = r; return e; }
static void launch_phase(int k, int grid, hipStream_t stream, const Args& a) {
    switch (k) {
    case 0: hipLaunchKernelGGL(mk_fwd<1u>, dim3(grid), dim3(NTHR), LDS_BYTES, stream, a); break;
    case 1: hipLaunchKernelGGL(mk_fwd<2u>, dim3(grid), dim3(NTHR), LDS_BYTES, stream, a); break;
    case 2: hipLaunchKernelGGL(mk_fwd<4u>, dim3(grid), dim3(NTHR), LDS_BYTES, stream, a); break;
    case 3: hipLaunchKernelGGL(mk_fwd<8u>, dim3(grid), dim3(NTHR), LDS_BYTES, stream, a); break;
    case 4: hipLaunchKernelGGL(mk_fwd<16u>, dim3(grid), dim3(NTHR), LDS_BYTES, stream, a); break;
    case 5: hipLaunchKernelGGL(mk_fwd<32u>, dim3(grid), dim3(NTHR), LDS_BYTES, stream, a); break;
    case 6: hipLaunchKernelGGL(mk_fwd<64u>, dim3(grid), dim3(NTHR), LDS_BYTES, stream, a); break;
    case 7: hipLaunchKernelGGL(mk_fwd<128u>, dim3(grid), dim3(NTHR), LDS_BYTES, stream, a); break;
    case 8: hipLaunchKernelGGL(mk_fwd<256u>, dim3(grid), dim3(NTHR), LDS_BYTES, stream, a); break;
    case 9: hipLaunchKernelGGL(mk_fwd<512u>, dim3(grid), dim3(NTHR), LDS_BYTES, stream, a); break;
    default: hipLaunchKernelGGL(mk_fwd<1024u>, dim3(grid), dim3(NTHR), LDS_BYTES, stream, a); break;
    }
}
#endif

extern "C" void kernel_launch(void* const* d_in, const int* in_sizes, int n_in, void* d_out, int out_size, void* d_ws, size_t ws_size, hipStream_t stream) {
    static int grid = 0;
    if (grid == 0) {
        if (n_in != 26 || out_size != T * DM || ws_size < WS_END) { fprintf(stderr, "kernel_launch: unexpected shapes (n_in %d out %d ws %zu need %zu)\n", n_in, out_size, ws_size, (size_t)WS_END); grid = -1; return; }
        int dev = 0, cus = 0;
        if (hipGetDevice(&dev) != hipSuccess || hipDeviceGetAttribute(&cus, hipDeviceAttributeMultiprocessorCount, dev) != hipSuccess) { grid = -1; return; }
        if (set_attr_all() != hipSuccess) { fprintf(stderr, "kernel_launch: hipFuncSetAttribute failed\n"); grid = -1; return; }
#if !MK_ONE_LAUNCH
        (void)hipFuncSetAttribute((const void*)mk_moe2, hipFuncAttributeMaxDynamicSharedMemorySize, LDS_BYTES);
        (void)hipFuncSetAttribute((const void*)mk_combine, hipFuncAttributeMaxDynamicSharedMemorySize, LDS_BYTES);
#endif
        int per_cu = 0;
        if (hipOccupancyMaxActiveBlocksPerMultiprocessor(&per_cu, (const void*)mk_fwd<MK_ONE_LAUNCH ? 0x7ffu : 0x2u>, NTHR, LDS_BYTES) != hipSuccess || per_cu < 1) fprintf(stderr, "kernel_launch: occupancy query says %d\n", per_cu);
        (void)hipGetLastError();
        grid = cus > 256 ? 256 : cus;
    }
    if (grid < 0) return;
    (void)hipMemsetAsync((char*)d_ws + WS_CTL, 0, CTL_ZERO_BYTES, stream);
    Args a{};
    for (int i = 0; i < 26; ++i) a.in[i] = (const float*)d_in[i];
    a.out = (float*)d_out; a.ws = (unsigned char*)d_ws;
    for (int j = 0; j < 8; ++j) a.invf[j] = (float)pow(500000.0, -(double)(2 * j) / 16.0);
    for (int j = 0; j < 32; ++j) a.invf[8 + j] = (float)pow(500000.0, -(double)(2 * j) / 64.0);
    for (int j = 0; j < 16; ++j) a.invf[40 + j] = (float)pow(500000.0, -(double)(2 * j) / 32.0);
#if MK_ONE_LAUNCH
    a.ph_lo = 0; a.ph_hi = 2 * NPH;
    hipLaunchKernelGGL(mk_fwd<0x7ffu>, dim3(grid), dim3(NTHR), LDS_BYTES, stream, a);
#else
#ifdef DBG_STOP
    {
        const int l = 0;
        for (int k = 0; k < NPH && k <= DBG_STOP; ++k) { a.ph_lo = l * NPH + k; a.ph_hi = a.ph_lo + 1; launch_phase(k, grid, stream, a); }
        if (DBG_STOP >= 11) hipLaunchKernelGGL(mk_moe2, dim3(grid), dim3(NTHR), LDS_BYTES, stream, a, l);
        if (DBG_STOP >= 12) hipLaunchKernelGGL(mk_combine, dim3(grid), dim3(NTHR), LDS_BYTES, stream, a, l);
        const size_t n = (size_t)T * DM; unsigned char* w = (unsigned char*)d_ws;
        const void* src; int f32 = 0; size_t nsrc = n;
        switch (DBG_STOP) {
        case 0: src = w + WS_WIN; nsrc = (size_t)10240 * 2048; break;
        case 1: src = w + WS_P; break;
        case 2: src = w + WS_QM; nsrc = (size_t)T * (1536 + 1536 + 1024); break;
        case 3: src = w + WS_O; break;
        case 4: src = w + WS_YB; break;
        case 5: src = w + WS_X1F; f32 = 1; break;
        case 6: src = w + WS_X1B; break;
        case 7: src = w + WS_LOGIT; f32 = 1; nsrc = (size_t)T * 64; break;
        case 8: src = w + WS_RW; f32 = 1; nsrc = (size_t)T * 8; break;
        default: src = w + WS_X2F; f32 = 1; break;
        }
        if (DBG_STOP == 9) hipLaunchKernelGGL(dbg_gather, dim3(1024), dim3(256), 0, stream, (const unsigned short*)(w + WS_STOK), (const unsigned short*)(w + WS_SW), (const int*)(w + WS_RPOS), (float*)d_out, 9);
        else if (DBG_STOP == 10 || DBG_STOP == 11) hipLaunchKernelGGL(dbg_gather, dim3(1024), dim3(256), 0, stream, (const unsigned short*)(w + WS_HID), (const unsigned short*)(w + WS_YS), (const int*)(w + WS_RPOS), (float*)d_out, (int)DBG_STOP);
        else hipLaunchKernelGGL(dbg_copy, dim3(1024), dim3(256), 0, stream, src, f32, (float*)d_out, n, nsrc);
    }
#else
    for (int l = 0; l < 2; ++l) {
        for (int k = 0; k < NPH; ++k) { a.ph_lo = l * NPH + k; a.ph_hi = a.ph_lo + 1; launch_phase(k, grid, stream, a); }
        hipLaunchKernelGGL(mk_moe2, dim3(grid), dim3(NTHR), LDS_BYTES, stream, a, l);
        hipLaunchKernelGGL(mk_combine, dim3(grid), dim3(NTHR), LDS_BYTES, stream, a, l);
    }
#endif
#endif
}
```
